# Optimizing an MI355X kernel written in HIP

```python
import jax
import jax.numpy as jnp
from jax import lax
import numpy as np


D_MODEL = 1024
BATCH = 4
SEQ = 4096
DEPTH = 2

GRID_W = 64
CTX_LEN = 256
HEAD_DIM = 64
NA_WIDTH = D_MODEL // 2
NA_HEADS = NA_WIDTH // HEAD_DIM
NA_ROWS = 8
NA_COLS = 16
CONV_CH = D_MODEL // 4
CONV_K = 3
FOURIER_WIDTH = D_MODEL - NA_WIDTH - CONV_CH
FOURIER_GROUPS = 4
FOURIER_GROUP_DIM = FOURIER_WIDTH // FOURIER_GROUPS
IN_WIDTH = 3 * NA_WIDTH + 3 * CONV_CH + FOURIER_WIDTH
N_EXPERTS = 16
CAPACITY_FACTOR = 2
EXPERT_HIDDEN = 256 * (-(-8 * D_MODEL // (3 * 256)))
N_MOD = 6
RMS_EPS = 1e-6
NEG_INF = -1e30

kernel_name = 'hybrid_na_conv_fourier_ec_block'


def rms_norm(x, g):
    xf = x.astype(jnp.float32)
    y = xf * lax.rsqrt(jnp.mean(xf * xf, axis=-1, keepdims=True) + RMS_EPS)
    return (y * g.astype(jnp.float32)).astype(x.dtype)


def group_rms(t):
    tf = t.astype(jnp.float32)
    return tf * lax.rsqrt(jnp.mean(tf * tf, axis=-1, keepdims=True) + RMS_EPS)


def modulate(h, shift, scale):
    return h * (1 + scale) + shift


def split_proj(p):
    b, n, _ = p.shape
    heads = lambda t: t.reshape(b, n, NA_HEADS, HEAD_DIM)
    q = heads(p[..., 0:NA_WIDTH])
    k = heads(p[..., NA_WIDTH:2 * NA_WIDTH])
    v = heads(p[..., 2 * NA_WIDTH:3 * NA_WIDTH])
    o = 3 * NA_WIDTH
    bg = p[..., o:o + CONV_CH]
    cg = p[..., o + CONV_CH:o + 2 * CONV_CH]
    u = p[..., o + 2 * CONV_CH:o + 3 * CONV_CH]
    f = p[..., o + 3 * CONV_CH:]
    return q, k, v, bg, cg, u, f


def neighbourhood_attention(q, k, v, k_ctx, v_ctx, rpb):
    b, n, h, dh = q.shape
    rows = n // GRID_W
    wr = min(NA_ROWS, rows)
    qg = q.reshape(b, rows, GRID_W, h, dh)
    kg = k.reshape(b, rows, GRID_W, h, dh)
    vg = v.reshape(b, rows, GRID_W, h, dh)
    r = jnp.arange(rows)
    row_start = jnp.clip(r - wr // 2, 0, rows - wr)
    row_idx = row_start[:, None] + jnp.arange(wr)[None, :]
    k_rows = kg[:, row_idx]
    v_rows = vg[:, row_idx]
    cols = jnp.arange(GRID_W)
    col_start = jnp.clip(cols - NA_COLS // 2, 0, GRID_W - NA_COLS)
    col_in = (cols[None, :] >= col_start[:, None]) & (cols[None, :] < col_start[:, None] + NA_COLS)
    dr = row_idx - r[:, None] + (NA_ROWS - 1)
    dc = jnp.clip(cols[None, :] - cols[:, None], -(NA_COLS - 1), NA_COLS - 1) + (NA_COLS - 1)
    bias = rpb[:, dr[:, None, :, None], dc[None, :, None, :]]
    scale = HEAD_DIM ** -0.5
    s_win = jnp.einsum('brqhd,brikhd->bhrqik', qg, k_rows, preferred_element_type=jnp.float32) * scale + bias
    s_win = jnp.where(col_in[:, None, :], s_win, NEG_INF)
    s_ctx = jnp.einsum('brqhd,bjhd->bhrqj', qg, k_ctx, preferred_element_type=jnp.float32) * scale
    n_win = wr * GRID_W
    s = jnp.concatenate([s_win.reshape(b, h, rows, GRID_W, n_win), s_ctx], axis=-1)
    p = jax.nn.softmax(s, axis=-1).astype(v.dtype)
    p_win = p[..., :n_win].reshape(b, h, rows, GRID_W, wr, GRID_W)
    p_ctx = p[..., n_win:]
    out = jnp.einsum('bhrqik,brikhd->brqhd', p_win, v_rows) + jnp.einsum('bhrqj,bjhd->brqhd', p_ctx, v_ctx)
    return out.reshape(b, n, h * dh)


def context_attention(q, k, v):
    b, l, h, dh = q.shape
    s = jnp.einsum('bihd,bjhd->bhij', q, k, preferred_element_type=jnp.float32) * (HEAD_DIM ** -0.5)
    p = jax.nn.softmax(s, axis=-1).astype(v.dtype)
    return jnp.einsum('bhij,bjhd->bihd', p, v).reshape(b, l, h * dh)


def short_gated_conv(bg, cg, u, w):
    z = cg * u
    zc = lax.conv_general_dilated(z, w[:, None, :], window_strides=(1,),
                                  padding=[(CONV_K // 2, CONV_K // 2)],
                                  dimension_numbers=('NWC', 'WIO', 'NWC'),
                                  feature_group_count=z.shape[-1])
    return bg * zc


def fourier_mix(f):
    b, n, _ = f.shape
    fg = f.reshape(b, n, FOURIER_GROUPS, FOURIER_GROUP_DIM).astype(jnp.float32)
    y = jnp.fft.fft2(fg, axes=(1, 3), norm='ortho').real
    return y.reshape(b, n, FOURIER_WIDTH).astype(f.dtype)


def merge_groups(na, cv, fo, g_mix_out, w_out):
    y = jnp.concatenate([group_rms(na), group_rms(cv), group_rms(fo)], axis=-1) * g_mix_out.astype(jnp.float32)
    return y.astype(na.dtype) @ w_out


def expert_choice_ffn(h, w_router, w_gate, w_up, w_down):
    b, n, d = h.shape
    cap = CAPACITY_FACTOR * n // N_EXPERTS
    aff = jax.nn.softmax((h @ w_router).astype(jnp.float32), axis=-1)
    gates, idx = lax.top_k(jnp.swapaxes(aff, 1, 2), cap)
    xs = jax.vmap(lambda hb, ib: hb[ib])(h, idx)
    hid = jax.nn.silu(jnp.einsum('becd,edf->becf', xs, w_gate)) * jnp.einsum('becd,edf->becf', xs, w_up)
    out = jnp.einsum('becf,efd->becd', hid, w_down) * gates[..., None].astype(h.dtype)
    return jax.vmap(lambda ib, ob: jnp.zeros((n, d), h.dtype).at[ib.reshape(-1)].add(ob.reshape(-1, d)))(idx, out)


def hybrid_layer(x, ctx, mod_x, mod_c, g_pre_mix, g_post_mix, g_pre_ffn, g_post_ffn,
                 w_in, rpb, conv_w, g_mix_out, w_out, w_router, w_gate, w_up, w_down, ctx_out):
    sh1, sc1, g1, sh2, sc2, g2 = [t[:, None, :] for t in jnp.split(mod_x, N_MOD, axis=-1)]
    sh1c, sc1c, g1c, sh2c, sc2c, g2c = [t[None, None, :] for t in jnp.split(mod_c, N_MOD, axis=-1)]
    h = modulate(rms_norm(x, g_pre_mix), sh1, sc1)
    hc = modulate(rms_norm(ctx, g_pre_mix), sh1c, sc1c)
    q, k, v, bg, cg, u, f = split_proj(h @ w_in)
    qc, kc, vc, bgc, cgc, uc, fc = split_proj(hc @ w_in)
    na = neighbourhood_attention(q, k, v, kc, vc, rpb)
    cv = short_gated_conv(bg, cg, u, conv_w)
    fo = fourier_mix(f)
    x = x + g1 * rms_norm(merge_groups(na, cv, fo, g_mix_out, w_out), g_post_mix)
    h2 = modulate(rms_norm(x, g_pre_ffn), sh2, sc2)
    x = x + g2 * rms_norm(expert_choice_ffn(h2, w_router, w_gate, w_up, w_down), g_post_ffn)
    if ctx_out:
        na_c = context_attention(qc, kc, vc)
        cv_c = short_gated_conv(bgc, cgc, uc, conv_w)
        fo_c = fourier_mix(fc)
        ctx = ctx + g1c * rms_norm(merge_groups(na_c, cv_c, fo_c, g_mix_out, w_out), g_post_mix)
        h2c = modulate(rms_norm(ctx, g_pre_ffn), sh2c, sc2c)
        ctx = ctx + g2c * rms_norm(expert_choice_ffn(h2c, w_router, w_gate, w_up, w_down), g_post_ffn)
    return x, ctx


def setup_inputs(seed: int = 0) -> dict:
    key = jax.random.key(seed)
    ks = jax.random.split(key, 20)
    d = D_MODEL
    nrm = lambda k, shape, s: jax.random.normal(k, shape, jnp.float32) * s
    return {
        'x': nrm(ks[0], (BATCH, SEQ, d), 1.0),
        'c': nrm(ks[1], (BATCH, d), 1.0),
        'ctx': nrm(ks[2], (BATCH, CTX_LEN, d), 1.0),
        'c_ctx': nrm(ks[3], (d,), 1.0),
        'w_mod': nrm(ks[4], (DEPTH, d, N_MOD * d), 0.5 * d ** -0.5),
        'b_mod': nrm(ks[5], (DEPTH, N_MOD * d), 0.02),
        'g_pre_mix': 1.0 + nrm(ks[6], (DEPTH, d), 0.05),
        'g_post_mix': 1.0 + nrm(ks[7], (DEPTH, d), 0.05),
        'g_pre_ffn': 1.0 + nrm(ks[8], (DEPTH, d), 0.05),
        'g_post_ffn': 1.0 + nrm(ks[9], (DEPTH, d), 0.05),
        'w_in': nrm(ks[10], (DEPTH, d, IN_WIDTH), d ** -0.5),
        'rpb': nrm(ks[11], (DEPTH, NA_HEADS, 2 * NA_ROWS - 1, 2 * NA_COLS - 1), 0.1),
        'conv_w': nrm(ks[12], (DEPTH, CONV_K, CONV_CH), CONV_K ** -0.5),
        'g_mix_out': 1.0 + nrm(ks[13], (DEPTH, d), 0.05),
        'w_out': nrm(ks[14], (DEPTH, d, d), d ** -0.5),
        'w_router': nrm(ks[15], (DEPTH, d, N_EXPERTS), d ** -0.5),
        'w_gate': nrm(ks[16], (DEPTH, N_EXPERTS, d, EXPERT_HIDDEN), d ** -0.5),
        'w_up': nrm(ks[17], (DEPTH, N_EXPERTS, d, EXPERT_HIDDEN), d ** -0.5),
        'w_down': nrm(ks[18], (DEPTH, N_EXPERTS, EXPERT_HIDDEN, d), EXPERT_HIDDEN ** -0.5),
    }


def reference(x, c, ctx, c_ctx, w_mod, b_mod, g_pre_mix, g_post_mix, g_pre_ffn, g_post_ffn,
              w_in, rpb, conv_w, g_mix_out, w_out, w_router, w_gate, w_up, w_down):
    silu_c = jax.nn.silu(c)
    silu_cc = jax.nn.silu(c_ctx)
    for layer in range(DEPTH):
        mod_x = silu_c @ w_mod[layer] + b_mod[layer]
        mod_c = silu_cc @ w_mod[layer] + b_mod[layer]
        x, ctx = hybrid_layer(x, ctx, mod_x, mod_c, g_pre_mix[layer], g_post_mix[layer],
                              g_pre_ffn[layer], g_post_ffn[layer], w_in[layer], rpb[layer],
                              conv_w[layer], g_mix_out[layer], w_out[layer], w_router[layer],
                              w_gate[layer], w_up[layer], w_down[layer], layer < DEPTH - 1)
    return x
```

```cpp
#include <hip/hip_runtime.h>
#include <cstdio>
#include <cstdint>
namespace pg8 {
#define PG8_LAS __attribute__((address_space(3)))
typedef unsigned short bf16_t;
typedef short bf16x8 __attribute__((ext_vector_type(8)));
typedef float f32x4 __attribute__((ext_vector_type(4)));
typedef unsigned u32x4 __attribute__((ext_vector_type(4)));
constexpr int BM = 256, BK = 64, HALF = 128, HTB = HALF * BK * 2  , STAGE_BYTES = 8 * HTB, NXCD = 8, WGM = 8;

__host__ __device__ __forceinline__ int lds_byte(int r, int c) { const int st = (r >> 4) * 2 + (c >> 5), rr = r & 15, cc = c & 31, ob = rr * 64 + cc * 2; return st * 1024 + (ob ^ (((ob >> 9) & 1) << 5)); }
__host__ __device__ __forceinline__ void stage_rc(int b, int& R, int& C) { const int st = b / 1024, sb = b % 1024, swz = sb ^ (((sb >> 9) & 1) << 5); R = (st >> 1) * 16 + swz / 64; C = (st & 1) * 32 + (swz % 64) / 2; }
__host__ __device__ __forceinline__ int perm32(int rho) { const int n = rho >> 4, i = rho & 15; return 8 * (i >> 2) + 4 * n + (i & 3); }

struct Unit { int pm, pn; };
struct Gemm { const bf16_t* A; const bf16_t* Bt; int M, N, K; };

struct StaticOrder {
    int nM, nN, nwg, G, c;
    __host__ __device__ void init(int M, int N, int G_, int c_) { nM = M / BM; nN = N / BM; nwg = nM * nN; G = G_; c = c_; }
    __host__ __device__ bool next(int i, Unit& u) const {
        const long L = (long)i * G + c; if (L >= nwg) return false;
        int wgid = (int)L; { const int q = nwg / NXCD, r = nwg % NXCD, xcd = wgid % NXCD, off = wgid / NXCD; wgid = (xcd < r ? xcd * (q + 1) : r * (q + 1) + (xcd - r) * q) + off; }
        const int nig = WGM * nN, gid = wgid / nig, fm = gid * WGM, gsz = (nM - fm) < WGM ? (nM - fm) : WGM;
        u.pm = fm + ((wgid % nig) % gsz); u.pn = (wgid % nig) / gsz; return true;
    }
    __device__ __forceinline__ void a_ready(const Unit&) const {}
    __device__ __forceinline__ void done(const Unit&) const {}
};

__device__ __forceinline__ unsigned cvt_pk_bf16(float lo, float hi) { unsigned r; asm volatile("v_cvt_pk_bf16_f32 %0, %1, %2" : "=v"(r) : "v"(lo), "v"(hi)); return r; }
struct TileOrder {
    int nM, nN, nwg, G, c;
    __device__ void init(int nM_, int nN_, int G_, int c_) { nM = nM_; nN = nN_; nwg = nM * nN; G = G_; c = c_; }
    __device__ bool next(int i, Unit& u) const {
        int wgid;
        if ((G & 7) == 0) { const int per = G >> 3; wgid = (i * 8 + (c & 7)) * per + (c >> 3); } else wgid = i * G + c;
        if (wgid >= nwg) return false;
        const int nig = WGM * nN, gid = wgid / nig, fm = gid * WGM, gsz = (nM - fm) < WGM ? (nM - fm) : WGM;
        u.pm = fm + ((wgid % nig) % gsz); u.pn = (wgid % nig) / gsz; return true;
    }
    __device__ __forceinline__ void a_ready(const Unit&) const {}
    __device__ __forceinline__ void done(const Unit&) const {}
};
struct GroupOrder {
    int nE, nMt, strideM, nNt, nwg, G, c;
    __device__ void init(int nE_, int nMt_, int strideM_, int nNt_, int G_, int c_) { nE = nE_; nMt = nMt_; strideM = strideM_; nNt = nNt_; nwg = nE * nMt * nNt; G = G_; c = c_; }
    __device__ bool next(int i, Unit& u) const {
        int wgid;
        if ((G & 7) == 0) { const int per = G >> 3; wgid = (i * 8 + (c & 7)) * per + (c >> 3); } else wgid = i * G + c;
        if (wgid >= nwg) return false;
        const int per_e = nMt * nNt, e = wgid / per_e, r = wgid % per_e, jn = r / nMt, im = r % nMt;
        u.pm = e * strideM + im; u.pn = e * nNt + jn; return true;
    }
    __device__ __forceinline__ void a_ready(const Unit&) const {}
    __device__ __forceinline__ void done(const Unit&) const {}
};
struct EpiBf16Map {
    static constexpr bool PERM = true, AFTER_DRAIN = false;
    bf16_t* O; int ldc; int pn_mod;
    __device__ __forceinline__ void operator()(const f32x4 (&acc)[2][2][4][2], const Unit& u, int wr, int wc, int fr, int fq) const {
        const int row0 = u.pm * BM + wr * 64 + fr, col0 = (u.pn % pn_mod) * BM + wc * 32 + 8 * fq;
#pragma unroll
        for (int ai = 0; ai < 2; ++ai)
#pragma unroll
            for (int m = 0; m < 4; ++m) { bf16_t* rowp = O + (size_t)(row0 + ai * HALF + m * 16) * ldc + col0;
#pragma unroll
                for (int bj = 0; bj < 2; ++bj) { const f32x4 v0 = acc[ai][bj][m][0], v1 = acc[ai][bj][m][1];
                    u32x4 w; w.x = cvt_pk_bf16(v0[0], v0[1]); w.y = cvt_pk_bf16(v0[2], v0[3]); w.z = cvt_pk_bf16(v1[0], v1[1]); w.w = cvt_pk_bf16(v1[2], v1[3]);
                    *(u32x4*)(rowp + bj * HALF) = w; } }
    }
};
struct EpiF32 {
    static constexpr bool PERM = false, AFTER_DRAIN = false;
    float* O; int ldc;
    __device__ __forceinline__ void operator()(const f32x4 (&acc)[2][2][4][2], const Unit& u, int wr, int wc, int fr, int fq) const {
        const int row0 = u.pm * BM + wr * 64 + fr, col0 = u.pn * BM + wc * 32 + 4 * fq;
#pragma unroll
        for (int ai = 0; ai < 2; ++ai)
#pragma unroll
            for (int m = 0; m < 4; ++m) { float* rowp = O + (size_t)(row0 + ai * HALF + m * 16) * ldc + col0;
#pragma unroll
                for (int bj = 0; bj < 2; ++bj)
#pragma unroll
                    for (int n = 0; n < 2; ++n) *(f32x4*)(rowp + bj * HALF + n * 16) = acc[ai][bj][m][n]; }
    }
};
__device__ __forceinline__ float silu_f(float g) { return g * __builtin_amdgcn_rcpf(1.0f + __builtin_amdgcn_exp2f(-1.4426950408889634f * g)); }
struct EpiSwiGLU {
    static constexpr bool PERM = true, AFTER_DRAIN = false;
    bf16_t* O; int ldc; int pn_mod;
    __device__ __forceinline__ void operator()(const f32x4 (&acc)[2][2][4][2], const Unit& u, int wr, int wc, int fr, int fq) const {
        const int row0 = u.pm * BM + wr * 64 + fr, col0 = (u.pn % pn_mod) * HALF + wc * 32 + 8 * fq;
#pragma unroll
        for (int ai = 0; ai < 2; ++ai)
#pragma unroll
            for (int m = 0; m < 4; ++m) { bf16_t* rowp = O + (size_t)(row0 + ai * HALF + m * 16) * ldc + col0;
                const f32x4 g0 = acc[ai][0][m][0], g1 = acc[ai][0][m][1], u0 = acc[ai][1][m][0], u1 = acc[ai][1][m][1];
                u32x4 w; w.x = cvt_pk_bf16(silu_f(g0[0]) * u0[0], silu_f(g0[1]) * u0[1]); w.y = cvt_pk_bf16(silu_f(g0[2]) * u0[2], silu_f(g0[3]) * u0[3]);
                w.z = cvt_pk_bf16(silu_f(g1[0]) * u1[0], silu_f(g1[1]) * u1[1]); w.w = cvt_pk_bf16(silu_f(g1[2]) * u1[2], silu_f(g1[3]) * u1[3]);
                *(u32x4*)rowp = w; }
    }
};
template <class Epi, class Sched, bool ALIGN_EPI = false, bool SP2 = false>
__device__ __forceinline__ void gemm_phase(PG8_LAS unsigned char* lds, const Gemm g, const Sched& S, const Epi& E) {
    int tid_ = threadIdx.x; asm volatile("" : "+v"(tid_));
    const int tid = tid_, wid = __builtin_amdgcn_readfirstlane(tid >> 6), lane = tid & 63, wr = wid >> 2, wc = wid & 3, fr = lane & 15, fq = lane >> 4;
    const int K = g.K, nt = K / BK;
    unsigned voffA[2], voffB[2];
#pragma unroll
    for (int i = 0; i < 2; ++i) { int R, C; stage_rc(tid * 16 + i * 8192, R, C); const int Rb = Epi::PERM ? ((R & ~31) + perm32(R & 31)) : R;
        voffA[i] = (unsigned)(R * K + C) * 2u; voffB[i] = (unsigned)(Rb * K + C) * 2u; }
    const size_t kstep = (size_t)(BK * 2);
    const size_t hstep = (size_t)HALF * K * 2;
    const size_t tstep = 2 * hstep;
    const unsigned ldsw = (unsigned)wid * 1024u;
    const int aoff = lds_byte(wr * 64 + fr, fq * 8), boff = lds_byte(wc * 32 + fr, fq * 8);
#define PG8_SA(b, h) (((b) * 2 + (h)) * HTB)
#define PG8_SB(b, h) ((4 + (b) * 2 + (h)) * HTB)
#define PG8_STAGE(bufoff, gbase, voff) do { _Pragma("unroll") for (int _i = 0; _i < 2; ++_i) \
        __builtin_amdgcn_global_load_lds((const unsigned*)((const char*)(gbase) + (voff)[_i]), (PG8_LAS unsigned*)(lds + (bufoff) + ldsw + _i * 8192), 16, 0, 0); } while (0)
#define PG8_LDA(dst, b, h) do { _Pragma("unroll") for (int m = 0; m < 4; ++m) _Pragma("unroll") for (int k = 0; k < 2; ++k) dst[m][k] = *(const PG8_LAS bf16x8*)(lds + PG8_SA(b, h) + aoff + m * 2048 + k * 1024); } while (0)
#define PG8_LDB(dst, b, h) do { _Pragma("unroll") for (int n = 0; n < 2; ++n) _Pragma("unroll") for (int k = 0; k < 2; ++k) dst[n][k] = *(const PG8_LAS bf16x8*)(lds + PG8_SB(b, h) + boff + n * 2048 + k * 1024); } while (0)
#define PG8_MMA(ai, bj, At, Bt) do { __builtin_amdgcn_s_setprio(1); _Pragma("unroll") for (int m = 0; m < 4; ++m) _Pragma("unroll") for (int n = 0; n < 2; ++n) _Pragma("unroll") for (int k = 0; k < 2; ++k) \
        acc[ai][bj][m][n] = __builtin_amdgcn_mfma_f32_16x16x32_bf16(Bt[n][k], At[m][k], acc[ai][bj][m][n], 0, 0, 0); __builtin_amdgcn_s_setprio(0); } while (0)
#define PG8_WAIT_V(n) asm volatile("s_waitcnt vmcnt(" #n ")" ::: "memory")
#define PG8_WAIT_L(n) asm volatile("s_waitcnt lgkmcnt(" #n ")" ::: "memory")
#define PG8_BAR __builtin_amdgcn_s_barrier()
#define PG8_SCHED __builtin_amdgcn_sched_barrier(0)
    Unit cur, nxt; int ui = 0;
    if (!S.next(0, cur)) return;
    f32x4 acc[2][2][4][2];
#pragma unroll
    for (int a = 0; a < 2; ++a)
#pragma unroll
        for (int b = 0; b < 2; ++b)
#pragma unroll
            for (int m = 0; m < 4; ++m)
#pragma unroll
                for (int n = 0; n < 2; ++n) acc[a][b][m][n] = (f32x4){0.f, 0.f, 0.f, 0.f};
    bf16x8 At[4][2], B0[2][2], B1[2][2];
    const char* cA = (const char*)g.A + (size_t)cur.pm * tstep; const char* cB = (const char*)g.Bt + (size_t)cur.pn * tstep;
    S.a_ready(cur);
    if constexpr (SP2) {
        PG8_STAGE(PG8_SB(0, 0), cB, voffB); PG8_STAGE(PG8_SB(0, 1), cB + hstep, voffB); PG8_STAGE(PG8_SA(0, 0), cA, voffA); PG8_STAGE(PG8_SA(0, 1), cA + hstep, voffA);
        if (wr == 1) PG8_BAR;
        PG8_WAIT_V(2); PG8_BAR;
        PG8_STAGE(PG8_SB(1, 0), cB + kstep, voffB); PG8_STAGE(PG8_SA(1, 0), cA + kstep, voffA); PG8_STAGE(PG8_SB(1, 1), cB + hstep + kstep, voffB);
        PG8_WAIT_V(6); PG8_BAR;
    } else {
        PG8_STAGE(PG8_SB(0, 0), cB, voffB); PG8_STAGE(PG8_SA(0, 0), cA, voffA); PG8_STAGE(PG8_SB(0, 1), cB + hstep, voffB); PG8_STAGE(PG8_SA(0, 1), cA + hstep, voffA);
        if (wr == 1) PG8_BAR;
        PG8_WAIT_V(4); PG8_BAR;
        PG8_STAGE(PG8_SB(1, 0), cB + kstep, voffB); PG8_STAGE(PG8_SA(1, 0), cA + kstep, voffA); PG8_STAGE(PG8_SB(1, 1), cB + hstep + kstep, voffB);
        PG8_WAIT_V(6); PG8_BAR;
    }
    for (;;) {
        const bool has_next = S.next(ui + 1, nxt);
        const char* nA = has_next ? (const char*)g.A + (size_t)nxt.pm * tstep : cA; const char* nB = has_next ? (const char*)g.Bt + (size_t)nxt.pn * tstep : cB;
        for (int t = 0; t < nt; t += 2) {
            const bool last = (t == nt - 2);
            const char* a1 = cA + (size_t)(t + 1) * kstep;
            const char* a2 = last ? nA : cA + (size_t)(t + 2) * kstep; const char* b2 = last ? nB : cB + (size_t)(t + 2) * kstep;
            const char* a3 = a2 + kstep; const char* b3 = b2 + kstep;
            if (last && has_next) S.a_ready(nxt);
            if constexpr (SP2) {
            PG8_LDB(B0, 0, 0); PG8_LDB(B1, 0, 1); PG8_SCHED; PG8_LDA(At, 0, 0); PG8_STAGE(PG8_SA(1, 1), a1 + hstep, voffA);
            PG8_WAIT_V(8); PG8_WAIT_L(0); PG8_BAR; PG8_MMA(0, 0, At, B0); PG8_MMA(0, 1, At, B1); PG8_BAR; PG8_SCHED;
            PG8_LDA(At, 0, 1); PG8_STAGE(PG8_SB(0, 0), b2, voffB); PG8_STAGE(PG8_SB(0, 1), b2 + hstep, voffB); PG8_STAGE(PG8_SA(0, 0), a2, voffA);
            PG8_WAIT_V(8); PG8_WAIT_L(0); PG8_BAR; PG8_MMA(1, 0, At, B0); PG8_MMA(1, 1, At, B1); PG8_BAR; PG8_SCHED;
            PG8_LDB(B0, 1, 0); PG8_LDB(B1, 1, 1); PG8_SCHED; PG8_LDA(At, 1, 0); PG8_STAGE(PG8_SA(0, 1), a2 + hstep, voffA);
            PG8_WAIT_V(8); PG8_WAIT_L(0); PG8_BAR; PG8_MMA(0, 0, At, B0); PG8_MMA(0, 1, At, B1); PG8_BAR; PG8_SCHED;
            PG8_LDA(At, 1, 1); PG8_STAGE(PG8_SB(1, 0), b3, voffB); PG8_STAGE(PG8_SB(1, 1), b3 + hstep, voffB); PG8_STAGE(PG8_SA(1, 0), a3, voffA);
            PG8_WAIT_V(8); PG8_WAIT_L(0); PG8_BAR; PG8_MMA(1, 0, At, B0); PG8_MMA(1, 1, At, B1); PG8_BAR; PG8_SCHED;
            } else {
            PG8_LDB(B0, 0, 0); PG8_SCHED; PG8_LDA(At, 0, 0); PG8_STAGE(PG8_SA(1, 1), a1 + hstep, voffA);
            PG8_WAIT_L(8); PG8_BAR; PG8_WAIT_L(0); PG8_MMA(0, 0, At, B0); PG8_BAR; PG8_SCHED;
            PG8_LDB(B1, 0, 1); PG8_STAGE(PG8_SB(0, 0), b2, voffB);
            PG8_BAR; PG8_WAIT_L(0); PG8_MMA(0, 1, At, B1); PG8_BAR;
            PG8_LDA(At, 0, 1); PG8_STAGE(PG8_SA(0, 0), a2, voffA);
            PG8_BAR; PG8_WAIT_L(0); PG8_MMA(1, 0, At, B0); PG8_BAR; PG8_SCHED;
            PG8_STAGE(PG8_SB(0, 1), b2 + hstep, voffB);
            PG8_WAIT_V(6); PG8_BAR; PG8_MMA(1, 1, At, B1); PG8_BAR;
            PG8_LDB(B0, 1, 0); PG8_SCHED; PG8_LDA(At, 1, 0); PG8_STAGE(PG8_SA(0, 1), a2 + hstep, voffA);
            PG8_WAIT_L(8); PG8_BAR; PG8_WAIT_L(0); PG8_MMA(0, 0, At, B0); PG8_BAR; PG8_SCHED;
            PG8_LDB(B1, 1, 1); PG8_STAGE(PG8_SB(1, 0), b3, voffB);
            PG8_BAR; PG8_WAIT_L(0); PG8_MMA(0, 1, At, B1); PG8_BAR;
            PG8_LDA(At, 1, 1); PG8_STAGE(PG8_SA(1, 0), a3, voffA);
            PG8_BAR; PG8_WAIT_L(0); PG8_MMA(1, 0, At, B0); PG8_BAR; PG8_SCHED;
            PG8_STAGE(PG8_SB(1, 1), b3 + hstep, voffB);
            PG8_WAIT_V(6); PG8_BAR; PG8_MMA(1, 1, At, B1); PG8_BAR;
            }
        }
        if constexpr (ALIGN_EPI) { if (wr == 0) PG8_BAR; }
        if constexpr (!Epi::AFTER_DRAIN) { E(acc, cur, wr, wc, fr, fq); S.done(cur); }
        if (!has_next) break;
#pragma unroll
        for (int a = 0; a < 2; ++a)
#pragma unroll
            for (int b = 0; b < 2; ++b)
#pragma unroll
                for (int m = 0; m < 4; ++m)
#pragma unroll
                    for (int n = 0; n < 2; ++n) acc[a][b][m][n] = (f32x4){0.f, 0.f, 0.f, 0.f};
        cur = nxt; cA = nA; cB = nB; ++ui;
        if constexpr (ALIGN_EPI) { if (wr == 1) PG8_BAR; }
    }
    PG8_WAIT_V(0);
    if constexpr (!ALIGN_EPI) { if (wr == 0) PG8_BAR; }
    PG8_BAR;
    if constexpr (Epi::AFTER_DRAIN) { E.fused(acc, cur, wr, wc, fr, fq, lds, wid, lane); S.done(cur); }
#undef PG8_SA
#undef PG8_SB
#undef PG8_STAGE
#undef PG8_LDA
#undef PG8_LDB
#undef PG8_MMA
#undef PG8_WAIT_V
#undef PG8_WAIT_L
#undef PG8_BAR
#undef PG8_SCHED
}
}
constexpr int NB = 4, SEQ = 4096, D = 1024, CTXL = 256, DEPTH = 2, GRIDW = 64, NROWS = 64;
constexpr int MX = NB * SEQ, MC = NB * CTXL, MT = MX + MC;
constexpr int NIN = 2560, NE = 16, FH = 2816, CAPX = 512, CAPC = 32, NMOD = 6;
constexpr int EROWS = 2304;
constexpr int ETILES = EROWS / 256, FNT = FH / 128;
constexpr int PQ = 0, PK = 512, PV = 1024, PBG = 1536, PCG = 1792, PU = 2048, PF = 2304;
constexpr float RMS_EPS = 1e-6f;
constexpr int NWAVES = 8;

constexpr size_t MiB = 1u << 20;
constexpr size_t WS_CTL = 0, CTL_ZERO_BYTES = 1 * MiB;
constexpr size_t WS_MODX = 64 * 1024;
constexpr size_t WS_WINT = 2 * MiB;
constexpr size_t WS_WOUTT = 12 * MiB;
constexpr size_t WS_WGUT = 16 * MiB;
constexpr size_t WS_WDT = 368 * MiB;
constexpr size_t WS_H = 544 * MiB;
constexpr size_t WS_P = 578 * MiB;
constexpr size_t WS_NA = 663 * MiB;
constexpr size_t WS_FO = 680 * MiB;
constexpr size_t WS_TT = 697 * MiB;
constexpr size_t WS_Y = 729 * MiB;
constexpr size_t WS_MO = 763 * MiB;
constexpr size_t WS_HID = 578 * MiB;
constexpr size_t WS_X1 = 831 * MiB;
constexpr size_t WS_X2 = 899 * MiB;
constexpr size_t WS_H2 = 967 * MiB;
constexpr size_t WS_AFF = 1001 * MiB;
constexpr size_t WS_SLOT = 1003 * MiB;
constexpr size_t WS_XS = 1005 * MiB;
constexpr size_t WS_YE = 1077 * MiB;
constexpr size_t WS_END = 1149 * MiB;
static_assert(WS_HID + (size_t)NE * EROWS * FH * 2 <= WS_X1, "HID overlay");
static_assert(WS_MODX + (size_t)DEPTH * 5 * NMOD * D * 4 <= CTL_ZERO_BYTES, "MODX inside memset region");
constexpr int CW_BAR = 4096;

constexpr int RING_OFF = 0, RING_BYTES = 131072;
constexpr int LDSCTL_OFF = RING_BYTES, MISC_OFF = LDSCTL_OFF + 320;
constexpr int TW64_OFF = LDSCTL_OFF + 512, TW256_OFF = LDSCTL_OFF + 1024;
constexpr int LDS_BYTES = 147456;
#define GAS __attribute__((address_space(1)))
#define LAS __attribute__((address_space(3)))
typedef unsigned short bf16;
typedef unsigned v4u __attribute__((ext_vector_type(4)));
typedef float f32x4 __attribute__((ext_vector_type(4)));
typedef short bf16x8 __attribute__((ext_vector_type(8)));
typedef GAS unsigned gu32;
typedef GAS unsigned long long gu64;
#define RLX_AGENT __ATOMIC_RELAXED, __HIP_MEMORY_SCOPE_AGENT
#define LDS_WAIT() asm volatile("s_waitcnt lgkmcnt(0)" ::: "memory")
#define VM_WAIT() asm volatile("s_waitcnt vmcnt(0)" ::: "memory")
__device__ __forceinline__ unsigned long long rt() { return __builtin_amdgcn_s_memrealtime(); }
__device__ __forceinline__ unsigned f2bf(float f) { unsigned u = __builtin_bit_cast(unsigned, f); return (u + 0x7fffu + ((u >> 16) & 1u)) >> 16; }
__device__ __forceinline__ unsigned pk2(float lo, float hi) { return f2bf(lo) | (f2bf(hi) << 16); }

#define XB_TMO      128
#define XB_XCNT(j)  (256  + 64 * (j))
#define XB_XSUB(j)  (1280 + 64 * (j))
#define XB_XGEN(j)  (2304 + 64 * (j))
#define XB_TOP      3328
#define XB_TOPGEN   3392
#define XCD_BAR_WORDS 3456
#define XB_SPIN_CAP (1u << 18)

__device__ __forceinline__ unsigned xb_ld(unsigned* p)              { return __hip_atomic_load(p, __ATOMIC_RELAXED, __HIP_MEMORY_SCOPE_AGENT); }
__device__ __forceinline__ unsigned xb_add(unsigned* p, unsigned v) { return __hip_atomic_fetch_add(p, v, __ATOMIC_RELAXED, __HIP_MEMORY_SCOPE_AGENT); }
__device__ __forceinline__ unsigned xb_xcc_id() { return (unsigned)__builtin_amdgcn_s_getreg((3 << 11) | 20) & 0xFu; }
#define XB_SPIN(cond, bar) do { unsigned _sp = 0; while (cond) { __builtin_amdgcn_s_sleep(1); \
    if ((++_sp & 255u) == 0u) { if (xb_ld(&(bar)[XB_TMO])) break; if (_sp > XB_SPIN_CAP) { atomicAdd(&(bar)[XB_TMO], 1u); break; } } } } while (0)

struct XcdBarrier {
    unsigned* bar; unsigned x;
    volatile LAS unsigned* st;
};

__device__ __forceinline__ XcdBarrier xcd_barrier_post(unsigned* bar, volatile LAS unsigned* st) {
    XcdBarrier b; b.bar = bar; b.x = xb_xcc_id(); b.st = st;
    if (threadIdx.x == 0) (void)xb_add(&bar[XB_XCNT(b.x)], 1u);
    return b;
}
__device__ __forceinline__ void xcd_barrier_complete(unsigned* bar, unsigned x, unsigned& nloc, unsigned& nx) {
    const unsigned G = gridDim.x * gridDim.y * gridDim.z;
    unsigned sum, cnt, mine, sp = 0u;
    for (;;) {
        sum = 0u; cnt = 0u; mine = 0u;
#pragma unroll
        for (unsigned j = 0; j < 16; ++j) { const unsigned c = xb_ld(&bar[XB_XCNT(j)]); sum += c; cnt += (c > 0u) ? 1u : 0u; mine = (j == x) ? c : mine; }
        if (sum == G) break;
        __builtin_amdgcn_s_sleep(1);
        if ((++sp & 255u) == 0u) { if (xb_ld(&bar[XB_TMO])) break; if (sp > XB_SPIN_CAP) { atomicAdd(&bar[XB_TMO], 1u); break; } }
    }
    nloc = mine > 0u ? mine : 1u; nx = cnt > 0u ? cnt : 1u;
}

__device__ __forceinline__ void xcd_barrier(const XcdBarrier& b) {
    asm volatile("s_waitcnt vmcnt(0)" ::: "memory");
    __syncthreads();
    if (threadIdx.x == 0) {
        unsigned* bar = b.bar;
        __builtin_amdgcn_s_waitcnt(0);
        unsigned nloc = b.st[0], nx = b.st[1];
        if (nloc == 0u) { xcd_barrier_complete(bar, b.x, nloc, nx); b.st[0] = nloc; b.st[1] = nx; }
        const unsigned old = xb_add(&bar[XB_XSUB(b.x)], 1u);
        const unsigned gen = old / nloc;
        if (old + 1u == (gen + 1u) * nloc) {
            __builtin_amdgcn_fence(__ATOMIC_RELEASE, "agent");
            asm volatile("s_waitcnt vmcnt(0)" ::: "memory");
            const unsigned og = xb_add(&bar[XB_TOP], 1u);
            const unsigned tg = og / nx;
            if (og + 1u == (tg + 1u) * nx) xb_add(&bar[XB_TOPGEN], 1u);
            else XB_SPIN(xb_ld(&bar[XB_TOPGEN]) == tg, bar);
            __builtin_amdgcn_fence(__ATOMIC_ACQUIRE, "agent");
            xb_add(&bar[XB_XGEN(b.x)], 1u);
            asm volatile("s_waitcnt vmcnt(0)" ::: "memory");
        } else {
            XB_SPIN(xb_ld(&bar[XB_XGEN(b.x)]) == gen, bar);
            __builtin_amdgcn_fence(__ATOMIC_ACQUIRE, "agent");
            asm volatile("s_waitcnt vmcnt(0)" ::: "memory");
        }
    }
    __syncthreads();
}
typedef LAS float lfloat;
typedef float f32x2 __attribute__((ext_vector_type(2)));
typedef unsigned u32x2 __attribute__((ext_vector_type(2)));
__device__ __forceinline__ float bflo(unsigned w) { return __uint_as_float(w << 16); }
__device__ __forceinline__ float bfhi(unsigned w) { return __uint_as_float(w & 0xffff0000u); }
__device__ __forceinline__ float bf2f(bf16 h) { return __uint_as_float((unsigned)h << 16); }
__device__ __forceinline__ float wave_sum(float v) {
#pragma unroll
    for (int o = 1; o < 64; o <<= 1) v += __shfl_xor(v, o);
    return v;
}
__device__ __forceinline__ float wave_max(float v) {
#pragma unroll
    for (int o = 1; o < 64; o <<= 1) v = fmaxf(v, __shfl_xor(v, o));
    return v;
}
__device__ __forceinline__ float silu(float x) { return x / (1.0f + __expf(-x)); }

struct Ctx {
    unsigned char* ws; LAS unsigned char* lds;
    int tid, lane, wave, G, gw, NGW;
};
#define IN_X 0
#define IN_C 1
#define IN_CTX 2
#define IN_CCTX 3
#define IN_WMOD 4
#define IN_BMOD 5
#define IN_GPREMIX 6
#define IN_GPOSTMIX 7
#define IN_GPREFFN 8
#define IN_GPOSTFFN 9
#define IN_WIN 10
#define IN_RPB 11
#define IN_CONVW 12
#define IN_GMIXOUT 13
#define IN_WOUT 14
#define IN_WROUTER 15
#define IN_WGATE 16
#define IN_WUP 17
#define IN_WDOWN 18

__device__ __forceinline__ int mod_row(int row) { return row < MX ? (row >> 12) : 4; }
__device__ __forceinline__ const float* modx(const Ctx& C, int layer, int mr, int which) { return (const float*)(C.ws + WS_MODX) + ((size_t)(layer * 5 + mr) * NMOD + which) * D; }

__device__ __forceinline__ void transpose_item(const float* W, int K, int N, bf16* WT, int item, int mode, lfloat* scr, int lane) {
    const int nblk = N / 32, kb = item / nblk, nb = item % nblk, k0 = 64 * kb, n0 = 32 * nb;
#pragma unroll 8
    for (int i = 0; i < 32; ++i) { const int kk = 2 * i + (lane >> 5); scr[kk * 33 + (lane & 31)] = W[(size_t)(k0 + kk) * N + n0 + (lane & 31)]; }
    LDS_WAIT(); asm volatile("" ::: "memory");
    const int rowbase = mode == 0 ? n0 : ((n0 >> 7) * 256 + (n0 & 127) + (mode == 2 ? 128 : 0));
    const int c = lane & 7;
#pragma unroll
    for (int j = 0; j < 4; ++j) { const int n = (lane >> 3) + 8 * j; const lfloat* s = scr + (8 * c) * 33 + n;
        v4u o; o.x = pk2(s[0 * 33], s[1 * 33]); o.y = pk2(s[2 * 33], s[3 * 33]); o.z = pk2(s[4 * 33], s[5 * 33]); o.w = pk2(s[6 * 33], s[7 * 33]);
        *(GAS v4u*)(WT + (size_t)(rowbase + n) * K + k0 + 8 * c) = o; }
    LDS_WAIT(); asm volatile("" ::: "memory");
}
constexpr int IT_WIN = (D / 64) * (NIN / 32), IT_WOUT = (D / 64) * (D / 32), IT_GU = (D / 64) * (FH / 32), IT_DN = (FH / 64) * (D / 32);
constexpr int N_T_ITEMS = DEPTH * IT_WIN + DEPTH * IT_WOUT + DEPTH * NE * (2 * IT_GU + IT_DN);
__device__ __forceinline__ void p0_prologue(const Ctx& C, const float* const (&in)[19]) {
    {
        lfloat* part = (lfloat*)(C.lds + RING_OFF);
        for (int it = blockIdx.x; it < DEPTH * (NMOD * D / 64); it += C.G) {
            const int l = it / (NMOD * D / 64), cb = it % (NMOD * D / 64), col = cb * 64 + C.lane;
            const float* wm = in[IN_WMOD] + (size_t)l * D * NMOD * D + col;
            float acc[5] = {0.f, 0.f, 0.f, 0.f, 0.f};
#pragma unroll 8
            for (int k = C.wave * 128; k < C.wave * 128 + 128; ++k) {
                const float wv = wm[(size_t)k * (NMOD * D)];
#pragma unroll
                for (int r = 0; r < 4; ++r) acc[r] += silu(in[IN_C][r * D + k]) * wv;
                acc[4] += silu(in[IN_CCTX][k]) * wv;
            }
#pragma unroll
            for (int r = 0; r < 5; ++r) part[(C.wave * 5 + r) * 64 + C.lane] = acc[r];
            __syncthreads();
            if (C.wave < 5) { const int r = C.wave; float sum = in[IN_BMOD][l * NMOD * D + col];
#pragma unroll
                for (int w = 0; w < 8; ++w) sum += part[(w * 5 + r) * 64 + C.lane];
                ((float*)(C.ws + WS_MODX))[(size_t)(l * 5 + r) * NMOD * D + col] = sum; }
            __syncthreads();
        }
    }
    lfloat* scr = (lfloat*)(C.lds + RING_OFF + C.wave * 16384);
    bf16* WINT = (bf16*)(C.ws + WS_WINT); bf16* WOUTT = (bf16*)(C.ws + WS_WOUTT); bf16* WGUT = (bf16*)(C.ws + WS_WGUT); bf16* WDT = (bf16*)(C.ws + WS_WDT);
    for (int it = C.gw; it < N_T_ITEMS; it += C.NGW) {
        int r = it;
        if (r < DEPTH * IT_WIN) { const int l = r / IT_WIN; transpose_item(in[IN_WIN] + (size_t)l * D * NIN, D, NIN, WINT + (size_t)l * NIN * D, r % IT_WIN, 0, scr, C.lane); continue; } r -= DEPTH * IT_WIN;
        if (r < DEPTH * IT_WOUT) { const int l = r / IT_WOUT; transpose_item(in[IN_WOUT] + (size_t)l * D * D, D, D, WOUTT + (size_t)l * D * D, r % IT_WOUT, 0, scr, C.lane); continue; } r -= DEPTH * IT_WOUT;
        if (r < DEPTH * NE * IT_GU) { const int le = r / IT_GU; transpose_item(in[IN_WGATE] + (size_t)le * D * FH, D, FH, WGUT + (size_t)le * 2 * FH * D, r % IT_GU, 1, scr, C.lane); continue; } r -= DEPTH * NE * IT_GU;
        if (r < DEPTH * NE * IT_GU) { const int le = r / IT_GU; transpose_item(in[IN_WUP] + (size_t)le * D * FH, D, FH, WGUT + (size_t)le * 2 * FH * D, r % IT_GU, 2, scr, C.lane); continue; } r -= DEPTH * NE * IT_GU;
        { const int le = r / IT_DN; transpose_item(in[IN_WDOWN] + (size_t)le * FH * D, FH, D, WDT + (size_t)le * D * FH, r % IT_DN, 0, scr, C.lane); }
    }
}

__device__ __forceinline__ void norm_mod_store(const f32x4 (&v)[4], float ss, const float* g, const float* sh, const float* sc, bf16* orow, int lane) {
    const float rstd = 1.0f / sqrtf(ss * (1.f / D) + RMS_EPS);
#pragma unroll
    for (int j = 0; j < 4; ++j) {
        const f32x4 gg = ((const f32x4*)g)[lane + 64 * j], hh = ((const f32x4*)sh)[lane + 64 * j], cc = ((const f32x4*)sc)[lane + 64 * j];
        const f32x4 o = (v[j] * rstd * gg) * (cc + 1.0f) + hh;
        u32x2 w; w.x = pk2(o.x, o.y); w.y = pk2(o.z, o.w);
        ((u32x2*)orow)[lane + 64 * j] = w;
    }
}
__device__ __forceinline__ void p1_h0(const Ctx& C, const float* const (&in)[19]) {
    bf16* H = (bf16*)(C.ws + WS_H);
    for (int row = C.gw; row < MT; row += C.NGW) {
        const float* xr = row < MX ? in[IN_X] + (size_t)row * D : in[IN_CTX] + (size_t)(row - MX) * D;
        f32x4 v[4]; float ss = 0.f;
#pragma unroll
        for (int j = 0; j < 4; ++j) { v[j] = ((const f32x4*)xr)[C.lane + 64 * j]; ss += (v[j].x * v[j].x + v[j].y * v[j].y) + (v[j].z * v[j].z + v[j].w * v[j].w); }
        ss = wave_sum(ss);
        const int mr = mod_row(row);
        norm_mod_store(v, ss, in[IN_GPREMIX], modx(C, 0, mr, 0), modx(C, 0, mr, 1), H + (size_t)row * D, C.lane);
    }
}
__device__ __forceinline__ float dot64(const float (&q)[64], const bf16* krow) {
    const v4u* p = (const v4u*)krow; float a = 0.f;
#pragma unroll
    for (int t = 0; t < 8; ++t) { const v4u w = p[t];
        a += q[8 * t + 0] * bflo(w.x) + q[8 * t + 1] * bfhi(w.x) + q[8 * t + 2] * bflo(w.y) + q[8 * t + 3] * bfhi(w.y)
           + q[8 * t + 4] * bflo(w.z) + q[8 * t + 5] * bfhi(w.z) + q[8 * t + 6] * bflo(w.w) + q[8 * t + 7] * bfhi(w.w); }
    return a;
}
__device__ __forceinline__ void axpy64(float (&o)[64], float p, const bf16* vrow) {
    const v4u* pp = (const v4u*)vrow;
#pragma unroll
    for (int t = 0; t < 8; ++t) { const v4u w = pp[t];
        o[8 * t + 0] += p * bflo(w.x); o[8 * t + 1] += p * bfhi(w.x); o[8 * t + 2] += p * bflo(w.y); o[8 * t + 3] += p * bfhi(w.y);
        o[8 * t + 4] += p * bflo(w.z); o[8 * t + 5] += p * bfhi(w.z); o[8 * t + 6] += p * bflo(w.w); o[8 * t + 7] += p * bfhi(w.w); }
}
__device__ __forceinline__ void attn_key(const float (&q)[64], float (&o)[64], float& m, float& l, float bias, const bf16* P, int key, int head) {
    const float s = dot64(q, P + (size_t)key * NIN + PK + head * 64) + bias;
    if (s > m) { const float alpha = __expf(m - s); l *= alpha;
#pragma unroll
        for (int d = 0; d < 64; ++d) o[d] *= alpha;
        m = s; }
    const float p = __expf(s - m); l += p;
    axpy64(o, p, P + (size_t)key * NIN + PV + head * 64);
}
__device__ __forceinline__ void p_attn_naive(const Ctx& C, const float* const (&in)[19], int layer) {
    const bf16* P = (const bf16*)(C.ws + WS_P); bf16* NA = (bf16*)(C.ws + WS_NA);
    const float* rpb = in[IN_RPB] + (size_t)layer * 8 * 15 * 31;
    const int nitems = layer == 0 ? 2048 + 128 : 2048;
    for (int id = C.gw; id < nitems; id += C.NGW) {
        const bool isctx = id >= 2048;
        int b, h, r = 0, c = 0, qrow;
        if (!isctx) { b = id >> 9; r = (id >> 3) & 63; h = id & 7; c = C.lane; qrow = b * SEQ + r * 64 + c; }
        else { const int j = id - 2048; b = j >> 5; h = (j >> 2) & 7; qrow = MX + b * CTXL + (j & 3) * 64 + C.lane; }
        float q[64], o[64];
        { const v4u* p = (const v4u*)(P + (size_t)qrow * NIN + PQ + h * 64);
#pragma unroll
          for (int t = 0; t < 8; ++t) { const v4u w = p[t];
              q[8 * t + 0] = 0.125f * bflo(w.x); q[8 * t + 1] = 0.125f * bfhi(w.x); q[8 * t + 2] = 0.125f * bflo(w.y); q[8 * t + 3] = 0.125f * bfhi(w.y);
              q[8 * t + 4] = 0.125f * bflo(w.z); q[8 * t + 5] = 0.125f * bfhi(w.z); q[8 * t + 6] = 0.125f * bflo(w.w); q[8 * t + 7] = 0.125f * bfhi(w.w); } }
#pragma unroll
        for (int d = 0; d < 64; ++d) o[d] = 0.f;
        float m = -1e30f, l = 0.f;
        if (!isctx) {
            const int rs = min(max(r - 4, 0), NROWS - 8), cs = min(max(c - 8, 0), GRIDW - 16);
            for (int kr = 0; kr < 8; ++kr) {
                const float* bp = rpb + (size_t)h * 465 + (rs + kr - r + 7) * 31 + 15;
#pragma unroll 1
                for (int i = 0; i < 16; ++i) { const int dc = min(max(cs + i - c, -15), 15); attn_key(q, o, m, l, bp[dc], P, b * SEQ + (rs + kr) * 64 + cs + i, h); }
            }
        }
#pragma unroll 1
        for (int j = 0; j < CTXL; ++j) attn_key(q, o, m, l, 0.f, P, MX + b * CTXL + j, h);
        const float inv = 1.0f / l;
        v4u* op = (v4u*)(NA + (size_t)qrow * 512 + h * 64);
#pragma unroll
        for (int t = 0; t < 8; ++t) { v4u w; w.x = pk2(o[8 * t] * inv, o[8 * t + 1] * inv); w.y = pk2(o[8 * t + 2] * inv, o[8 * t + 3] * inv);
            w.z = pk2(o[8 * t + 4] * inv, o[8 * t + 5] * inv); w.w = pk2(o[8 * t + 6] * inv, o[8 * t + 7] * inv); op[t] = w; }
    }
}

__device__ __forceinline__ void p_fft_a(const Ctx& C) {
    const bf16* P = (const bf16*)(C.ws + WS_P); f32x2* TT = (f32x2*)(C.ws + WS_TT);
    lfloat* scr = (lfloat*)(C.lds + RING_OFF + C.wave * 16384);
    LAS unsigned* gscr = (LAS unsigned*)scr;
    const LAS f32x2* tw64 = (const LAS f32x2*)(C.lds + TW64_OFF);
    const int lane = C.lane;
    if (C.gw >= NB * 4 * 64) return;
    for (int id = C.gw; id < NB * 4 * 64; id += C.NGW) {
        const int b = id >> 8, g = (id >> 6) & 3, n2 = id & 63;
#pragma unroll
        for (int it = 0; it < 8; ++it) { const int n1 = it * 8 + (lane >> 3), c0 = (lane & 7) * 8;
            const v4u w = *(const v4u*)(P + (size_t)(b * SEQ + 64 * n1 + n2) * NIN + PF + g * 64 + c0);
            lfloat* d = scr + n1 * 64 + c0;
            d[0] = bflo(w.x); d[1] = bfhi(w.x); d[2] = bflo(w.y); d[3] = bfhi(w.y); d[4] = bflo(w.z); d[5] = bfhi(w.z); d[6] = bflo(w.w); d[7] = bfhi(w.w); }
        LDS_WAIT(); asm volatile("" ::: "memory");
#pragma unroll 1
        for (int n1 = 0; n1 < 64; ++n1) {
            float gr = 0.f, gi = 0.f;
#pragma unroll 8
            for (int c = 0; c < 64; ++c) { const float fv = scr[n1 * 64 + c]; const f32x2 t = tw64[(lane * c) & 63]; gr += fv * t.x; gi -= fv * t.y; }
            LDS_WAIT(); asm volatile("" ::: "memory");
            gscr[n1 * 64 + lane] = pk2(gr, gi);
        }
        LDS_WAIT(); asm volatile("" ::: "memory");
#pragma unroll 1
        for (int k1 = 0; k1 < 64; ++k1) {
            float tr = 0.f, ti = 0.f; int idx = 0;
#pragma unroll 8
            for (int n1 = 0; n1 < 64; ++n1) { const unsigned gp = gscr[n1 * 64 + lane]; const float gr = bflo(gp), gi = bfhi(gp); const f32x2 w = tw64[idx]; idx = (idx + k1) & 63;
                tr += w.x * gr + w.y * gi; ti += w.x * gi - w.y * gr; }
            float sn, cs; sincospif((float)(k1 * n2) * (1.0f / 2048.0f), &sn, &cs);
            TT[((size_t)((b * 4 + g) * 64 + k1) * 64 + n2) * 64 + lane] = (f32x2){cs * tr + sn * ti, cs * ti - sn * tr};
        }
        LDS_WAIT(); asm volatile("" ::: "memory");
    }
}
__device__ __forceinline__ void p_fft_b(const Ctx& C) {
    const f32x2* TT = (const f32x2*)(C.ws + WS_TT); float* FO = (float*)(C.ws + WS_FO);
    const LAS f32x2* tw64 = (const LAS f32x2*)(C.lds + TW64_OFF);
    const int lane = C.lane;
    for (int id = C.gw; id < NB * 4 * 64; id += C.NGW) {
        const int b = id >> 8, g = (id >> 6) & 3, k1 = id & 63;
        float Tr[64], Ti[64];
#pragma unroll
        for (int n2 = 0; n2 < 64; ++n2) { const f32x2 t = TT[((size_t)((b * 4 + g) * 64 + k1) * 64 + n2) * 64 + lane]; Tr[n2] = t.x; Ti[n2] = t.y; }
        for (int k2 = 0; k2 < 64; ++k2) {
            float a = 0.f;
#pragma unroll
            for (int n2 = 0; n2 < 64; ++n2) { const f32x2 w = tw64[(k2 * n2) & 63]; a += w.x * Tr[n2] + w.y * Ti[n2]; }
            FO[(size_t)(b * SEQ + k1 + 64 * k2) * 256 + g * 64 + lane] = a * (1.0f / 512.0f);
        }
    }
}
__device__ __forceinline__ void p_fft_ctx(const Ctx& C) {
    const bf16* P = (const bf16*)(C.ws + WS_P); float* FO = (float*)(C.ws + WS_FO);
    const LAS f32x2* tw64 = (const LAS f32x2*)(C.lds + TW64_OFF); const LAS f32x2* tw256 = (const LAS f32x2*)(C.lds + TW256_OFF);
    const int lane = C.lane;
    for (int id = C.gw; id < NB * 4 * 16; id += C.NGW) {
        const int b = id >> 6, g = (id >> 4) & 3, kc = id & 15;
        float acc[16];
#pragma unroll
        for (int kk = 0; kk < 16; ++kk) acc[kk] = 0.f;
        for (int n = 0; n < CTXL; ++n) {
            const bf16* fr = P + (size_t)(MX + b * CTXL + n) * NIN + PF + g * 64;
            float gr = 0.f, gi = 0.f;
#pragma unroll 8
            for (int c = 0; c < 64; ++c) { const float fv = bf2f(fr[c]); const f32x2 t = tw64[(lane * c) & 63]; gr += fv * t.x; gi -= fv * t.y; }
#pragma unroll
            for (int kk = 0; kk < 16; ++kk) { const f32x2 t = tw256[((kc * 16 + kk) * n) & 255]; acc[kk] += t.x * gr + t.y * gi; }
        }
#pragma unroll
        for (int kk = 0; kk < 16; ++kk) FO[(size_t)(MX + b * CTXL + kc * 16 + kk) * 256 + g * 64 + lane] = acc[kk] * (1.0f / 128.0f);
    }
}

__device__ __forceinline__ void p_merge(const Ctx& C, const float* const (&in)[19], int layer) {
    const bf16* P = (const bf16*)(C.ws + WS_P); const bf16* NA = (const bf16*)(C.ws + WS_NA); const float* FO = (const float*)(C.ws + WS_FO); bf16* Y = (bf16*)(C.ws + WS_Y);
    const float* cw = in[IN_CONVW] + (size_t)layer * 3 * 256; const float* gm = in[IN_GMIXOUT] + (size_t)layer * D;
    const int nrows = layer == 0 ? MT : MX, lane = C.lane;
    for (int row = C.gw; row < nrows; row += C.NGW) {
        const bool isctx = row >= MX; const int slen = isctx ? CTXL : SEQ, pos = isctx ? ((row - MX) & (CTXL - 1)) : (row & (SEQ - 1));
        float na[8]; { const v4u w = *(const v4u*)(NA + (size_t)row * 512 + 8 * lane);
            na[0] = bflo(w.x); na[1] = bfhi(w.x); na[2] = bflo(w.y); na[3] = bfhi(w.y); na[4] = bflo(w.z); na[5] = bfhi(w.z); na[6] = bflo(w.w); na[7] = bfhi(w.w); }
        float s_na = 0.f;
#pragma unroll
        for (int i = 0; i < 8; ++i) s_na += na[i] * na[i];
        const bf16* pr = P + (size_t)row * NIN;
        float z[3][4];
#pragma unroll
        for (int dk = 0; dk < 3; ++dk) { const int pp = pos + dk - 1; const bool ok = pp >= 0 && pp < slen;
            const bf16* pq = pr + (ptrdiff_t)(dk - 1) * NIN;
            u32x2 cg = (u32x2){0u, 0u}, uu = (u32x2){0u, 0u};
            if (ok) { cg = *(const u32x2*)(pq + PCG + 4 * lane); uu = *(const u32x2*)(pq + PU + 4 * lane); }
            z[dk][0] = bflo(cg.x) * bflo(uu.x); z[dk][1] = bfhi(cg.x) * bfhi(uu.x); z[dk][2] = bflo(cg.y) * bflo(uu.y); z[dk][3] = bfhi(cg.y) * bfhi(uu.y); }
        const u32x2 bgw = *(const u32x2*)(pr + PBG + 4 * lane);
        const f32x4 w0 = *(const f32x4*)(cw + 4 * lane), w1 = *(const f32x4*)(cw + 256 + 4 * lane), w2 = *(const f32x4*)(cw + 512 + 4 * lane);
        float cv[4];
        cv[0] = bflo(bgw.x) * (w0.x * z[0][0] + w1.x * z[1][0] + w2.x * z[2][0]); cv[1] = bfhi(bgw.x) * (w0.y * z[0][1] + w1.y * z[1][1] + w2.y * z[2][1]);
        cv[2] = bflo(bgw.y) * (w0.z * z[0][2] + w1.z * z[1][2] + w2.z * z[2][2]); cv[3] = bfhi(bgw.y) * (w0.w * z[0][3] + w1.w * z[1][3] + w2.w * z[2][3]);
        float s_cv = cv[0] * cv[0] + cv[1] * cv[1] + cv[2] * cv[2] + cv[3] * cv[3];
        const f32x4 fo = *(const f32x4*)(FO + (size_t)row * 256 + 4 * lane);
        float s_fo = fo.x * fo.x + fo.y * fo.y + fo.z * fo.z + fo.w * fo.w;
        s_na = wave_sum(s_na); s_cv = wave_sum(s_cv); s_fo = wave_sum(s_fo);
        const float r_na = 1.0f / sqrtf(s_na * (1.f / 512.f) + RMS_EPS), r_cv = 1.0f / sqrtf(s_cv * (1.f / 256.f) + RMS_EPS), r_fo = 1.0f / sqrtf(s_fo * (1.f / 256.f) + RMS_EPS);
        bf16* yr = Y + (size_t)row * D;
        { const f32x4 g0 = *(const f32x4*)(gm + 8 * lane), g1 = *(const f32x4*)(gm + 8 * lane + 4);
          v4u w; w.x = pk2(na[0] * r_na * g0.x, na[1] * r_na * g0.y); w.y = pk2(na[2] * r_na * g0.z, na[3] * r_na * g0.w);
          w.z = pk2(na[4] * r_na * g1.x, na[5] * r_na * g1.y); w.w = pk2(na[6] * r_na * g1.z, na[7] * r_na * g1.w); *(v4u*)(yr + 8 * lane) = w; }
        { const f32x4 g0 = *(const f32x4*)(gm + 512 + 4 * lane); u32x2 w; w.x = pk2(cv[0] * r_cv * g0.x, cv[1] * r_cv * g0.y); w.y = pk2(cv[2] * r_cv * g0.z, cv[3] * r_cv * g0.w); *(u32x2*)(yr + 512 + 4 * lane) = w; }
        { const f32x4 g0 = *(const f32x4*)(gm + 768 + 4 * lane); u32x2 w; w.x = pk2(fo.x * r_fo * g0.x, fo.y * r_fo * g0.y); w.y = pk2(fo.z * r_fo * g0.z, fo.w * r_fo * g0.w); *(u32x2*)(yr + 768 + 4 * lane) = w; }
    }
}
__device__ __forceinline__ const float* xin_row(const Ctx& C, const float* const (&in)[19], int layer, int row) {
    if (layer == 0) return row < MX ? in[IN_X] + (size_t)row * D : in[IN_CTX] + (size_t)(row - MX) * D;
    return (const float*)(C.ws + WS_X2) + (size_t)row * D;
}
__device__ __forceinline__ void p_postmix(const Ctx& C, const float* const (&in)[19], int layer) {
    const float* MO = (const float*)(C.ws + WS_MO); float* X1 = (float*)(C.ws + WS_X1); bf16* H2 = (bf16*)(C.ws + WS_H2); float* AFF = (float*)(C.ws + WS_AFF);
    const float* gpost = in[IN_GPOSTMIX] + (size_t)layer * D; const float* gpre = in[IN_GPREFFN] + (size_t)layer * D; const float* wr = in[IN_WROUTER] + (size_t)layer * D * NE;
    const int nrows = layer == 0 ? MT : MX, lane = C.lane;
    for (int row = C.gw; row < nrows; row += C.NGW) {
        const int mr = mod_row(row);
        const float* g1 = modx(C, layer, mr, 2); const float* sh2 = modx(C, layer, mr, 3); const float* sc2 = modx(C, layer, mr, 4);
        const float* xr = xin_row(C, in, layer, row);
        f32x4 v[4]; float ss = 0.f;
#pragma unroll
        for (int j = 0; j < 4; ++j) { v[j] = ((const f32x4*)(MO + (size_t)row * D))[lane + 64 * j]; ss += (v[j].x * v[j].x + v[j].y * v[j].y) + (v[j].z * v[j].z + v[j].w * v[j].w); }
        ss = wave_sum(ss);
        const float r1 = 1.0f / sqrtf(ss * (1.f / D) + RMS_EPS);
        float ss2 = 0.f;
#pragma unroll
        for (int j = 0; j < 4; ++j) { const f32x4 xx = ((const f32x4*)xr)[lane + 64 * j], gg = ((const f32x4*)gpost)[lane + 64 * j], g1v = ((const f32x4*)g1)[lane + 64 * j];
            v[j] = xx + g1v * (v[j] * r1 * gg); ((f32x4*)(X1 + (size_t)row * D))[lane + 64 * j] = v[j];
            ss2 += (v[j].x * v[j].x + v[j].y * v[j].y) + (v[j].z * v[j].z + v[j].w * v[j].w); }
        ss2 = wave_sum(ss2);
        const float r2 = 1.0f / sqrtf(ss2 * (1.f / D) + RMS_EPS);
        float acc[NE];
#pragma unroll
        for (int e = 0; e < NE; ++e) acc[e] = 0.f;
#pragma unroll
        for (int j = 0; j < 4; ++j) {
            const f32x4 gg = ((const f32x4*)gpre)[lane + 64 * j], hh = ((const f32x4*)sh2)[lane + 64 * j], cc = ((const f32x4*)sc2)[lane + 64 * j];
            const f32x4 h = (v[j] * r2 * gg) * (cc + 1.0f) + hh;
            u32x2 w; w.x = pk2(h.x, h.y); w.y = pk2(h.z, h.w);
            ((u32x2*)(H2 + (size_t)row * D))[lane + 64 * j] = w;
            const float hv[4] = {h.x, h.y, h.z, h.w};
#pragma unroll
            for (int i = 0; i < 4; ++i) { const f32x4* wp = (const f32x4*)(wr + (size_t)(4 * (lane + 64 * j) + i) * NE);
#pragma unroll
                for (int q4 = 0; q4 < 4; ++q4) { const f32x4 ww = wp[q4]; acc[4 * q4] += hv[i] * ww.x; acc[4 * q4 + 1] += hv[i] * ww.y; acc[4 * q4 + 2] += hv[i] * ww.z; acc[4 * q4 + 3] += hv[i] * ww.w; } }
        }
        float mx = -1e30f;
#pragma unroll
        for (int e = 0; e < NE; ++e) { acc[e] = wave_sum(acc[e]); mx = fmaxf(mx, acc[e]); }
        float sum = 0.f;
#pragma unroll
        for (int e = 0; e < NE; ++e) { acc[e] = expf(acc[e] - mx); sum += acc[e]; }
        const float inv = 1.0f / sum;
        if (lane == 0) {
#pragma unroll
            for (int q4 = 0; q4 < 4; ++q4) ((f32x4*)(AFF + (size_t)row * NE))[q4] = (f32x4){acc[4 * q4] * inv, acc[4 * q4 + 1] * inv, acc[4 * q4 + 2] * inv, acc[4 * q4 + 3] * inv};
        }
    }
}

__device__ __forceinline__ void p_route(const Ctx& C, int layer) {
    const float* AFF = (const float*)(C.ws + WS_AFF); int* SLOT = (int*)(C.ws + WS_SLOT); const bf16* H2 = (const bf16*)(C.ws + WS_H2); bf16* XS = (bf16*)(C.ws + WS_XS);
    lfloat* vals = (lfloat*)(C.lds + RING_OFF); LAS int* list = (LAS int*)(C.lds + RING_OFF + 16384); LAS int* cnt = (LAS int*)(C.lds + RING_OFF + 16384 + 8192);
    const int nitems = layer == 0 ? 256 + 64 : 256;
    for (int item = blockIdx.x; item < nitems; item += C.G) {
        int b, e, NT, rowbase, cap, tok0, ntok, xsbase;
        if (item < 256) { b = item >> 6; e = (item >> 2) & 15; NT = SEQ; rowbase = b * SEQ; cap = CAPX; tok0 = (item & 3) * 1024; ntok = 1024; xsbase = e * EROWS + b * CAPX; }
        else { const int j = item - 256; b = j >> 4; e = j & 15; NT = CTXL; rowbase = MX + b * CTXL; cap = CAPC; tok0 = 0; ntok = CTXL; xsbase = e * EROWS + NB * CAPX + b * CAPC; }
        for (int t = C.tid; t < NT; t += NWAVES * 64) vals[t] = AFF[(size_t)(rowbase + t) * NE + e];
        if (C.tid == 0) *cnt = 0;
        __syncthreads();
        for (int tt = C.tid; tt < ntok; tt += NWAVES * 64) {
            const int t = tok0 + tt; const float v = vals[t]; int rank = 0;
            for (int t4 = 0; t4 < NT; t4 += 4) { const LAS f32x4* p4 = (const LAS f32x4*)(vals + t4); const f32x4 w = *p4;
                rank += (w.x > v || (w.x == v && t4 + 0 < t)) ? 1 : 0; rank += (w.y > v || (w.y == v && t4 + 1 < t)) ? 1 : 0;
                rank += (w.z > v || (w.z == v && t4 + 2 < t)) ? 1 : 0; rank += (w.w > v || (w.w == v && t4 + 3 < t)) ? 1 : 0; }
            if (rank < cap) { SLOT[(size_t)(rowbase + t) * NE + e] = rank; const int pos = atomicAdd((int*)cnt, 1); list[2 * pos] = t; list[2 * pos + 1] = rank; }
            else SLOT[(size_t)(rowbase + t) * NE + e] = -1;
        }
        __syncthreads();
        const int n = *cnt;
        for (int idx = C.wave; idx < n; idx += NWAVES) { const int t = list[2 * idx], rank = list[2 * idx + 1];
            const v4u* src = (const v4u*)(H2 + (size_t)(rowbase + t) * D); v4u* dst = (v4u*)(XS + (size_t)(xsbase + rank) * D);
            const v4u a = src[C.lane], c = src[C.lane + 64]; dst[C.lane] = a; dst[C.lane + 64] = c; }
        __syncthreads();
    }
}

__device__ __forceinline__ void p_combine(const Ctx& C, const float* const (&in)[19], float* out, int layer) {
    const float* AFF = (const float*)(C.ws + WS_AFF); const int* SLOT = (const int*)(C.ws + WS_SLOT); const bf16* YE = (const bf16*)(C.ws + WS_YE); const float* X1 = (const float*)(C.ws + WS_X1);
    float* XO = layer == 0 ? (float*)(C.ws + WS_X2) : out; bf16* H = (bf16*)(C.ws + WS_H);
    const float* gpost = in[IN_GPOSTFFN] + (size_t)layer * D;
    const int nrows = layer == 0 ? MT : MX, lane = C.lane;
    for (int row = C.gw; row < nrows; row += C.NGW) {
        const int mr = mod_row(row);
        const int ebase = row < MX ? (row >> 12) * CAPX : NB * CAPX + ((row - MX) >> 8) * CAPC;
        f32x4 a[4];
#pragma unroll
        for (int j = 0; j < 4; ++j) a[j] = (f32x4){0.f, 0.f, 0.f, 0.f};
        for (int e = 0; e < NE; ++e) {
            const int s = SLOT[(size_t)row * NE + e];
            if (s >= 0) { const float gt = AFF[(size_t)row * NE + e]; const u32x2* yr = (const u32x2*)(YE + (size_t)(e * EROWS + ebase + s) * D);
#pragma unroll
                for (int j = 0; j < 4; ++j) { const u32x2 w = yr[lane + 64 * j]; a[j].x += gt * bflo(w.x); a[j].y += gt * bfhi(w.x); a[j].z += gt * bflo(w.y); a[j].w += gt * bfhi(w.y); } }
        }
        float ss = 0.f;
#pragma unroll
        for (int j = 0; j < 4; ++j) ss += (a[j].x * a[j].x + a[j].y * a[j].y) + (a[j].z * a[j].z + a[j].w * a[j].w);
        ss = wave_sum(ss);
        const float r = 1.0f / sqrtf(ss * (1.f / D) + RMS_EPS);
        const float* g2 = modx(C, layer, mr, 5);
        float ss2 = 0.f;
#pragma unroll
        for (int j = 0; j < 4; ++j) { const f32x4 xx = ((const f32x4*)(X1 + (size_t)row * D))[lane + 64 * j], gg = ((const f32x4*)gpost)[lane + 64 * j], g2v = ((const f32x4*)g2)[lane + 64 * j];
            a[j] = xx + g2v * (a[j] * r * gg); ((f32x4*)(XO + (size_t)row * D))[lane + 64 * j] = a[j];
            ss2 += (a[j].x * a[j].x + a[j].y * a[j].y) + (a[j].z * a[j].z + a[j].w * a[j].w); }
        if (layer == 0) {
            ss2 = wave_sum(ss2);
            norm_mod_store(a, ss2, in[IN_GPREMIX] + D, modx(C, 1, mr, 0), modx(C, 1, mr, 1), H + (size_t)row * D, lane);
        }
    }
}
constexpr int NPH = 22;
#ifndef MK_PER_PHASE
#define MK_PER_PHASE 0
#endif
struct Args { const float* in[19]; float* out; unsigned char* ws; int ph_lo, ph_hi; };
__global__ void __launch_bounds__(NWAVES * 64, 2) mk_fwd(Args args) {
    extern __shared__ __attribute__((aligned(16))) unsigned char lds_raw[];
    Ctx C;
    C.ws = args.ws; C.lds = (LAS unsigned char*)lds_raw;
    C.tid = threadIdx.x; C.lane = C.tid & 63; C.wave = __builtin_amdgcn_readfirstlane(C.tid >> 6); C.G = gridDim.x;
    C.gw = blockIdx.x * NWAVES + C.wave; C.NGW = C.G * NWAVES;
    volatile LAS unsigned* MISC = (volatile LAS unsigned*)(C.lds + MISC_OFF);
    for (int u = C.tid; u < (512 - 0) / 4; u += NWAVES * 64) ((LAS unsigned*)(C.lds + LDSCTL_OFF))[u] = 0u;
    if (C.tid < 64) { float s, c; sincospif((float)C.tid * (1.0f / 32.0f), &s, &c); ((LAS f32x2*)(C.lds + TW64_OFF))[C.tid] = (f32x2){c, s}; }
    if (C.tid < 256) { float s, c; sincospif((float)C.tid * (1.0f / 128.0f), &s, &c); ((LAS f32x2*)(C.lds + TW256_OFF))[C.tid] = (f32x2){c, s}; }
    __syncthreads();
    gu32* ctl = (gu32*)(C.ws + WS_CTL);
    XcdBarrier bar = xcd_barrier_post((unsigned*)(ctl + CW_BAR), MISC + 8);
    const int lo = args.ph_lo, hi = args.ph_hi;
#ifndef DBG_MASK
#define DBG_MASK 0xffffffffu
#endif
#define PH_ON(k) (((DBG_MASK) >> (k)) & 1u)
#define IN(k) (lo <= (k) && (k) < hi)
#define SEAM(k) do { if (IN(k) && IN((k) + 1)) xcd_barrier(bar); } while (0)

    if (PH_ON(0) && IN(0)) p0_prologue(C, args.in);
    SEAM(0);
    if (PH_ON(1) && IN(1)) p1_h0(C, args.in);
    SEAM(1);
    for (int layer = 0; layer < DEPTH; ++layer) {
        const int pb = 2 + 10 * layer;
        Ctx L = C; asm volatile("" : "+v"(L.tid), "+v"(L.lane)); asm volatile("" : "+s"(L.wave), "+s"(L.gw));
        if (PH_ON(2) && IN(pb + 0)) {
            pg8::Gemm g{(const pg8::bf16_t*)(L.ws + WS_H), (const pg8::bf16_t*)(L.ws + WS_WINT) + (size_t)layer * NIN * D, MT, NIN, D};
            pg8::TileOrder S; S.init(MT / 256, NIN / 256, L.G, (int)blockIdx.x);
            pg8::EpiBf16Map E{(pg8::bf16_t*)(L.ws + WS_P), NIN, 1 << 30};
            pg8::gemm_phase<pg8::EpiBf16Map, pg8::TileOrder, true, true>(L.lds + RING_OFF, g, S, E);
        }
        SEAM(pb + 0);
        if (IN(pb + 1)) { if (PH_ON(3)) p_attn_naive(L, args.in, layer); if (PH_ON(4)) p_fft_a(L); if (PH_ON(5) && layer == 0) p_fft_ctx(L); }
        SEAM(pb + 1);
        if (PH_ON(6) && IN(pb + 2)) p_fft_b(L);
        SEAM(pb + 2);
        if (PH_ON(7) && IN(pb + 3)) p_merge(L, args.in, layer);
        SEAM(pb + 3);
        if (PH_ON(8) && IN(pb + 4)) {
            pg8::Gemm g{(const pg8::bf16_t*)(L.ws + WS_Y), (const pg8::bf16_t*)(L.ws + WS_WOUTT) + (size_t)layer * D * D, MT, D, D};
            pg8::TileOrder S; S.init((layer == 0 ? MT : MX) / 256, D / 256, L.G, (int)blockIdx.x);
            pg8::EpiF32 E{(float*)(L.ws + WS_MO), D};
            pg8::gemm_phase<pg8::EpiF32, pg8::TileOrder, true, true>(L.lds + RING_OFF, g, S, E);
        }
        SEAM(pb + 4);
        if (PH_ON(9) && IN(pb + 5)) p_postmix(L, args.in, layer);
        SEAM(pb + 5);
        if (PH_ON(10) && IN(pb + 6)) p_route(L, layer);
        SEAM(pb + 6);
        if (PH_ON(11) && IN(pb + 7)) {
            pg8::Gemm g{(const pg8::bf16_t*)(L.ws + WS_XS), (const pg8::bf16_t*)(L.ws + WS_WGUT) + (size_t)layer * NE * 2 * FH * D, NE * EROWS, NE * 2 * FH, D};
            pg8::GroupOrder S; S.init(NE, layer == 0 ? ETILES : ETILES - 1, ETILES, FNT, L.G, (int)blockIdx.x);
            pg8::EpiSwiGLU E{(pg8::bf16_t*)(L.ws + WS_HID), FH, FNT};
            pg8::gemm_phase<pg8::EpiSwiGLU, pg8::GroupOrder, true, true>(L.lds + RING_OFF, g, S, E);
        }
        SEAM(pb + 7);
        if (PH_ON(12) && IN(pb + 8)) {
            pg8::Gemm g{(const pg8::bf16_t*)(L.ws + WS_HID), (const pg8::bf16_t*)(L.ws + WS_WDT) + (size_t)layer * NE * D * FH, NE * EROWS, NE * D, FH};
            pg8::GroupOrder S; S.init(NE, layer == 0 ? ETILES : ETILES - 1, ETILES, D / 256, L.G, (int)blockIdx.x);
            pg8::EpiBf16Map E{(pg8::bf16_t*)(L.ws + WS_YE), D, D / 256};
            pg8::gemm_phase<pg8::EpiBf16Map, pg8::GroupOrder, true, true>(L.lds + RING_OFF, g, S, E);
        }
        SEAM(pb + 8);
        if (PH_ON(13) && IN(pb + 9)) p_combine(L, args.in, args.out, layer);
        SEAM(pb + 9);
    }
#undef IN
#undef SEAM
}

extern "C" void kernel_launch(void* const* d_in, const int* in_sizes, int n_in, void* d_out, int out_size, void* d_ws, size_t ws_size, hipStream_t stream) {
    static int grid = 0;
    if (grid == 0) {
        if (n_in != 19 || in_sizes[0] != MX * D || out_size != MX * D || ws_size < WS_END) { fprintf(stderr, "kernel_launch: unexpected shapes (n_in %d, in0 %d, out %d, ws %zu < %zu); nothing launched\n", n_in, n_in > 0 ? in_sizes[0] : -1, out_size, ws_size, (size_t)WS_END); grid = -1; return; }
        int dev = 0, cus = 0, per_cu = 0;
        if (hipGetDevice(&dev) != hipSuccess || hipDeviceGetAttribute(&cus, hipDeviceAttributeMultiprocessorCount, dev) != hipSuccess) { fprintf(stderr, "kernel_launch: device query failed\n"); grid = -1; return; }
        if (hipFuncSetAttribute((const void*)mk_fwd, hipFuncAttributeMaxDynamicSharedMemorySize, LDS_BYTES) != hipSuccess) { fprintf(stderr, "kernel_launch: hipFuncSetAttribute failed\n"); grid = -1; return; }
        if (hipOccupancyMaxActiveBlocksPerMultiprocessor(&per_cu, (const void*)mk_fwd, NWAVES * 64, LDS_BYTES) != hipSuccess || per_cu < 1)
            fprintf(stderr, "kernel_launch: note: occupancy query reports %d workgroups per CU\n", per_cu);
        (void)hipGetLastError();
        grid = cus;
    }
    if (grid < 0) return;
    if (hipMemsetAsync((char*)d_ws + WS_CTL, 0, CTL_ZERO_BYTES, stream) != hipSuccess) { fprintf(stderr, "kernel_launch: memset failed\n"); return; }
    Args a{};
    for (int i = 0; i < 19; ++i) a.in[i] = (const float*)d_in[i];
    a.out = (float*)d_out; a.ws = (unsigned char*)d_ws;
#if MK_PER_PHASE
    for (int ph = 0; ph < NPH; ++ph) { a.ph_lo = ph; a.ph_hi = ph + 1; hipLaunchKernelGGL(mk_fwd, dim3(grid), dim3(NWAVES * 64), LDS_BYTES, stream, a); }
#else
    a.ph_lo = 0; a.ph_hi = NPH;
    hipLaunchKernelGGL(mk_fwd, dim3(grid), dim3(NWAVES * 64), LDS_BYTES, stream, a);
#endif
    const hipError_t le = hipPeekAtLastError();
    if (le != hipSuccess) fprintf(stderr, "kernel_launch: launch failed: %s\n", hipGetErrorName(le));
}
```

```cpp
#include <hip/hip_runtime.h>
#include <cstdio>
#include <cstdint>
namespace pg8 {
#define PG8_LAS __attribute__((address_space(3)))
typedef unsigned short bf16_t;
typedef short bf16x8 __attribute__((ext_vector_type(8)));
typedef float f32x4 __attribute__((ext_vector_type(4)));
typedef unsigned u32x4 __attribute__((ext_vector_type(4)));
constexpr int BM = 256, BK = 64, HALF = 128, HTB = HALF * BK * 2  , STAGE_BYTES = 8 * HTB, NXCD = 8, WGM = 8;

__host__ __device__ __forceinline__ int lds_byte(int r, int c) { const int st = (r >> 4) * 2 + (c >> 5), rr = r & 15, cc = c & 31, ob = rr * 64 + cc * 2; return st * 1024 + (ob ^ (((ob >> 9) & 1) << 5)); }
__host__ __device__ __forceinline__ void stage_rc(int b, int& R, int& C) { const int st = b / 1024, sb = b % 1024, swz = sb ^ (((sb >> 9) & 1) << 5); R = (st >> 1) * 16 + swz / 64; C = (st & 1) * 32 + (swz % 64) / 2; }
__host__ __device__ __forceinline__ int perm32(int rho) { const int n = rho >> 4, i = rho & 15; return 8 * (i >> 2) + 4 * n + (i & 3); }

struct Unit { int pm, pn; };
struct Gemm { const bf16_t* A; const bf16_t* Bt; int M, N, K; };

struct StaticOrder {
    int nM, nN, nwg, G, c;
    __host__ __device__ void init(int M, int N, int G_, int c_) { nM = M / BM; nN = N / BM; nwg = nM * nN; G = G_; c = c_; }
    __host__ __device__ bool next(int i, Unit& u) const {
        const long L = (long)i * G + c; if (L >= nwg) return false;
        int wgid = (int)L; { const int q = nwg / NXCD, r = nwg % NXCD, xcd = wgid % NXCD, off = wgid / NXCD; wgid = (xcd < r ? xcd * (q + 1) : r * (q + 1) + (xcd - r) * q) + off; }
        const int nig = WGM * nN, gid = wgid / nig, fm = gid * WGM, gsz = (nM - fm) < WGM ? (nM - fm) : WGM;
        u.pm = fm + ((wgid % nig) % gsz); u.pn = (wgid % nig) / gsz; return true;
    }
    __device__ __forceinline__ void a_ready(const Unit&) const {}
    __device__ __forceinline__ void done(const Unit&) const {}
};

__device__ __forceinline__ unsigned cvt_pk_bf16(float lo, float hi) { unsigned r; asm volatile("v_cvt_pk_bf16_f32 %0, %1, %2" : "=v"(r) : "v"(lo), "v"(hi)); return r; }
struct TileOrder {
    int nM, nN, nwg, G, c;
    __device__ void init(int nM_, int nN_, int G_, int c_) { nM = nM_; nN = nN_; nwg = nM * nN; G = G_; c = c_; }
    __device__ bool next(int i, Unit& u) const {
        int wgid;
        if ((G & 7) == 0) { const int per = G >> 3; wgid = (i * 8 + (c & 7)) * per + (c >> 3); } else wgid = i * G + c;
        if (wgid >= nwg) return false;
        const int nig = WGM * nN, gid = wgid / nig, fm = gid * WGM, gsz = (nM - fm) < WGM ? (nM - fm) : WGM;
        u.pm = fm + ((wgid % nig) % gsz); u.pn = (wgid % nig) / gsz; return true;
    }
    __device__ __forceinline__ void a_ready(const Unit&) const {}
    __device__ __forceinline__ void done(const Unit&) const {}
};
struct GroupOrder {
    int nE, nMt, strideM, nNt, nwg, G, c;
    __device__ void init(int nE_, int nMt_, int strideM_, int nNt_, int G_, int c_) { nE = nE_; nMt = nMt_; strideM = strideM_; nNt = nNt_; nwg = nE * nMt * nNt; G = G_; c = c_; }
    __device__ bool next(int i, Unit& u) const {
        int wgid;
        if ((G & 7) == 0) { const int per = G >> 3; wgid = (i * 8 + (c & 7)) * per + (c >> 3); } else wgid = i * G + c;
        if (wgid >= nwg) return false;
        const int per_e = nMt * nNt, e = wgid / per_e, r = wgid % per_e, jn = r / nMt, im = r % nMt;
        u.pm = e * strideM + im; u.pn = e * nNt + jn; return true;
    }
    __device__ __forceinline__ void a_ready(const Unit&) const {}
    __device__ __forceinline__ void done(const Unit&) const {}
};
struct EpiBf16Map {
    static constexpr bool PERM = true, AFTER_DRAIN = false;
    bf16_t* O; int ldc; int pn_mod;
    __device__ __forceinline__ void operator()(const f32x4 (&acc)[2][2][4][2], const Unit& u, int wr, int wc, int fr, int fq) const {
        const int row0 = u.pm * BM + wr * 64 + fr, col0 = (u.pn % pn_mod) * BM + wc * 32 + 8 * fq;
#pragma unroll
        for (int ai = 0; ai < 2; ++ai)
#pragma unroll
            for (int m = 0; m < 4; ++m) { bf16_t* rowp = O + (size_t)(row0 + ai * HALF + m * 16) * ldc + col0;
#pragma unroll
                for (int bj = 0; bj < 2; ++bj) { const f32x4 v0 = acc[ai][bj][m][0], v1 = acc[ai][bj][m][1];
                    u32x4 w; w.x = cvt_pk_bf16(v0[0], v0[1]); w.y = cvt_pk_bf16(v0[2], v0[3]); w.z = cvt_pk_bf16(v1[0], v1[1]); w.w = cvt_pk_bf16(v1[2], v1[3]);
                    *(u32x4*)(rowp + bj * HALF) = w; } }
    }
};
struct EpiF32 {
    static constexpr bool PERM = false, AFTER_DRAIN = false;
    float* O; int ldc;
    __device__ __forceinline__ void operator()(const f32x4 (&acc)[2][2][4][2], const Unit& u, int wr, int wc, int fr, int fq) const {
        const int row0 = u.pm * BM + wr * 64 + fr, col0 = u.pn * BM + wc * 32 + 4 * fq;
#pragma unroll
        for (int ai = 0; ai < 2; ++ai)
#pragma unroll
            for (int m = 0; m < 4; ++m) { float* rowp = O + (size_t)(row0 + ai * HALF + m * 16) * ldc + col0;
#pragma unroll
                for (int bj = 0; bj < 2; ++bj)
#pragma unroll
                    for (int n = 0; n < 2; ++n) *(f32x4*)(rowp + bj * HALF + n * 16) = acc[ai][bj][m][n]; }
    }
};
__device__ __forceinline__ float silu_f(float g) { return g * __builtin_amdgcn_rcpf(1.0f + __builtin_amdgcn_exp2f(-1.4426950408889634f * g)); }
struct EpiSwiGLU {
    static constexpr bool PERM = true, AFTER_DRAIN = false;
    bf16_t* O; int ldc; int pn_mod;
    __device__ __forceinline__ void operator()(const f32x4 (&acc)[2][2][4][2], const Unit& u, int wr, int wc, int fr, int fq) const {
        const int row0 = u.pm * BM + wr * 64 + fr, col0 = (u.pn % pn_mod) * HALF + wc * 32 + 8 * fq;
#pragma unroll
        for (int ai = 0; ai < 2; ++ai)
#pragma unroll
            for (int m = 0; m < 4; ++m) { bf16_t* rowp = O + (size_t)(row0 + ai * HALF + m * 16) * ldc + col0;
                const f32x4 g0 = acc[ai][0][m][0], g1 = acc[ai][0][m][1], u0 = acc[ai][1][m][0], u1 = acc[ai][1][m][1];
                u32x4 w; w.x = cvt_pk_bf16(silu_f(g0[0]) * u0[0], silu_f(g0[1]) * u0[1]); w.y = cvt_pk_bf16(silu_f(g0[2]) * u0[2], silu_f(g0[3]) * u0[3]);
                w.z = cvt_pk_bf16(silu_f(g1[0]) * u1[0], silu_f(g1[1]) * u1[1]); w.w = cvt_pk_bf16(silu_f(g1[2]) * u1[2], silu_f(g1[3]) * u1[3]);
                *(u32x4*)rowp = w; }
    }
};
template <class Epi, class Sched, bool ALIGN_EPI = false, bool SP2 = false>
__device__ __forceinline__ void gemm_phase(PG8_LAS unsigned char* lds, const Gemm g, const Sched& S, const Epi& E) {
    int tid_ = threadIdx.x; asm volatile("" : "+v"(tid_));
    const int tid = tid_, wid = __builtin_amdgcn_readfirstlane(tid >> 6), lane = tid & 63, wr = wid >> 2, wc = wid & 3, fr = lane & 15, fq = lane >> 4;
    const int K = g.K, nt = K / BK;
    unsigned voffA[2], voffB[2];
#pragma unroll
    for (int i = 0; i < 2; ++i) { int R, C; stage_rc(tid * 16 + i * 8192, R, C); const int Rb = Epi::PERM ? ((R & ~31) + perm32(R & 31)) : R;
        voffA[i] = (unsigned)(R * K + C) * 2u; voffB[i] = (unsigned)(Rb * K + C) * 2u; }
    const size_t kstep = (size_t)(BK * 2);
    const size_t hstep = (size_t)HALF * K * 2;
    const size_t tstep = 2 * hstep;
    const unsigned ldsw = (unsigned)wid * 1024u;
    const int aoff = lds_byte(wr * 64 + fr, fq * 8), boff = lds_byte(wc * 32 + fr, fq * 8);
#define PG8_SA(b, h) (((b) * 2 + (h)) * HTB)
#define PG8_SB(b, h) ((4 + (b) * 2 + (h)) * HTB)
#define PG8_STAGE(bufoff, gbase, voff) do { _Pragma("unroll") for (int _i = 0; _i < 2; ++_i) \
        __builtin_amdgcn_global_load_lds((const unsigned*)((const char*)(gbase) + (voff)[_i]), (PG8_LAS unsigned*)(lds + (bufoff) + ldsw + _i * 8192), 16, 0, 0); } while (0)
#define PG8_LDA(dst, b, h) do { _Pragma("unroll") for (int m = 0; m < 4; ++m) _Pragma("unroll") for (int k = 0; k < 2; ++k) dst[m][k] = *(const PG8_LAS bf16x8*)(lds + PG8_SA(b, h) + aoff + m * 2048 + k * 1024); } while (0)
#define PG8_LDB(dst, b, h) do { _Pragma("unroll") for (int n = 0; n < 2; ++n) _Pragma("unroll") for (int k = 0; k < 2; ++k) dst[n][k] = *(const PG8_LAS bf16x8*)(lds + PG8_SB(b, h) + boff + n * 2048 + k * 1024); } while (0)
#define PG8_MMA(ai, bj, At, Bt) do { __builtin_amdgcn_s_setprio(1); _Pragma("unroll") for (int m = 0; m < 4; ++m) _Pragma("unroll") for (int n = 0; n < 2; ++n) _Pragma("unroll") for (int k = 0; k < 2; ++k) \
        acc[ai][bj][m][n] = __builtin_amdgcn_mfma_f32_16x16x32_bf16(Bt[n][k], At[m][k], acc[ai][bj][m][n], 0, 0, 0); __builtin_amdgcn_s_setprio(0); } while (0)
#define PG8_WAIT_V(n) asm volatile("s_waitcnt vmcnt(" #n ")" ::: "memory")
#define PG8_WAIT_L(n) asm volatile("s_waitcnt lgkmcnt(" #n ")" ::: "memory")
#define PG8_BAR __builtin_amdgcn_s_barrier()
#define PG8_SCHED __builtin_amdgcn_sched_barrier(0)
    Unit cur, nxt; int ui = 0;
    if (!S.next(0, cur)) return;
    f32x4 acc[2][2][4][2];
#pragma unroll
    for (int a = 0; a < 2; ++a)
#pragma unroll
        for (int b = 0; b < 2; ++b)
#pragma unroll
            for (int m = 0; m < 4; ++m)
#pragma unroll
                for (int n = 0; n < 2; ++n) acc[a][b][m][n] = (f32x4){0.f, 0.f, 0.f, 0.f};
    bf16x8 At[4][2], B0[2][2], B1[2][2];
    const char* cA = (const char*)g.A + (size_t)cur.pm * tstep; const char* cB = (const char*)g.Bt + (size_t)cur.pn * tstep;
    S.a_ready(cur);
    if constexpr (SP2) {
        PG8_STAGE(PG8_SB(0, 0), cB, voffB); PG8_STAGE(PG8_SB(0, 1), cB + hstep, voffB); PG8_STAGE(PG8_SA(0, 0), cA, voffA); PG8_STAGE(PG8_SA(0, 1), cA + hstep, voffA);
        if (wr == 1) PG8_BAR;
        PG8_WAIT_V(2); PG8_BAR;
        PG8_STAGE(PG8_SB(1, 0), cB + kstep, voffB); PG8_STAGE(PG8_SA(1, 0), cA + kstep, voffA); PG8_STAGE(PG8_SB(1, 1), cB + hstep + kstep, voffB);
        PG8_WAIT_V(6); PG8_BAR;
    } else {
        PG8_STAGE(PG8_SB(0, 0), cB, voffB); PG8_STAGE(PG8_SA(0, 0), cA, voffA); PG8_STAGE(PG8_SB(0, 1), cB + hstep, voffB); PG8_STAGE(PG8_SA(0, 1), cA + hstep, voffA);
        if (wr == 1) PG8_BAR;
        PG8_WAIT_V(4); PG8_BAR;
        PG8_STAGE(PG8_SB(1, 0), cB + kstep, voffB); PG8_STAGE(PG8_SA(1, 0), cA + kstep, voffA); PG8_STAGE(PG8_SB(1, 1), cB + hstep + kstep, voffB);
        PG8_WAIT_V(6); PG8_BAR;
    }
    for (;;) {
        const bool has_next = S.next(ui + 1, nxt);
        const char* nA = has_next ? (const char*)g.A + (size_t)nxt.pm * tstep : cA; const char* nB = has_next ? (const char*)g.Bt + (size_t)nxt.pn * tstep : cB;
        for (int t = 0; t < nt; t += 2) {
            const bool last = (t == nt - 2);
            const char* a1 = cA + (size_t)(t + 1) * kstep;
            const char* a2 = last ? nA : cA + (size_t)(t + 2) * kstep; const char* b2 = last ? nB : cB + (size_t)(t + 2) * kstep;
            const char* a3 = a2 + kstep; const char* b3 = b2 + kstep;
            if (last && has_next) S.a_ready(nxt);
            if constexpr (SP2) {
            PG8_LDB(B0, 0, 0); PG8_LDB(B1, 0, 1); PG8_SCHED; PG8_LDA(At, 0, 0); PG8_STAGE(PG8_SA(1, 1), a1 + hstep, voffA);
            PG8_WAIT_V(8); PG8_WAIT_L(0); PG8_BAR; PG8_MMA(0, 0, At, B0); PG8_MMA(0, 1, At, B1); PG8_BAR; PG8_SCHED;
            PG8_LDA(At, 0, 1); PG8_STAGE(PG8_SB(0, 0), b2, voffB); PG8_STAGE(PG8_SB(0, 1), b2 + hstep, voffB); PG8_STAGE(PG8_SA(0, 0), a2, voffA);
            PG8_WAIT_V(8); PG8_WAIT_L(0); PG8_BAR; PG8_MMA(1, 0, At, B0); PG8_MMA(1, 1, At, B1); PG8_BAR; PG8_SCHED;
            PG8_LDB(B0, 1, 0); PG8_LDB(B1, 1, 1); PG8_SCHED; PG8_LDA(At, 1, 0); PG8_STAGE(PG8_SA(0, 1), a2 + hstep, voffA);
            PG8_WAIT_V(8); PG8_WAIT_L(0); PG8_BAR; PG8_MMA(0, 0, At, B0); PG8_MMA(0, 1, At, B1); PG8_BAR; PG8_SCHED;
            PG8_LDA(At, 1, 1); PG8_STAGE(PG8_SB(1, 0), b3, voffB); PG8_STAGE(PG8_SB(1, 1), b3 + hstep, voffB); PG8_STAGE(PG8_SA(1, 0), a3, voffA);
            PG8_WAIT_V(8); PG8_WAIT_L(0); PG8_BAR; PG8_MMA(1, 0, At, B0); PG8_MMA(1, 1, At, B1); PG8_BAR; PG8_SCHED;
            } else {
            PG8_LDB(B0, 0, 0); PG8_SCHED; PG8_LDA(At, 0, 0); PG8_STAGE(PG8_SA(1, 1), a1 + hstep, voffA);
            PG8_WAIT_L(8); PG8_BAR; PG8_WAIT_L(0); PG8_MMA(0, 0, At, B0); PG8_BAR; PG8_SCHED;
            PG8_LDB(B1, 0, 1); PG8_STAGE(PG8_SB(0, 0), b2, voffB);
            PG8_BAR; PG8_WAIT_L(0); PG8_MMA(0, 1, At, B1); PG8_BAR;
            PG8_LDA(At, 0, 1); PG8_STAGE(PG8_SA(0, 0), a2, voffA);
            PG8_BAR; PG8_WAIT_L(0); PG8_MMA(1, 0, At, B0); PG8_BAR; PG8_SCHED;
            PG8_STAGE(PG8_SB(0, 1), b2 + hstep, voffB);
            PG8_WAIT_V(6); PG8_BAR; PG8_MMA(1, 1, At, B1); PG8_BAR;
            PG8_LDB(B0, 1, 0); PG8_SCHED; PG8_LDA(At, 1, 0); PG8_STAGE(PG8_SA(0, 1), a2 + hstep, voffA);
            PG8_WAIT_L(8); PG8_BAR; PG8_WAIT_L(0); PG8_MMA(0, 0, At, B0); PG8_BAR; PG8_SCHED;
            PG8_LDB(B1, 1, 1); PG8_STAGE(PG8_SB(1, 0), b3, voffB);
            PG8_BAR; PG8_WAIT_L(0); PG8_MMA(0, 1, At, B1); PG8_BAR;
            PG8_LDA(At, 1, 1); PG8_STAGE(PG8_SA(1, 0), a3, voffA);
            PG8_BAR; PG8_WAIT_L(0); PG8_MMA(1, 0, At, B0); PG8_BAR; PG8_SCHED;
            PG8_STAGE(PG8_SB(1, 1), b3 + hstep, voffB);
            PG8_WAIT_V(6); PG8_BAR; PG8_MMA(1, 1, At, B1); PG8_BAR;
            }
        }
        if constexpr (ALIGN_EPI) { if (wr == 0) PG8_BAR; }
        if constexpr (!Epi::AFTER_DRAIN) { E(acc, cur, wr, wc, fr, fq); S.done(cur); }
        if (!has_next) break;
#pragma unroll
        for (int a = 0; a < 2; ++a)
#pragma unroll
            for (int b = 0; b < 2; ++b)
#pragma unroll
                for (int m = 0; m < 4; ++m)
#pragma unroll
                    for (int n = 0; n < 2; ++n) acc[a][b][m][n] = (f32x4){0.f, 0.f, 0.f, 0.f};
        cur = nxt; cA = nA; cB = nB; ++ui;
        if constexpr (ALIGN_EPI) { if (wr == 1) PG8_BAR; }
    }
    PG8_WAIT_V(0);
    if constexpr (!ALIGN_EPI) { if (wr == 0) PG8_BAR; }
    PG8_BAR;
    if constexpr (Epi::AFTER_DRAIN) { E.fused(acc, cur, wr, wc, fr, fq, lds, wid, lane); S.done(cur); }
#undef PG8_SA
#undef PG8_SB
#undef PG8_STAGE
#undef PG8_LDA
#undef PG8_LDB
#undef PG8_MMA
#undef PG8_WAIT_V
#undef PG8_WAIT_L
#undef PG8_BAR
#undef PG8_SCHED
}
}
constexpr int NB = 4, SEQ = 4096, D = 1024, CTXL = 256, DEPTH = 2, GRIDW = 64, NROWS = 64;
constexpr int MX = NB * SEQ, MC = NB * CTXL, MT = MX + MC;
constexpr int NIN = 2560, NE = 16, FH = 2816, CAPX = 512, CAPC = 32, NMOD = 6;
constexpr int EROWS = 2304;
constexpr int ETILES = EROWS / 256, FNT = FH / 128;
constexpr int PQ = 0, PK = 512, PV = 1024, PBG = 1536, PCG = 1792, PU = 2048, PF = 2304;
constexpr float RMS_EPS = 1e-6f;
constexpr int NWAVES = 8;

constexpr size_t MiB = 1u << 20;
constexpr size_t WS_CTL = 0, CTL_ZERO_BYTES = 1 * MiB;
constexpr size_t WS_MODX = 64 * 1024;
constexpr size_t WS_WINT = 2 * MiB;
constexpr size_t WS_WOUTT = 12 * MiB;
constexpr size_t WS_WGUT = 16 * MiB;
constexpr size_t WS_WDT = 368 * MiB;
constexpr size_t WS_H = 544 * MiB;
constexpr size_t WS_P = 578 * MiB;
constexpr size_t WS_NA = 663 * MiB;
constexpr size_t WS_FO = 680 * MiB;
constexpr size_t WS_TT = 697 * MiB;
constexpr size_t WS_GC = 729 * MiB;
constexpr size_t WS_Y = 731 * MiB;
constexpr size_t WS_MO = 765 * MiB;
constexpr size_t WS_HID = 578 * MiB;
constexpr size_t WS_X1 = 833 * MiB;
constexpr size_t WS_X2 = 901 * MiB;
constexpr size_t WS_H2 = 969 * MiB;
constexpr size_t WS_AFF = 1003 * MiB;
constexpr size_t WS_SLOT = 1005 * MiB;
constexpr size_t WS_XS = 1007 * MiB;
constexpr size_t WS_YE = 1079 * MiB;
constexpr size_t WS_END = 1151 * MiB;
static_assert(WS_HID + (size_t)NE * EROWS * FH * 2 <= WS_X1, "HID overlay");
static_assert(WS_MODX + (size_t)DEPTH * 5 * NMOD * D * 4 <= CTL_ZERO_BYTES, "MODX inside memset region");
constexpr int CW_BAR = 4096;

constexpr int RING_OFF = 0, RING_BYTES = 131072;
constexpr int LDSCTL_OFF = RING_BYTES, MISC_OFF = LDSCTL_OFF + 320;
constexpr int TW64_OFF = LDSCTL_OFF + 512, TW256_OFF = LDSCTL_OFF + 1024;
constexpr int CT_OFF = LDSCTL_OFF + 4096, ST_OFF = LDSCTL_OFF + 12288;
constexpr int RPB_OFF = LDSCTL_OFF + 20480;
constexpr int LDS_BYTES = LDSCTL_OFF + 20480 + 7680;
#define GAS __attribute__((address_space(1)))
#define LAS __attribute__((address_space(3)))
typedef unsigned short bf16;
typedef unsigned v4u __attribute__((ext_vector_type(4)));
typedef float f32x4 __attribute__((ext_vector_type(4)));
typedef short bf16x8 __attribute__((ext_vector_type(8)));
typedef GAS unsigned gu32;
typedef GAS unsigned long long gu64;
#define RLX_AGENT __ATOMIC_RELAXED, __HIP_MEMORY_SCOPE_AGENT
#define LDS_WAIT() asm volatile("s_waitcnt lgkmcnt(0)" ::: "memory")
#define VM_WAIT() asm volatile("s_waitcnt vmcnt(0)" ::: "memory")
__device__ __forceinline__ unsigned long long rt() { return __builtin_amdgcn_s_memrealtime(); }
__device__ __forceinline__ unsigned f2bf(float f) { unsigned u = __builtin_bit_cast(unsigned, f); return (u + 0x7fffu + ((u >> 16) & 1u)) >> 16; }
__device__ __forceinline__ unsigned pk2(float lo, float hi) { return f2bf(lo) | (f2bf(hi) << 16); }

#define XB_TMO      128
#define XB_XCNT(j)  (256  + 64 * (j))
#define XB_XSUB(j)  (1280 + 64 * (j))
#define XB_XGEN(j)  (2304 + 64 * (j))
#define XB_TOP      3328
#define XB_TOPGEN   3392
#define XCD_BAR_WORDS 3456
#define XB_SPIN_CAP (1u << 18)

__device__ __forceinline__ unsigned xb_ld(unsigned* p)              { return __hip_atomic_load(p, __ATOMIC_RELAXED, __HIP_MEMORY_SCOPE_AGENT); }
__device__ __forceinline__ unsigned xb_add(unsigned* p, unsigned v) { return __hip_atomic_fetch_add(p, v, __ATOMIC_RELAXED, __HIP_MEMORY_SCOPE_AGENT); }
__device__ __forceinline__ unsigned xb_xcc_id() { return (unsigned)__builtin_amdgcn_s_getreg((3 << 11) | 20) & 0xFu; }
#define XB_SPIN(cond, bar) do { unsigned _sp = 0; while (cond) { __builtin_amdgcn_s_sleep(1); \
    if ((++_sp & 255u) == 0u) { if (xb_ld(&(bar)[XB_TMO])) break; if (_sp > XB_SPIN_CAP) { atomicAdd(&(bar)[XB_TMO], 1u); break; } } } } while (0)

struct XcdBarrier {
    unsigned* bar; unsigned x;
    volatile LAS unsigned* st;
};

__device__ __forceinline__ XcdBarrier xcd_barrier_post(unsigned* bar, volatile LAS unsigned* st) {
    XcdBarrier b; b.bar = bar; b.x = xb_xcc_id(); b.st = st;
    if (threadIdx.x == 0) (void)xb_add(&bar[XB_XCNT(b.x)], 1u);
    return b;
}
__device__ __forceinline__ void xcd_barrier_complete(unsigned* bar, unsigned x, unsigned& nloc, unsigned& nx) {
    const unsigned G = gridDim.x * gridDim.y * gridDim.z;
    unsigned sum, cnt, mine, sp = 0u;
    for (;;) {
        sum = 0u; cnt = 0u; mine = 0u;
#pragma unroll
        for (unsigned j = 0; j < 16; ++j) { const unsigned c = xb_ld(&bar[XB_XCNT(j)]); sum += c; cnt += (c > 0u) ? 1u : 0u; mine = (j == x) ? c : mine; }
        if (sum == G) break;
        __builtin_amdgcn_s_sleep(1);
        if ((++sp & 255u) == 0u) { if (xb_ld(&bar[XB_TMO])) break; if (sp > XB_SPIN_CAP) { atomicAdd(&bar[XB_TMO], 1u); break; } }
    }
    nloc = mine > 0u ? mine : 1u; nx = cnt > 0u ? cnt : 1u;
}

__device__ __forceinline__ void xcd_barrier(const XcdBarrier& b) {
    asm volatile("s_waitcnt vmcnt(0)" ::: "memory");
    __syncthreads();
    if (threadIdx.x == 0) {
        unsigned* bar = b.bar;
        __builtin_amdgcn_s_waitcnt(0);
        unsigned nloc = b.st[0], nx = b.st[1];
        if (nloc == 0u) { xcd_barrier_complete(bar, b.x, nloc, nx); b.st[0] = nloc; b.st[1] = nx; }
        const unsigned old = xb_add(&bar[XB_XSUB(b.x)], 1u);
        const unsigned gen = old / nloc;
        if (old + 1u == (gen + 1u) * nloc) {
            __builtin_amdgcn_fence(__ATOMIC_RELEASE, "agent");
            asm volatile("s_waitcnt vmcnt(0)" ::: "memory");
            const unsigned og = xb_add(&bar[XB_TOP], 1u);
            const unsigned tg = og / nx;
            if (og + 1u == (tg + 1u) * nx) xb_add(&bar[XB_TOPGEN], 1u);
            else XB_SPIN(xb_ld(&bar[XB_TOPGEN]) == tg, bar);
            __builtin_amdgcn_fence(__ATOMIC_ACQUIRE, "agent");
            xb_add(&bar[XB_XGEN(b.x)], 1u);
            asm volatile("s_waitcnt vmcnt(0)" ::: "memory");
        } else {
            XB_SPIN(xb_ld(&bar[XB_XGEN(b.x)]) == gen, bar);
            __builtin_amdgcn_fence(__ATOMIC_ACQUIRE, "agent");
            asm volatile("s_waitcnt vmcnt(0)" ::: "memory");
        }
    }
    __syncthreads();
}
typedef LAS float lfloat;
typedef float f32x2 __attribute__((ext_vector_type(2)));
typedef unsigned u32x2 __attribute__((ext_vector_type(2)));
__device__ __forceinline__ float bflo(unsigned w) { return __uint_as_float(w << 16); }
__device__ __forceinline__ float bfhi(unsigned w) { return __uint_as_float(w & 0xffff0000u); }
__device__ __forceinline__ float bf2f(bf16 h) { return __uint_as_float((unsigned)h << 16); }
__device__ __forceinline__ float wave_sum(float v) {
#pragma unroll
    for (int o = 1; o < 64; o <<= 1) v += __shfl_xor(v, o);
    return v;
}
__device__ __forceinline__ float wave_max(float v) {
#pragma unroll
    for (int o = 1; o < 64; o <<= 1) v = fmaxf(v, __shfl_xor(v, o));
    return v;
}
__device__ __forceinline__ float silu(float x) { return x / (1.0f + __expf(-x)); }

struct Ctx {
    unsigned char* ws; LAS unsigned char* lds;
    int tid, lane, wave, G, gw, NGW;
};
#define IN_X 0
#define IN_C 1
#define IN_CTX 2
#define IN_CCTX 3
#define IN_WMOD 4
#define IN_BMOD 5
#define IN_GPREMIX 6
#define IN_GPOSTMIX 7
#define IN_GPREFFN 8
#define IN_GPOSTFFN 9
#define IN_WIN 10
#define IN_RPB 11
#define IN_CONVW 12
#define IN_GMIXOUT 13
#define IN_WOUT 14
#define IN_WROUTER 15
#define IN_WGATE 16
#define IN_WUP 17
#define IN_WDOWN 18

__device__ __forceinline__ int mod_row(int row) { return row < MX ? (row >> 12) : 4; }
__device__ __forceinline__ const float* modx(const Ctx& C, int layer, int mr, int which) { return (const float*)(C.ws + WS_MODX) + ((size_t)(layer * 5 + mr) * NMOD + which) * D; }

__device__ __forceinline__ void transpose_item(const float* W, int K, int N, bf16* WT, int item, int mode, lfloat* scr, int lane) {
    const int nblk = N / 32, kb = item / nblk, nb = item % nblk, k0 = 64 * kb, n0 = 32 * nb;
#pragma unroll 8
    for (int i = 0; i < 32; ++i) { const int kk = 2 * i + (lane >> 5); scr[kk * 33 + (lane & 31)] = W[(size_t)(k0 + kk) * N + n0 + (lane & 31)]; }
    LDS_WAIT(); asm volatile("" ::: "memory");
    const int rowbase = mode == 0 ? n0 : ((n0 >> 7) * 256 + (n0 & 127) + (mode == 2 ? 128 : 0));
    const int c = lane & 7;
#pragma unroll
    for (int j = 0; j < 4; ++j) { const int n = (lane >> 3) + 8 * j; const lfloat* s = scr + (8 * c) * 33 + n;
        v4u o; o.x = pk2(s[0 * 33], s[1 * 33]); o.y = pk2(s[2 * 33], s[3 * 33]); o.z = pk2(s[4 * 33], s[5 * 33]); o.w = pk2(s[6 * 33], s[7 * 33]);
        *(GAS v4u*)(WT + (size_t)(rowbase + n) * K + k0 + 8 * c) = o; }
    LDS_WAIT(); asm volatile("" ::: "memory");
}
constexpr int IT_WIN = (D / 64) * (NIN / 32), IT_WOUT = (D / 64) * (D / 32), IT_GU = (D / 64) * (FH / 32), IT_DN = (FH / 64) * (D / 32);
constexpr int N_T_ITEMS = DEPTH * IT_WIN + DEPTH * IT_WOUT + DEPTH * NE * (2 * IT_GU + IT_DN);
__device__ __forceinline__ void p0_prologue(const Ctx& C, const float* const (&in)[19]) {
    {
        lfloat* part = (lfloat*)(C.lds + RING_OFF);
        for (int it = blockIdx.x; it < DEPTH * (NMOD * D / 64); it += C.G) {
            const int l = it / (NMOD * D / 64), cb = it % (NMOD * D / 64), col = cb * 64 + C.lane;
            const float* wm = in[IN_WMOD] + (size_t)l * D * NMOD * D + col;
            float acc[5] = {0.f, 0.f, 0.f, 0.f, 0.f};
#pragma unroll 8
            for (int k = C.wave * 128; k < C.wave * 128 + 128; ++k) {
                const float wv = wm[(size_t)k * (NMOD * D)];
#pragma unroll
                for (int r = 0; r < 4; ++r) acc[r] += silu(in[IN_C][r * D + k]) * wv;
                acc[4] += silu(in[IN_CCTX][k]) * wv;
            }
#pragma unroll
            for (int r = 0; r < 5; ++r) part[(C.wave * 5 + r) * 64 + C.lane] = acc[r];
            __syncthreads();
            if (C.wave < 5) { const int r = C.wave; float sum = in[IN_BMOD][l * NMOD * D + col];
#pragma unroll
                for (int w = 0; w < 8; ++w) sum += part[(w * 5 + r) * 64 + C.lane];
                ((float*)(C.ws + WS_MODX))[(size_t)(l * 5 + r) * NMOD * D + col] = sum; }
            __syncthreads();
        }
    }
    lfloat* scr = (lfloat*)(C.lds + RING_OFF + C.wave * 16384);
    bf16* WINT = (bf16*)(C.ws + WS_WINT); bf16* WOUTT = (bf16*)(C.ws + WS_WOUTT); bf16* WGUT = (bf16*)(C.ws + WS_WGUT); bf16* WDT = (bf16*)(C.ws + WS_WDT);
    for (int it = C.gw; it < N_T_ITEMS; it += C.NGW) {
        int r = it;
        if (r < DEPTH * IT_WIN) { const int l = r / IT_WIN; transpose_item(in[IN_WIN] + (size_t)l * D * NIN, D, NIN, WINT + (size_t)l * NIN * D, r % IT_WIN, 0, scr, C.lane); continue; } r -= DEPTH * IT_WIN;
        if (r < DEPTH * IT_WOUT) { const int l = r / IT_WOUT; transpose_item(in[IN_WOUT] + (size_t)l * D * D, D, D, WOUTT + (size_t)l * D * D, r % IT_WOUT, 0, scr, C.lane); continue; } r -= DEPTH * IT_WOUT;
        if (r < DEPTH * NE * IT_GU) { const int le = r / IT_GU; transpose_item(in[IN_WGATE] + (size_t)le * D * FH, D, FH, WGUT + (size_t)le * 2 * FH * D, r % IT_GU, 1, scr, C.lane); continue; } r -= DEPTH * NE * IT_GU;
        if (r < DEPTH * NE * IT_GU) { const int le = r / IT_GU; transpose_item(in[IN_WUP] + (size_t)le * D * FH, D, FH, WGUT + (size_t)le * 2 * FH * D, r % IT_GU, 2, scr, C.lane); continue; } r -= DEPTH * NE * IT_GU;
        { const int le = r / IT_DN; transpose_item(in[IN_WDOWN] + (size_t)le * FH * D, FH, D, WDT + (size_t)le * D * FH, r % IT_DN, 0, scr, C.lane); }
    }
}

__device__ __forceinline__ void norm_mod_store(const f32x4 (&v)[4], float ss, const float* g, const float* sh, const float* sc, bf16* orow, int lane) {
    const float rstd = 1.0f / sqrtf(ss * (1.f / D) + RMS_EPS);
#pragma unroll
    for (int j = 0; j < 4; ++j) {
        const f32x4 gg = ((const f32x4*)g)[lane + 64 * j], hh = ((const f32x4*)sh)[lane + 64 * j], cc = ((const f32x4*)sc)[lane + 64 * j];
        const f32x4 o = (v[j] * rstd * gg) * (cc + 1.0f) + hh;
        u32x2 w; w.x = pk2(o.x, o.y); w.y = pk2(o.z, o.w);
        ((u32x2*)orow)[lane + 64 * j] = w;
    }
}
__device__ __forceinline__ void p1_h0(const Ctx& C, const float* const (&in)[19]) {
    bf16* H = (bf16*)(C.ws + WS_H);
    for (int row = C.gw; row < MT; row += C.NGW) {
        const float* xr = row < MX ? in[IN_X] + (size_t)row * D : in[IN_CTX] + (size_t)(row - MX) * D;
        f32x4 v[4]; float ss = 0.f;
#pragma unroll
        for (int j = 0; j < 4; ++j) { v[j] = ((const f32x4*)xr)[C.lane + 64 * j]; ss += (v[j].x * v[j].x + v[j].y * v[j].y) + (v[j].z * v[j].z + v[j].w * v[j].w); }
        ss = wave_sum(ss);
        const int mr = mod_row(row);
        norm_mod_store(v, ss, in[IN_GPREMIX], modx(C, 0, mr, 0), modx(C, 0, mr, 1), H + (size_t)row * D, C.lane);
    }
}
__device__ __forceinline__ float dot64(const float (&q)[64], const bf16* krow) {
    const v4u* p = (const v4u*)krow; float a = 0.f;
#pragma unroll
    for (int t = 0; t < 8; ++t) { const v4u w = p[t];
        a += q[8 * t + 0] * bflo(w.x) + q[8 * t + 1] * bfhi(w.x) + q[8 * t + 2] * bflo(w.y) + q[8 * t + 3] * bfhi(w.y)
           + q[8 * t + 4] * bflo(w.z) + q[8 * t + 5] * bfhi(w.z) + q[8 * t + 6] * bflo(w.w) + q[8 * t + 7] * bfhi(w.w); }
    return a;
}
__device__ __forceinline__ void axpy64(float (&o)[64], float p, const bf16* vrow) {
    const v4u* pp = (const v4u*)vrow;
#pragma unroll
    for (int t = 0; t < 8; ++t) { const v4u w = pp[t];
        o[8 * t + 0] += p * bflo(w.x); o[8 * t + 1] += p * bfhi(w.x); o[8 * t + 2] += p * bflo(w.y); o[8 * t + 3] += p * bfhi(w.y);
        o[8 * t + 4] += p * bflo(w.z); o[8 * t + 5] += p * bfhi(w.z); o[8 * t + 6] += p * bflo(w.w); o[8 * t + 7] += p * bfhi(w.w); }
}
__device__ __forceinline__ void attn_key(const float (&q)[64], float (&o)[64], float& m, float& l, float bias, const bf16* P, int key, int head) {
    const float s = dot64(q, P + (size_t)key * NIN + PK + head * 64) + bias;
    if (s > m) { const float alpha = __expf(m - s); l *= alpha;
#pragma unroll
        for (int d = 0; d < 64; ++d) o[d] *= alpha;
        m = s; }
    const float p = __expf(s - m); l += p;
    axpy64(o, p, P + (size_t)key * NIN + PV + head * 64);
}
__device__ __forceinline__ void p_attn_naive(const Ctx& C, const float* const (&in)[19], int layer) {
    const bf16* P = (const bf16*)(C.ws + WS_P); bf16* NA = (bf16*)(C.ws + WS_NA);
    const float* rpb = in[IN_RPB] + (size_t)layer * 8 * 15 * 31;
    const int nitems = layer == 0 ? 2048 + 128 : 2048;
    for (int id = C.gw; id < nitems; id += C.NGW) {
        const bool isctx = id >= 2048;
        int b, h, r = 0, c = 0, qrow;
        if (!isctx) { b = id >> 9; r = (id >> 3) & 63; h = id & 7; c = C.lane; qrow = b * SEQ + r * 64 + c; }
        else { const int j = id - 2048; b = j >> 5; h = (j >> 2) & 7; qrow = MX + b * CTXL + (j & 3) * 64 + C.lane; }
        float q[64], o[64];
        { const v4u* p = (const v4u*)(P + (size_t)qrow * NIN + PQ + h * 64);
#pragma unroll
          for (int t = 0; t < 8; ++t) { const v4u w = p[t];
              q[8 * t + 0] = 0.125f * bflo(w.x); q[8 * t + 1] = 0.125f * bfhi(w.x); q[8 * t + 2] = 0.125f * bflo(w.y); q[8 * t + 3] = 0.125f * bfhi(w.y);
              q[8 * t + 4] = 0.125f * bflo(w.z); q[8 * t + 5] = 0.125f * bfhi(w.z); q[8 * t + 6] = 0.125f * bflo(w.w); q[8 * t + 7] = 0.125f * bfhi(w.w); } }
#pragma unroll
        for (int d = 0; d < 64; ++d) o[d] = 0.f;
        float m = -1e30f, l = 0.f;
        if (!isctx) {
            const int rs = min(max(r - 4, 0), NROWS - 8), cs = min(max(c - 8, 0), GRIDW - 16);
            for (int kr = 0; kr < 8; ++kr) {
                const float* bp = rpb + (size_t)h * 465 + (rs + kr - r + 7) * 31 + 15;
#pragma unroll 1
                for (int i = 0; i < 16; ++i) { const int dc = min(max(cs + i - c, -15), 15); attn_key(q, o, m, l, bp[dc], P, b * SEQ + (rs + kr) * 64 + cs + i, h); }
            }
        }
#pragma unroll 1
        for (int j = 0; j < CTXL; ++j) attn_key(q, o, m, l, 0.f, P, MX + b * CTXL + j, h);
        const float inv = 1.0f / l;
        v4u* op = (v4u*)(NA + (size_t)qrow * 512 + h * 64);
#pragma unroll
        for (int t = 0; t < 8; ++t) { v4u w; w.x = pk2(o[8 * t] * inv, o[8 * t + 1] * inv); w.y = pk2(o[8 * t + 2] * inv, o[8 * t + 3] * inv);
            w.z = pk2(o[8 * t + 4] * inv, o[8 * t + 5] * inv); w.w = pk2(o[8 * t + 6] * inv, o[8 * t + 7] * inv); op[t] = w; }
    }
}

typedef short v4i16_t __attribute__((ext_vector_type(4)));
__device__ __forceinline__ bf16x8 pack8(const f32x4& a, const f32x4& b) {
    v4u w; w.x = pk2(a[0], a[1]); w.y = pk2(a[2], a[3]); w.z = pk2(b[0], b[1]); w.w = pk2(b[2], b[3]); return __builtin_bit_cast(bf16x8, w);
}
__device__ __forceinline__ bf16x8 neg8(const bf16x8& a) { v4u w = __builtin_bit_cast(v4u, a); w.x ^= 0x80008000u; w.y ^= 0x80008000u; w.z ^= 0x80008000u; w.w ^= 0x80008000u; return __builtin_bit_cast(bf16x8, w); }
#define MFMA16(a, b, c) __builtin_amdgcn_mfma_f32_16x16x32_bf16((a), (b), (c), 0, 0, 0)
constexpr float LOG2E = 1.4426950408889634f;
template <int NI>
__device__ __forceinline__ void attn_load_tile(LAS unsigned char* dst_lane, const bf16* src, unsigned lofs) {
#pragma unroll
    for (int i = 0; i < NI; ++i) { const char* bi = (const char*)src + (size_t)i * (8 * NIN * 2);
        const v4u w = *(const v4u*)(bi + lofs);
        *(LAS v4u*)(dst_lane + i * 1024) = w; }
}
struct AttnAddr { const LAS unsigned char* k[2]; const LAS unsigned char* v[4]; };
__device__ __forceinline__ AttnAddr attn_addr(const LAS unsigned char* KL, const LAS unsigned char* VL, int lr, int lq) {
    AttnAddr A;
#pragma unroll
    for (int ks = 0; ks < 2; ++ks) A.k[ks] = KL + lr * 128 + (((4 * ks + lq) ^ (lr & 7)) << 4);
    const int qq = lr >> 2, p = lr & 3, row = 4 * lq + qq;
#pragma unroll
    for (int dt = 0; dt < 4; ++dt) A.v[dt] = VL + row * 128 + (((2 * dt + (p >> 1)) ^ (row & 7)) << 4) + 8 * (p & 1);
    return A;
}
__device__ __forceinline__ bf16x8 attn_v_op(const LAS unsigned char* va, int kb0, int kb1) {
    const v4i16_t lo = __builtin_amdgcn_ds_read_tr16_b64_v4i16((LAS v4i16_t*)(va + kb0 * 128));
    const v4i16_t hi = __builtin_amdgcn_ds_read_tr16_b64_v4i16((LAS v4i16_t*)(va + kb1 * 128));
    return (bf16x8){lo[0], lo[1], lo[2], lo[3], hi[0], hi[1], hi[2], hi[3]};
}
__device__ __forceinline__ float xmax4(float v) { v = fmaxf(v, __shfl_xor(v, 16)); v = fmaxf(v, __shfl_xor(v, 32)); return v; }
template <int NT, bool WIN, int KB>
__device__ __forceinline__ void attn_block(const AttnAddr& A, const bf16x8 (&QB)[2], f32x4 (&O)[4], float& m, float& l, int lo, const LAS bf16* bias, int lq) {
    const f32x4 z4 = (f32x4){0.f, 0.f, 0.f, 0.f};
    constexpr float SC = 0.125f * LOG2E;
    float s[NT][4]; float mc = -1e30f;
#pragma unroll
    for (int t = 0; t < NT; ++t) {
        f32x4 a = MFMA16(*(const LAS bf16x8*)(A.k[0] + (KB + 16 * t) * 128), QB[0], z4);
        a = MFMA16(*(const LAS bf16x8*)(A.k[1] + (KB + 16 * t) * 128), QB[1], a);
#pragma unroll
        for (int r = 0; r < 4; ++r) { const int kk = 16 * t + 4 * lq + r; float v = a[r] * SC;
            if (WIN) { v += bf2f(bias[kk]); v = ((unsigned)(kk - lo) < 16u) ? v : -1e30f; }
            s[t][r] = v; mc = fmaxf(mc, v); }
        asm volatile("" ::: "memory");
    }
    mc = xmax4(mc);
    const float mn = fmaxf(m, mc), alpha = __builtin_amdgcn_exp2f(m - mn); m = mn;
    float ps = 0.f;
#pragma unroll
    for (int t = 0; t < NT; ++t)
#pragma unroll
        for (int r = 0; r < 4; ++r) { s[t][r] = __builtin_amdgcn_exp2f(s[t][r] - mn); ps += s[t][r]; }
    l = l * alpha + ps;
#pragma unroll
    for (int dt = 0; dt < 4; ++dt) O[dt] = O[dt] * alpha;
#pragma unroll
    for (int kp = 0; kp < NT / 2; ++kp) {
        const bf16x8 bp = pack8((f32x4){s[2 * kp][0], s[2 * kp][1], s[2 * kp][2], s[2 * kp][3]}, (f32x4){s[2 * kp + 1][0], s[2 * kp + 1][1], s[2 * kp + 1][2], s[2 * kp + 1][3]});
#pragma unroll
        for (int dt = 0; dt < 4; ++dt) { O[dt] = MFMA16(attn_v_op(A.v[dt], KB + 32 * kp, KB + 32 * kp + 16), bp, O[dt]); if (dt & 1) asm volatile("" ::: "memory"); }
    }
}
__device__ __forceinline__ void p_attn(const Ctx& C, const float* const (&in)[19], int layer) {
    const bf16* P = (const bf16*)(C.ws + WS_P); bf16* NA = (bf16*)(C.ws + WS_NA);
    LAS unsigned char* KL = C.lds + RING_OFF + C.wave * 16384; LAS unsigned char* VL = KL + 8192;
    LAS bf16* RPB = (LAS bf16*)(C.lds + RPB_OFF) + 32;
    { const float* rpb = in[IN_RPB] + (size_t)layer * 8 * 465;
      for (int u = C.tid; u < 8 * 465; u += NWAVES * 64) RPB[u] = (bf16)f2bf(rpb[u] * LOG2E);
      __syncthreads(); }
    const int lane = C.lane, lr = lane & 15, lq = lane >> 4;
    const AttnAddr AD = attn_addr(KL, VL, lr, lq);
    const unsigned lofs = (unsigned)(((lane >> 3) * NIN + (lane & 7) * 8) * 2);
    LAS unsigned char* kdst = KL + (lane >> 3) * 128 + (((lane & 7) ^ ((lane >> 3) & 7)) << 4); LAS unsigned char* vdst = kdst + 8192;
    const int nitems = layer == 0 ? 4096 + 256 : 4096;
    for (int id = C.gw; id < nitems; id += C.NGW) {
        const bool isctx = id >= 4096;
        int b, h, r = 0, half = 0, qtok0;
        if (!isctx) { b = id >> 10; r = (id >> 4) & 63; h = (id >> 1) & 7; half = id & 1; qtok0 = b * SEQ + r * 64 + 32 * half; }
        else { const int j = id - 4096; b = j >> 6; h = (j >> 3) & 7; qtok0 = MX + b * CTXL + (j & 7) * 32; }
        bf16x8 QB[2][2];
#pragma unroll
        for (int qb = 0; qb < 2; ++qb) { const bf16* qp = P + (size_t)(qtok0 + 16 * qb + lr) * NIN + PQ + h * 64 + 8 * lq; QB[qb][0] = *(const bf16x8*)qp; QB[qb][1] = *(const bf16x8*)(qp + 32); }
        f32x4 O[2][4]; float m[2], l[2];
#pragma unroll
        for (int qb = 0; qb < 2; ++qb) { m[qb] = -1e30f; l[qb] = 0.f;
#pragma unroll
            for (int dt = 0; dt < 4; ++dt) O[qb][dt] = (f32x4){0.f, 0.f, 0.f, 0.f}; }
        if (!isctx) {
            const int rs = min(max(r - 4, 0), NROWS - 8), kc0 = 24 * half;
#pragma unroll 1
            for (int kr = 0; kr < 8; ++kr) {
                const bf16* src = P + (size_t)(b * SEQ + (rs + kr) * 64 + kc0) * NIN + h * 64;
                attn_load_tile<5>(kdst, src + PK, lofs); attn_load_tile<5>(vdst, src + PV, lofs);
                LDS_WAIT(); asm volatile("" ::: "memory");
                const LAS bf16* brow = RPB + h * 465 + (rs + kr - r + 7) * 31;
#define ATTN_WIN(qb, ks0) { const int c = 32 * half + 16 * (qb) + lr, cs = min(max(c - 8, 0), GRIDW - 16); attn_block<2, true, ks0>(AD, QB[qb], O[qb], m[qb], l[qb], cs - (kc0 + (ks0)), brow + ((kc0 + (ks0)) - c + 15), lq); __builtin_amdgcn_sched_barrier(0); }
                ATTN_WIN(0, 0) ATTN_WIN(1, 8)
#undef ATTN_WIN
                LDS_WAIT(); asm volatile("" ::: "memory");
            }
        }
#pragma unroll 1
        for (int cc = 0; cc < 4; ++cc) {
            const bf16* src = P + (size_t)(MX + b * CTXL + cc * 64) * NIN + h * 64;
            attn_load_tile<8>(kdst, src + PK, lofs); attn_load_tile<8>(vdst, src + PV, lofs);
            LDS_WAIT(); asm volatile("" ::: "memory");
#pragma unroll
            for (int qb = 0; qb < 2; ++qb) { attn_block<4, false, 0>(AD, QB[qb], O[qb], m[qb], l[qb], 0, RPB, lq); __builtin_amdgcn_sched_barrier(0); }
            LDS_WAIT(); asm volatile("" ::: "memory");
        }
#pragma unroll
        for (int qb = 0; qb < 2; ++qb) {
            float lt = l[qb]; lt += __shfl_xor(lt, 16); lt += __shfl_xor(lt, 32);
            const float inv = 1.0f / lt;
            bf16* op = NA + (size_t)(qtok0 + 16 * qb + lr) * 512 + h * 64 + 4 * lq;
#pragma unroll
            for (int dt = 0; dt < 4; ++dt) { u32x2 w; w.x = pk2(O[qb][dt][0] * inv, O[qb][dt][1] * inv); w.y = pk2(O[qb][dt][2] * inv, O[qb][dt][3] * inv); *(u32x2*)(op + 16 * dt) = w; }
        }
    }
}

__device__ __forceinline__ void p_fft_a(const Ctx& C) {
    const bf16* P = (const bf16*)(C.ws + WS_P); bf16* TT = (bf16*)(C.ws + WS_TT);
    const LAS unsigned char* CT = C.lds + CT_OFF; const LAS unsigned char* ST = C.lds + ST_OFF;
    const int lane = C.lane, lr = lane & 15, lq = lane >> 4;
    const f32x4 z4 = (f32x4){0.f, 0.f, 0.f, 0.f};
    for (int id = C.gw; id < NB * 4 * 64; id += C.NGW) {
        const int b = id >> 8, g = (id >> 6) & 3, n2 = id & 63;
        bf16x8 FA[4][2];
#pragma unroll
        for (int mt = 0; mt < 4; ++mt) { const int n1 = 32 * (mt >> 1) + 8 * (lr >> 2) + 4 * (mt & 1) + (lr & 3);
            const bf16* fr = P + (size_t)(b * SEQ + 64 * n1 + n2) * NIN + PF + g * 64 + 8 * lq;
            FA[mt][0] = *(const bf16x8*)fr; FA[mt][1] = *(const bf16x8*)(fr + 32); }
        float tcs[4][4], tsn[4][4];
#pragma unroll
        for (int kt = 0; kt < 4; ++kt)
#pragma unroll
            for (int r = 0; r < 4; ++r) sincospif((float)((16 * kt + 4 * lq + r) * n2) * (1.0f / 2048.0f), &tsn[kt][r], &tcs[kt][r]);
#pragma unroll 1
        for (int jt = 0; jt < 4; ++jt) {
            bf16x8 cb[2], sb[2];
#pragma unroll
            for (int ks = 0; ks < 2; ++ks) { cb[ks] = *(const LAS bf16x8*)(CT + (16 * jt + lr) * 128 + (32 * ks + 8 * lq) * 2); sb[ks] = *(const LAS bf16x8*)(ST + (16 * jt + lr) * 128 + (32 * ks + 8 * lq) * 2); }
            f32x4 gr[4], gi[4];
#pragma unroll
            for (int mt = 0; mt < 4; ++mt) { gr[mt] = MFMA16(FA[mt][0], cb[0], z4); gr[mt] = MFMA16(FA[mt][1], cb[1], gr[mt]); gi[mt] = MFMA16(FA[mt][0], sb[0], z4); gi[mt] = MFMA16(FA[mt][1], sb[1], gi[mt]); }
            bf16x8 BGr[2], BGi[2], BnGi[2];
#pragma unroll
            for (int p = 0; p < 2; ++p) { BGr[p] = pack8(gr[2 * p], gr[2 * p + 1]); BGi[p] = pack8(gi[2 * p], gi[2 * p + 1]); BnGi[p] = neg8(BGi[p]); }
#pragma unroll
            for (int kt = 0; kt < 4; ++kt) {
                f32x4 tr = z4, nti = z4;
#pragma unroll
                for (int p = 0; p < 2; ++p) { const bf16x8 ca = *(const LAS bf16x8*)(CT + (16 * kt + lr) * 128 + (32 * p + 8 * lq) * 2), sa = *(const LAS bf16x8*)(ST + (16 * kt + lr) * 128 + (32 * p + 8 * lq) * 2);
                    tr = MFMA16(ca, BGr[p], tr); tr = MFMA16(sa, BnGi[p], tr); nti = MFMA16(ca, BGi[p], nti); nti = MFMA16(sa, BGr[p], nti); }
#pragma unroll
                for (int r = 0; r < 4; ++r) { const int k1 = 16 * kt + 4 * lq + r; const float cs = tcs[kt][r], sn = tsn[kt][r];
                    const float tpr = cs * tr[r] - sn * nti[r], tpi = -cs * nti[r] - sn * tr[r];
                    bf16* dst = TT + ((size_t)(((b * 4 + g) * 64 + k1) * 2) * 64 + n2) * 64 + 16 * jt + lr;
                    dst[0] = (bf16)f2bf(tpr); dst[64 * 64] = (bf16)f2bf(tpi); }
            }
        }
    }
}
__device__ __forceinline__ void p_fft_b(const Ctx& C) {
    const bf16* TT = (const bf16*)(C.ws + WS_TT); float* FO = (float*)(C.ws + WS_FO);
    const LAS unsigned char* CT = C.lds + CT_OFF; const LAS unsigned char* ST = C.lds + ST_OFF;
    LAS unsigned char* scr = C.lds + RING_OFF + C.wave * 16384;
    const int lane = C.lane, lr = lane & 15, lq = lane >> 4;
    const f32x4 z4 = (f32x4){0.f, 0.f, 0.f, 0.f};
    for (int id = C.gw; id < NB * 4 * 64; id += C.NGW) {
        const int b = id >> 8, g = (id >> 6) & 3, k1 = id & 63;
        const v4u* src = (const v4u*)(TT + (size_t)(((b * 4 + g) * 64 + k1) * 2) * 64 * 64);
#pragma unroll
        for (int i = 0; i < 16; ++i) { const v4u w = src[i * 64 + lane]; *(LAS v4u*)(scr + (i * 64 + lane) * 16) = w; }
        LDS_WAIT(); asm volatile("" ::: "memory");
        f32x4 acc[4][4];
#pragma unroll
        for (int kt = 0; kt < 4; ++kt)
#pragma unroll
            for (int jt = 0; jt < 4; ++jt) acc[kt][jt] = z4;
#pragma unroll
        for (int ri = 0; ri < 2; ++ri)
#pragma unroll
            for (int ks = 0; ks < 2; ++ks) {
                bf16x8 Bop[4];
#pragma unroll
                for (int jt = 0; jt < 4; ++jt) {
                    const int r0 = 32 * ks + 8 * lq; const LAS unsigned char* pa = scr + ri * 8192 + (r0 + (lr >> 2)) * 128 + (16 * jt + 4 * (lr & 3)) * 2;
                    const v4i16_t lo = __builtin_amdgcn_ds_read_tr16_b64_v4i16((LAS v4i16_t*)pa), hi = __builtin_amdgcn_ds_read_tr16_b64_v4i16((LAS v4i16_t*)(pa + 4 * 128));
                    Bop[jt] = (bf16x8){lo[0], lo[1], lo[2], lo[3], hi[0], hi[1], hi[2], hi[3]}; }
#pragma unroll
                for (int kt = 0; kt < 4; ++kt) { const bf16x8 aop = *(const LAS bf16x8*)((ri == 0 ? CT : ST) + (16 * kt + lr) * 128 + (32 * ks + 8 * lq) * 2);
#pragma unroll
                    for (int jt = 0; jt < 4; ++jt) acc[kt][jt] = MFMA16(aop, Bop[jt], acc[kt][jt]); }
            }
#pragma unroll
        for (int kt = 0; kt < 4; ++kt)
#pragma unroll
            for (int r = 0; r < 4; ++r) { const int k2 = 16 * kt + 4 * lq + r; float* dst = FO + (size_t)(b * SEQ + k1 + 64 * k2) * 256 + g * 64 + lr;
#pragma unroll
                for (int jt = 0; jt < 4; ++jt) dst[16 * jt] = acc[kt][jt][r] * (1.0f / 512.0f); }
        LDS_WAIT(); asm volatile("" ::: "memory");
    }
}
__device__ __forceinline__ void p_fft_ctx1(const Ctx& C) {
    const bf16* P = (const bf16*)(C.ws + WS_P); f32x2* GC = (f32x2*)(C.ws + WS_GC);
    const LAS f32x2* tw64 = (const LAS f32x2*)(C.lds + TW64_OFF);
    const int lane = C.lane;
    for (int id = C.gw; id < NB * 4 * CTXL; id += C.NGW) {
        const int b = id >> 10, g = (id >> 8) & 3, n = id & 255;
        const float fv = bf2f(P[(size_t)(MX + b * CTXL + n) * NIN + PF + g * 64 + lane]);
        float gr = 0.f, gi = 0.f;
#pragma unroll
        for (int c = 0; c < 64; ++c) { const float f = __builtin_bit_cast(float, __builtin_amdgcn_readlane(__builtin_bit_cast(int, fv), c)); const f32x2 t = tw64[(lane * c) & 63]; gr += f * t.x; gi -= f * t.y; }
        GC[(size_t)((b * 4 + g) * CTXL + n) * 64 + lane] = (f32x2){gr, gi};
    }
}
__device__ __forceinline__ void p_fft_ctx2(const Ctx& C) {
    const f32x2* GC = (const f32x2*)(C.ws + WS_GC); float* FO = (float*)(C.ws + WS_FO);
    const LAS f32x2* tw256 = (const LAS f32x2*)(C.lds + TW256_OFF);
    const int lane = C.lane;
    for (int id = C.gw; id < NB * 4 * 16; id += C.NGW) {
        const int b = id >> 6, g = (id >> 4) & 3, kc = id & 15;
        float acc[16];
#pragma unroll
        for (int kk = 0; kk < 16; ++kk) acc[kk] = 0.f;
#pragma unroll 4
        for (int n = 0; n < CTXL; ++n) {
            const f32x2 gv = GC[(size_t)((b * 4 + g) * CTXL + n) * 64 + lane];
#pragma unroll
            for (int kk = 0; kk < 16; ++kk) { const f32x2 t = tw256[((kc * 16 + kk) * n) & 255]; acc[kk] += t.x * gv.x + t.y * gv.y; }
        }
#pragma unroll
        for (int kk = 0; kk < 16; ++kk) FO[(size_t)(MX + b * CTXL + kc * 16 + kk) * 256 + g * 64 + lane] = acc[kk] * (1.0f / 128.0f);
    }
}

__device__ __forceinline__ void p_merge(const Ctx& C, const float* const (&in)[19], int layer) {
    const bf16* P = (const bf16*)(C.ws + WS_P); const bf16* NA = (const bf16*)(C.ws + WS_NA); const float* FO = (const float*)(C.ws + WS_FO); bf16* Y = (bf16*)(C.ws + WS_Y);
    const float* cw = in[IN_CONVW] + (size_t)layer * 3 * 256; const float* gm = in[IN_GMIXOUT] + (size_t)layer * D;
    const int nrows = layer == 0 ? MT : MX, lane = C.lane;
    for (int row = C.gw; row < nrows; row += C.NGW) {
        const bool isctx = row >= MX; const int slen = isctx ? CTXL : SEQ, pos = isctx ? ((row - MX) & (CTXL - 1)) : (row & (SEQ - 1));
        float na[8]; { const v4u w = *(const v4u*)(NA + (size_t)row * 512 + 8 * lane);
            na[0] = bflo(w.x); na[1] = bfhi(w.x); na[2] = bflo(w.y); na[3] = bfhi(w.y); na[4] = bflo(w.z); na[5] = bfhi(w.z); na[6] = bflo(w.w); na[7] = bfhi(w.w); }
        float s_na = 0.f;
#pragma unroll
        for (int i = 0; i < 8; ++i) s_na += na[i] * na[i];
        const bf16* pr = P + (size_t)row * NIN;
        float z[3][4];
#pragma unroll
        for (int dk = 0; dk < 3; ++dk) { const int pp = pos + dk - 1; const bool ok = pp >= 0 && pp < slen;
            const bf16* pq = pr + (ptrdiff_t)(dk - 1) * NIN;
            u32x2 cg = (u32x2){0u, 0u}, uu = (u32x2){0u, 0u};
            if (ok) { cg = *(const u32x2*)(pq + PCG + 4 * lane); uu = *(const u32x2*)(pq + PU + 4 * lane); }
            z[dk][0] = bflo(cg.x) * bflo(uu.x); z[dk][1] = bfhi(cg.x) * bfhi(uu.x); z[dk][2] = bflo(cg.y) * bflo(uu.y); z[dk][3] = bfhi(cg.y) * bfhi(uu.y); }
        const u32x2 bgw = *(const u32x2*)(pr + PBG + 4 * lane);
        const f32x4 w0 = *(const f32x4*)(cw + 4 * lane), w1 = *(const f32x4*)(cw + 256 + 4 * lane), w2 = *(const f32x4*)(cw + 512 + 4 * lane);
        float cv[4];
        cv[0] = bflo(bgw.x) * (w0.x * z[0][0] + w1.x * z[1][0] + w2.x * z[2][0]); cv[1] = bfhi(bgw.x) * (w0.y * z[0][1] + w1.y * z[1][1] + w2.y * z[2][1]);
        cv[2] = bflo(bgw.y) * (w0.z * z[0][2] + w1.z * z[1][2] + w2.z * z[2][2]); cv[3] = bfhi(bgw.y) * (w0.w * z[0][3] + w1.w * z[1][3] + w2.w * z[2][3]);
        float s_cv = cv[0] * cv[0] + cv[1] * cv[1] + cv[2] * cv[2] + cv[3] * cv[3];
        const f32x4 fo = *(const f32x4*)(FO + (size_t)row * 256 + 4 * lane);
        float s_fo = fo.x * fo.x + fo.y * fo.y + fo.z * fo.z + fo.w * fo.w;
        s_na = wave_sum(s_na); s_cv = wave_sum(s_cv); s_fo = wave_sum(s_fo);
        const float r_na = 1.0f / sqrtf(s_na * (1.f / 512.f) + RMS_EPS), r_cv = 1.0f / sqrtf(s_cv * (1.f / 256.f) + RMS_EPS), r_fo = 1.0f / sqrtf(s_fo * (1.f / 256.f) + RMS_EPS);
        bf16* yr = Y + (size_t)row * D;
        { const f32x4 g0 = *(const f32x4*)(gm + 8 * lane), g1 = *(const f32x4*)(gm + 8 * lane + 4);
          v4u w; w.x = pk2(na[0] * r_na * g0.x, na[1] * r_na * g0.y); w.y = pk2(na[2] * r_na * g0.z, na[3] * r_na * g0.w);
          w.z = pk2(na[4] * r_na * g1.x, na[5] * r_na * g1.y); w.w = pk2(na[6] * r_na * g1.z, na[7] * r_na * g1.w); *(v4u*)(yr + 8 * lane) = w; }
        { const f32x4 g0 = *(const f32x4*)(gm + 512 + 4 * lane); u32x2 w; w.x = pk2(cv[0] * r_cv * g0.x, cv[1] * r_cv * g0.y); w.y = pk2(cv[2] * r_cv * g0.z, cv[3] * r_cv * g0.w); *(u32x2*)(yr + 512 + 4 * lane) = w; }
        { const f32x4 g0 = *(const f32x4*)(gm + 768 + 4 * lane); u32x2 w; w.x = pk2(fo.x * r_fo * g0.x, fo.y * r_fo * g0.y); w.y = pk2(fo.z * r_fo * g0.z, fo.w * r_fo * g0.w); *(u32x2*)(yr + 768 + 4 * lane) = w; }
    }
}
__device__ __forceinline__ const float* xin_row(const Ctx& C, const float* const (&in)[19], int layer, int row) {
    if (layer == 0) return row < MX ? in[IN_X] + (size_t)row * D : in[IN_CTX] + (size_t)(row - MX) * D;
    return (const float*)(C.ws + WS_X2) + (size_t)row * D;
}
__device__ __forceinline__ void p_postmix(const Ctx& C, const float* const (&in)[19], int layer) {
    const float* MO = (const float*)(C.ws + WS_MO); float* X1 = (float*)(C.ws + WS_X1); bf16* H2 = (bf16*)(C.ws + WS_H2); float* AFF = (float*)(C.ws + WS_AFF);
    const float* gpost = in[IN_GPOSTMIX] + (size_t)layer * D; const float* gpre = in[IN_GPREFFN] + (size_t)layer * D; const float* wr = in[IN_WROUTER] + (size_t)layer * D * NE;
    const int nrows = layer == 0 ? MT : MX, lane = C.lane;
    for (int row = C.gw; row < nrows; row += C.NGW) {
        const int mr = mod_row(row);
        const float* g1 = modx(C, layer, mr, 2); const float* sh2 = modx(C, layer, mr, 3); const float* sc2 = modx(C, layer, mr, 4);
        const float* xr = xin_row(C, in, layer, row);
        f32x4 v[4]; float ss = 0.f;
#pragma unroll
        for (int j = 0; j < 4; ++j) { v[j] = ((const f32x4*)(MO + (size_t)row * D))[lane + 64 * j]; ss += (v[j].x * v[j].x + v[j].y * v[j].y) + (v[j].z * v[j].z + v[j].w * v[j].w); }
        ss = wave_sum(ss);
        const float r1 = 1.0f / sqrtf(ss * (1.f / D) + RMS_EPS);
        float ss2 = 0.f;
#pragma unroll
        for (int j = 0; j < 4; ++j) { const f32x4 xx = ((const f32x4*)xr)[lane + 64 * j], gg = ((const f32x4*)gpost)[lane + 64 * j], g1v = ((const f32x4*)g1)[lane + 64 * j];
            v[j] = xx + g1v * (v[j] * r1 * gg); ((f32x4*)(X1 + (size_t)row * D))[lane + 64 * j] = v[j];
            ss2 += (v[j].x * v[j].x + v[j].y * v[j].y) + (v[j].z * v[j].z + v[j].w * v[j].w); }
        ss2 = wave_sum(ss2);
        const float r2 = 1.0f / sqrtf(ss2 * (1.f / D) + RMS_EPS);
        float acc[NE];
#pragma unroll
        for (int e = 0; e < NE; ++e) acc[e] = 0.f;
#pragma unroll
        for (int j = 0; j < 4; ++j) {
            const f32x4 gg = ((const f32x4*)gpre)[lane + 64 * j], hh = ((const f32x4*)sh2)[lane + 64 * j], cc = ((const f32x4*)sc2)[lane + 64 * j];
            const f32x4 h = (v[j] * r2 * gg) * (cc + 1.0f) + hh;
            u32x2 w; w.x = pk2(h.x, h.y); w.y = pk2(h.z, h.w);
            ((u32x2*)(H2 + (size_t)row * D))[lane + 64 * j] = w;
            const float hv[4] = {h.x, h.y, h.z, h.w};
#pragma unroll
            for (int i = 0; i < 4; ++i) { const f32x4* wp = (const f32x4*)(wr + (size_t)(4 * (lane + 64 * j) + i) * NE);
#pragma unroll
                for (int q4 = 0; q4 < 4; ++q4) { const f32x4 ww = wp[q4]; acc[4 * q4] += hv[i] * ww.x; acc[4 * q4 + 1] += hv[i] * ww.y; acc[4 * q4 + 2] += hv[i] * ww.z; acc[4 * q4 + 3] += hv[i] * ww.w; } }
        }
        float mx = -1e30f;
#pragma unroll
        for (int e = 0; e < NE; ++e) { acc[e] = wave_sum(acc[e]); mx = fmaxf(mx, acc[e]); }
        float sum = 0.f;
#pragma unroll
        for (int e = 0; e < NE; ++e) { acc[e] = expf(acc[e] - mx); sum += acc[e]; }
        const float inv = 1.0f / sum;
        if (lane == 0) {
#pragma unroll
            for (int q4 = 0; q4 < 4; ++q4) ((f32x4*)(AFF + (size_t)row * NE))[q4] = (f32x4){acc[4 * q4] * inv, acc[4 * q4 + 1] * inv, acc[4 * q4 + 2] * inv, acc[4 * q4 + 3] * inv};
        }
    }
}

__device__ __forceinline__ int wave_isum(int v) {
#pragma unroll
    for (int o = 1; o < 64; o <<= 1) v += __shfl_xor(v, o);
    return v;
}
__device__ __forceinline__ void p_route(const Ctx& C, int layer) {
    const float* AFF = (const float*)(C.ws + WS_AFF); int* SLOT = (int*)(C.ws + WS_SLOT); const bf16* H2 = (const bf16*)(C.ws + WS_H2); bf16* XS = (bf16*)(C.ws + WS_XS);
    LAS int* red = (LAS int*)(C.lds + RING_OFF);
    LAS int* list = (LAS int*)(C.lds + RING_OFF + 1024); LAS int* cnt = (LAS int*)(C.lds + RING_OFF + 512);
    const int nitems = layer == 0 ? 256 + 64 : 256;
    for (int item = blockIdx.x; item < nitems; item += C.G) {
        int b, e, NT, rowbase, cap, tok0, ntok, xsbase;
        if (item < 256) { b = item >> 6; e = (item >> 2) & 15; NT = SEQ; rowbase = b * SEQ; cap = CAPX; tok0 = (item & 3) * 1024; ntok = 1024; xsbase = e * EROWS + b * CAPX; }
        else { const int j = item - 256; b = j >> 4; e = j & 15; NT = CTXL; rowbase = MX + b * CTXL; cap = CAPC; tok0 = 0; ntok = CTXL; xsbase = e * EROWS + NB * CAPX + b * CAPC; }
        unsigned v[8];
#pragma unroll
        for (int j = 0; j < 8; ++j) { const int t = C.tid * 8 + j; v[j] = t < NT ? __float_as_uint(AFF[(size_t)(rowbase + t) * NE + e]) : 0u; }
        if (C.tid == 0) *cnt = 0;
        unsigned T = 0u;
        for (int bit = 30; bit >= 0; --bit) {
            const unsigned cand = T | (1u << bit); int c = 0;
#pragma unroll
            for (int j = 0; j < 8; ++j) c += (v[j] >= cand) ? 1 : 0;
            c = wave_isum(c);
            LAS int* r = red + (bit & 1) * 8;
            if (C.lane == 0) r[C.wave] = c;
            __syncthreads();
            int tot = 0;
#pragma unroll
            for (int w = 0; w < 8; ++w) tot += r[w];
            if (tot >= cap) T = cand;
        }
        int cg = 0, ce = 0;
#pragma unroll
        for (int j = 0; j < 8; ++j) { cg += (v[j] > T) ? 1 : 0; ce += (v[j] == T && (C.tid * 8 + j) < NT) ? 1 : 0; }
        int sg = cg, se = ce;
#pragma unroll
        for (int o = 1; o < 64; o <<= 1) { const int ag = __shfl_up(sg, o), ae = __shfl_up(se, o); if (C.lane >= o) { sg += ag; se += ae; } }
        LAS int* sc = red + 64;
        __syncthreads();
        if (C.lane == 63) { sc[C.wave] = sg; sc[8 + C.wave] = se; }
        __syncthreads();
        int bg = 0, be = 0, totg = 0;
#pragma unroll
        for (int w = 0; w < 8; ++w) { const int xg = sc[w], xe = sc[8 + w]; if (w < C.wave) { bg += xg; be += xe; } totg += xg; }
        int pg = bg + sg - cg, pe = be + se - ce;
        const int need_eq = cap - totg;
#pragma unroll
        for (int j = 0; j < 8; ++j) {
            const int t = C.tid * 8 + j; const bool gt = v[j] > T, eq = (v[j] == T) && t < NT;
            const bool sel = gt || (eq && pe < need_eq);
            const int slot = pg + min(pe, need_eq);
            if (t >= tok0 && t < tok0 + ntok) {
                SLOT[(size_t)(rowbase + t) * NE + e] = sel ? slot : -1;
                if (sel) { const int pos = atomicAdd((int*)cnt, 1); list[2 * pos] = t; list[2 * pos + 1] = slot; }
            }
            pg += gt ? 1 : 0; pe += eq ? 1 : 0;
        }
        __syncthreads();
        const int n = *cnt;
        for (int idx = C.wave; idx < n; idx += NWAVES) { const int t = list[2 * idx], slot = list[2 * idx + 1];
            const v4u* src = (const v4u*)(H2 + (size_t)(rowbase + t) * D); v4u* dst = (v4u*)(XS + (size_t)(xsbase + slot) * D);
            const v4u a = src[C.lane], c = src[C.lane + 64]; dst[C.lane] = a; dst[C.lane + 64] = c; }
        __syncthreads();
    }
}

__device__ __forceinline__ void p_combine(const Ctx& C, const float* const (&in)[19], float* out, int layer) {
    const float* AFF = (const float*)(C.ws + WS_AFF); const int* SLOT = (const int*)(C.ws + WS_SLOT); const bf16* YE = (const bf16*)(C.ws + WS_YE); const float* X1 = (const float*)(C.ws + WS_X1);
    float* XO = layer == 0 ? (float*)(C.ws + WS_X2) : out; bf16* H = (bf16*)(C.ws + WS_H);
    const float* gpost = in[IN_GPOSTFFN] + (size_t)layer * D;
    const int nrows = layer == 0 ? MT : MX, lane = C.lane;
    for (int row = C.gw; row < nrows; row += C.NGW) {
        const int mr = mod_row(row);
        const int ebase = row < MX ? (row >> 12) * CAPX : NB * CAPX + ((row - MX) >> 8) * CAPC;
        f32x4 a[4];
#pragma unroll
        for (int j = 0; j < 4; ++j) a[j] = (f32x4){0.f, 0.f, 0.f, 0.f};
        for (int e = 0; e < NE; ++e) {
            const int s = SLOT[(size_t)row * NE + e];
            if (s >= 0) { const float gt = AFF[(size_t)row * NE + e]; const u32x2* yr = (const u32x2*)(YE + (size_t)(e * EROWS + ebase + s) * D);
#pragma unroll
                for (int j = 0; j < 4; ++j) { const u32x2 w = yr[lane + 64 * j]; a[j].x += gt * bflo(w.x); a[j].y += gt * bfhi(w.x); a[j].z += gt * bflo(w.y); a[j].w += gt * bfhi(w.y); } }
        }
        float ss = 0.f;
#pragma unroll
        for (int j = 0; j < 4; ++j) ss += (a[j].x * a[j].x + a[j].y * a[j].y) + (a[j].z * a[j].z + a[j].w * a[j].w);
        ss = wave_sum(ss);
        const float r = 1.0f / sqrtf(ss * (1.f / D) + RMS_EPS);
        const float* g2 = modx(C, layer, mr, 5);
        float ss2 = 0.f;
#pragma unroll
        for (int j = 0; j < 4; ++j) { const f32x4 xx = ((const f32x4*)(X1 + (size_t)row * D))[lane + 64 * j], gg = ((const f32x4*)gpost)[lane + 64 * j], g2v = ((const f32x4*)g2)[lane + 64 * j];
            a[j] = xx + g2v * (a[j] * r * gg); ((f32x4*)(XO + (size_t)row * D))[lane + 64 * j] = a[j];
            ss2 += (a[j].x * a[j].x + a[j].y * a[j].y) + (a[j].z * a[j].z + a[j].w * a[j].w); }
        if (layer == 0) {
            ss2 = wave_sum(ss2);
            norm_mod_store(a, ss2, in[IN_GPREMIX] + D, modx(C, 1, mr, 0), modx(C, 1, mr, 1), H + (size_t)row * D, lane);
        }
    }
}
constexpr int NPH = 22;
#ifndef MK_PER_PHASE
#define MK_PER_PHASE 0
#endif
struct Args { const float* in[19]; float* out; unsigned char* ws; int ph_lo, ph_hi; };
__global__ void __launch_bounds__(NWAVES * 64, 2) mk_fwd(Args args) {
    extern __shared__ __attribute__((aligned(16))) unsigned char lds_raw[];
    Ctx C;
    C.ws = args.ws; C.lds = (LAS unsigned char*)lds_raw;
    C.tid = threadIdx.x; C.lane = C.tid & 63; C.wave = __builtin_amdgcn_readfirstlane(C.tid >> 6); C.G = gridDim.x;
    C.gw = blockIdx.x * NWAVES + C.wave; C.NGW = C.G * NWAVES;
    volatile LAS unsigned* MISC = (volatile LAS unsigned*)(C.lds + MISC_OFF);
    for (int u = C.tid; u < (512 - 0) / 4; u += NWAVES * 64) ((LAS unsigned*)(C.lds + LDSCTL_OFF))[u] = 0u;
    if (C.tid < 64) { float s, c; sincospif((float)C.tid * (1.0f / 32.0f), &s, &c); ((LAS f32x2*)(C.lds + TW64_OFF))[C.tid] = (f32x2){c, s}; }
    if (C.tid < 256) { float s, c; sincospif((float)C.tid * (1.0f / 128.0f), &s, &c); ((LAS f32x2*)(C.lds + TW256_OFF))[C.tid] = (f32x2){c, s}; }
    for (int u = C.tid; u < 4096; u += NWAVES * 64) { float s, c; sincospif((float)(((u >> 6) * (u & 63)) & 63) * (1.0f / 32.0f), &s, &c); ((LAS bf16*)(C.lds + CT_OFF))[u] = (bf16)f2bf(c); ((LAS bf16*)(C.lds + ST_OFF))[u] = (bf16)f2bf(s); }
    __syncthreads();
    gu32* ctl = (gu32*)(C.ws + WS_CTL);
    XcdBarrier bar = xcd_barrier_post((unsigned*)(ctl + CW_BAR), MISC + 8);
    const int lo = args.ph_lo, hi = args.ph_hi;
#ifndef DBG_MASK
#define DBG_MASK 0xffffffffu
#endif
#define PH_ON(k) (((DBG_MASK) >> (k)) & 1u)
#ifndef DBG_REP
#define DBG_REP 0u
#endif
#define REP(k) _Pragma("unroll") for (int rep_ = 0; rep_ < 1 + (int)(((DBG_REP) >> (k)) & 1u); ++rep_)
#define IN(k) (lo <= (k) && (k) < hi)
#define SEAM(k) do { if (IN(k) && IN((k) + 1)) xcd_barrier(bar); } while (0)

    if (PH_ON(0) && IN(0)) REP(0) p0_prologue(C, args.in);
    SEAM(0);
    if (PH_ON(1) && IN(1)) REP(1) p1_h0(C, args.in);
    SEAM(1);
    for (int layer = 0; layer < DEPTH; ++layer) {
        const int pb = 2 + 10 * layer;
        Ctx L = C; asm volatile("" : "+v"(L.tid), "+v"(L.lane)); asm volatile("" : "+s"(L.wave), "+s"(L.gw));
        if (PH_ON(2) && IN(pb + 0)) REP(2) {
            pg8::Gemm g{(const pg8::bf16_t*)(L.ws + WS_H), (const pg8::bf16_t*)(L.ws + WS_WINT) + (size_t)layer * NIN * D, MT, NIN, D};
            pg8::TileOrder S; S.init(MT / 256, NIN / 256, L.G, (int)blockIdx.x);
            pg8::EpiBf16Map E{(pg8::bf16_t*)(L.ws + WS_P), NIN, 1 << 30};
            pg8::gemm_phase<pg8::EpiBf16Map, pg8::TileOrder, true, true>(L.lds + RING_OFF, g, S, E);
        }
        SEAM(pb + 0);
        if (IN(pb + 1)) { if (PH_ON(3)) REP(3) p_attn(L, args.in, layer); if (PH_ON(4)) REP(4) p_fft_a(L); if (PH_ON(5) && layer == 0) REP(5) p_fft_ctx1(L); }
        SEAM(pb + 1);
        if (IN(pb + 2)) { if (PH_ON(6)) REP(6) p_fft_b(L); if (PH_ON(5) && layer == 0) REP(5) p_fft_ctx2(L); }
        SEAM(pb + 2);
        if (PH_ON(7) && IN(pb + 3)) REP(7) p_merge(L, args.in, layer);
        SEAM(pb + 3);
        if (PH_ON(8) && IN(pb + 4)) REP(8) {
            pg8::Gemm g{(const pg8::bf16_t*)(L.ws + WS_Y), (const pg8::bf16_t*)(L.ws + WS_WOUTT) + (size_t)layer * D * D, MT, D, D};
            pg8::TileOrder S; S.init((layer == 0 ? MT : MX) / 256, D / 256, L.G, (int)blockIdx.x);
            pg8::EpiF32 E{(float*)(L.ws + WS_MO), D};
            pg8::gemm_phase<pg8::EpiF32, pg8::TileOrder, true, true>(L.lds + RING_OFF, g, S, E);
        }
        SEAM(pb + 4);
        if (PH_ON(9) && IN(pb + 5)) REP(9) p_postmix(L, args.in, layer);
        SEAM(pb + 5);
        if (PH_ON(10) && IN(pb + 6)) REP(10) p_route(L, layer);
        SEAM(pb + 6);
        if (PH_ON(11) && IN(pb + 7)) REP(11) {
            pg8::Gemm g{(const pg8::bf16_t*)(L.ws + WS_XS), (const pg8::bf16_t*)(L.ws + WS_WGUT) + (size_t)layer * NE * 2 * FH * D, NE * EROWS, NE * 2 * FH, D};
            pg8::GroupOrder S; S.init(NE, layer == 0 ? ETILES : ETILES - 1, ETILES, FNT, L.G, (int)blockIdx.x);
            pg8::EpiSwiGLU E{(pg8::bf16_t*)(L.ws + WS_HID), FH, FNT};
            pg8::gemm_phase<pg8::EpiSwiGLU, pg8::GroupOrder, true, true>(L.lds + RING_OFF, g, S, E);
        }
        SEAM(pb + 7);
        if (PH_ON(12) && IN(pb + 8)) REP(12) {
            pg8::Gemm g{(const pg8::bf16_t*)(L.ws + WS_HID), (const pg8::bf16_t*)(L.ws + WS_WDT) + (size_t)layer * NE * D * FH, NE * EROWS, NE * D, FH};
            pg8::GroupOrder S; S.init(NE, layer == 0 ? ETILES : ETILES - 1, ETILES, D / 256, L.G, (int)blockIdx.x);
            pg8::EpiBf16Map E{(pg8::bf16_t*)(L.ws + WS_YE), D, D / 256};
            pg8::gemm_phase<pg8::EpiBf16Map, pg8::GroupOrder, true, true>(L.lds + RING_OFF, g, S, E);
        }
        SEAM(pb + 8);
        if (PH_ON(13) && IN(pb + 9)) REP(13) p_combine(L, args.in, args.out, layer);
        SEAM(pb + 9);
    }
#undef IN
#undef SEAM
}

extern "C" void kernel_launch(void* const* d_in, const int* in_sizes, int n_in, void* d_out, int out_size, void* d_ws, size_t ws_size, hipStream_t stream) {
    static int grid = 0;
    if (grid == 0) {
        if (n_in != 19 || in_sizes[0] != MX * D || out_size != MX * D || ws_size < WS_END) { fprintf(stderr, "kernel_launch: unexpected shapes (n_in %d, in0 %d, out %d, ws %zu < %zu); nothing launched\n", n_in, n_in > 0 ? in_sizes[0] : -1, out_size, ws_size, (size_t)WS_END); grid = -1; return; }
        int dev = 0, cus = 0, per_cu = 0;
        if (hipGetDevice(&dev) != hipSuccess || hipDeviceGetAttribute(&cus, hipDeviceAttributeMultiprocessorCount, dev) != hipSuccess) { fprintf(stderr, "kernel_launch: device query failed\n"); grid = -1; return; }
        if (hipFuncSetAttribute((const void*)mk_fwd, hipFuncAttributeMaxDynamicSharedMemorySize, LDS_BYTES) != hipSuccess) { fprintf(stderr, "kernel_launch: hipFuncSetAttribute failed\n"); grid = -1; return; }
        if (hipOccupancyMaxActiveBlocksPerMultiprocessor(&per_cu, (const void*)mk_fwd, NWAVES * 64, LDS_BYTES) != hipSuccess || per_cu < 1)
            fprintf(stderr, "kernel_launch: note: occupancy query reports %d workgroups per CU\n", per_cu);
        (void)hipGetLastError();
        grid = cus;
    }
    if (grid < 0) return;
    if (hipMemsetAsync((char*)d_ws + WS_CTL, 0, CTL_ZERO_BYTES, stream) != hipSuccess) { fprintf(stderr, "kernel_launch: memset failed\n"); return; }
    Args a{};
    for (int i = 0; i < 19; ++i) a.in[i] = (const float*)d_in[i];
    a.out = (float*)d_out; a.ws = (unsigned char*)d_ws;
#if MK_PER_PHASE
    for (int ph = 0; ph < NPH; ++ph) { a.ph_lo = ph; a.ph_hi = ph + 1; hipLaunchKernelGGL(mk_fwd, dim3(grid), dim3(NWAVES * 64), LDS_BYTES, stream, a); }
#else
    a.ph_lo = 0; a.ph_hi = NPH;
    hipLaunchKernelGGL(mk_fwd, dim3(grid), dim3(NWAVES * 64), LDS_BYTES, stream, a);
#endif
    const hipError_t le = hipPeekAtLastError();
    if (le != hipSuccess) fprintf(stderr, "kernel_launch: launch failed: %s\n", hipGetErrorName(le));
}
```

```cpp
#include <hip/hip_runtime.h>
#include <cstdio>
#include <cstdint>
namespace pg8 {
#define PG8_LAS __attribute__((address_space(3)))
typedef unsigned short bf16_t;
typedef short bf16x8 __attribute__((ext_vector_type(8)));
typedef float f32x4 __attribute__((ext_vector_type(4)));
typedef unsigned u32x4 __attribute__((ext_vector_type(4)));
typedef int i32x4 __attribute__((ext_vector_type(4)));
typedef int i32x8 __attribute__((ext_vector_type(8)));
typedef unsigned u32x2 __attribute__((ext_vector_type(2)));
constexpr int BM = 256, BK = 64, HALF = 128, HTB = HALF * BK * 2  , STAGE_BYTES = 8 * HTB, NXCD = 8, WGM = 8;

__host__ __device__ __forceinline__ int lds_byte(int r, int c) { const int st = (r >> 4) * 2 + (c >> 5), rr = r & 15, cc = c & 31, ob = rr * 64 + cc * 2; return st * 1024 + (ob ^ (((ob >> 9) & 1) << 5)); }
__host__ __device__ __forceinline__ void stage_rc(int b, int& R, int& C) { const int st = b / 1024, sb = b % 1024, swz = sb ^ (((sb >> 9) & 1) << 5); R = (st >> 1) * 16 + swz / 64; C = (st & 1) * 32 + (swz % 64) / 2; }
__host__ __device__ __forceinline__ int perm32(int rho) { const int n = rho >> 4, i = rho & 15; return 8 * (i >> 2) + 4 * n + (i & 3); }

struct Unit { int pm, pn; };
struct Gemm { const bf16_t* A; const bf16_t* Bt; int M, N, K; };

struct StaticOrder {
    int nM, nN, nwg, G, c;
    __host__ __device__ void init(int M, int N, int G_, int c_) { nM = M / BM; nN = N / BM; nwg = nM * nN; G = G_; c = c_; }
    __host__ __device__ bool next(int i, Unit& u) const {
        const long L = (long)i * G + c; if (L >= nwg) return false;
        int wgid = (int)L; { const int q = nwg / NXCD, r = nwg % NXCD, xcd = wgid % NXCD, off = wgid / NXCD; wgid = (xcd < r ? xcd * (q + 1) : r * (q + 1) + (xcd - r) * q) + off; }
        const int nig = WGM * nN, gid = wgid / nig, fm = gid * WGM, gsz = (nM - fm) < WGM ? (nM - fm) : WGM;
        u.pm = fm + ((wgid % nig) % gsz); u.pn = (wgid % nig) / gsz; return true;
    }
    __device__ __forceinline__ void a_ready(const Unit&) const {}
    __device__ __forceinline__ void done(const Unit&) const {}
};

__device__ __forceinline__ unsigned cvt_pk_bf16(float lo, float hi) { unsigned r; asm volatile("v_cvt_pk_bf16_f32 %0, %1, %2" : "=v"(r) : "v"(lo), "v"(hi)); return r; }
struct TileOrder {
    int nM, nN, nwg, G, c;
    __device__ void init(int nM_, int nN_, int G_, int c_) { nM = nM_; nN = nN_; nwg = nM * nN; G = G_; c = c_; }
    __device__ bool next(int i, Unit& u) const {
        int wgid;
        if ((G & 7) == 0) { const int per = G >> 3; wgid = (i * 8 + (c & 7)) * per + (c >> 3); } else wgid = i * G + c;
        if (wgid >= nwg) return false;
        const int nig = WGM * nN, gid = wgid / nig, fm = gid * WGM, gsz = (nM - fm) < WGM ? (nM - fm) : WGM;
        u.pm = fm + ((wgid % nig) % gsz); u.pn = (wgid % nig) / gsz; return true;
    }
    __device__ __forceinline__ void a_ready(const Unit&) const {}
    __device__ __forceinline__ void done(const Unit&) const {}
};
struct GroupOrder {
    int nE, nMt, strideM, nNt, nwg, G, c;
    __device__ void init(int nE_, int nMt_, int strideM_, int nNt_, int G_, int c_) { nE = nE_; nMt = nMt_; strideM = strideM_; nNt = nNt_; nwg = nE * nMt * nNt; G = G_; c = c_; }
    __device__ bool next(int i, Unit& u) const {
        int wgid;
        if ((G & 7) == 0) { const int per = G >> 3; wgid = (i * 8 + (c & 7)) * per + (c >> 3); } else wgid = i * G + c;
        if (wgid >= nwg) return false;
        const int per_e = nMt * nNt, e = wgid / per_e, r = wgid % per_e, jn = r / nMt, im = r % nMt;
        u.pm = e * strideM + im; u.pn = e * nNt + jn; return true;
    }
    __device__ __forceinline__ void a_ready(const Unit&) const {}
    __device__ __forceinline__ void done(const Unit&) const {}
};
struct EpiBf16Map {
    static constexpr bool PERM = true, AFTER_DRAIN = false;
    bf16_t* O; int ldc; int pn_mod; float scale;
    __device__ __forceinline__ void operator()(const f32x4 (&acc)[2][2][4][2], const Unit& u, int wr, int wc, int fr_, int fq_) const {
        int fr = fr_, fq = fq_; asm volatile("" : "+v"(fr), "+v"(fq));
        const int row0 = u.pm * BM + wr * 64 + fr, col0 = (u.pn % pn_mod) * BM + wc * 32 + 8 * fq;
#pragma unroll
        for (int ai = 0; ai < 2; ++ai)
#pragma unroll
            for (int m = 0; m < 4; ++m) { bf16_t* rowp = O + (size_t)(row0 + ai * HALF + m * 16) * ldc + col0;
#pragma unroll
                for (int bj = 0; bj < 2; ++bj) { const f32x4 v0 = acc[ai][bj][m][0] * scale, v1 = acc[ai][bj][m][1] * scale;
                    u32x4 w; w.x = cvt_pk_bf16(v0[0], v0[1]); w.y = cvt_pk_bf16(v0[2], v0[3]); w.z = cvt_pk_bf16(v1[0], v1[1]); w.w = cvt_pk_bf16(v1[2], v1[3]);
                    *(u32x4*)(rowp + bj * HALF) = w; } }
    }
};
struct EpiF32 {
    static constexpr bool PERM = false, AFTER_DRAIN = false;
    float* O; int ldc;
    __device__ __forceinline__ void operator()(const f32x4 (&acc)[2][2][4][2], const Unit& u, int wr, int wc, int fr_, int fq_) const {
        int fr = fr_, fq = fq_; asm volatile("" : "+v"(fr), "+v"(fq));
        const int row0 = u.pm * BM + wr * 64 + fr, col0 = u.pn * BM + wc * 32 + 4 * fq;
#pragma unroll
        for (int ai = 0; ai < 2; ++ai)
#pragma unroll
            for (int m = 0; m < 4; ++m) { float* rowp = O + (size_t)(row0 + ai * HALF + m * 16) * ldc + col0;
#pragma unroll
                for (int bj = 0; bj < 2; ++bj)
#pragma unroll
                    for (int n = 0; n < 2; ++n) *(f32x4*)(rowp + bj * HALF + n * 16) = acc[ai][bj][m][n]; }
    }
};
__device__ __forceinline__ float silu_f(float g) { return g * __builtin_amdgcn_rcpf(1.0f + __builtin_amdgcn_exp2f(-1.4426950408889634f * g)); }
struct EpiSwiGLU {
    static constexpr bool PERM = true, AFTER_DRAIN = false;
    bf16_t* O; int ldc; int pn_mod;
    __device__ __forceinline__ void operator()(const f32x4 (&acc)[2][2][4][2], const Unit& u, int wr, int wc, int fr_, int fq_) const {
        int fr = fr_, fq = fq_; asm volatile("" : "+v"(fr), "+v"(fq));
        const int row0 = u.pm * BM + wr * 64 + fr, col0 = (u.pn % pn_mod) * HALF + wc * 32 + 8 * fq;
#pragma unroll
        for (int ai = 0; ai < 2; ++ai)
#pragma unroll
            for (int m = 0; m < 4; ++m) { bf16_t* rowp = O + (size_t)(row0 + ai * HALF + m * 16) * ldc + col0;
                const f32x4 g0 = acc[ai][0][m][0], g1 = acc[ai][0][m][1], u0 = acc[ai][1][m][0], u1 = acc[ai][1][m][1];
                u32x4 w; w.x = cvt_pk_bf16(silu_f(g0[0]) * u0[0], silu_f(g0[1]) * u0[1]); w.y = cvt_pk_bf16(silu_f(g0[2]) * u0[2], silu_f(g0[3]) * u0[3]);
                w.z = cvt_pk_bf16(silu_f(g1[0]) * u1[0], silu_f(g1[1]) * u1[1]); w.w = cvt_pk_bf16(silu_f(g1[2]) * u1[2], silu_f(g1[3]) * u1[3]);
                *(u32x4*)rowp = w; }
    }
};

__device__ __forceinline__ unsigned pk4_fp8(float a, float b, float c, float d) {
    a = fminf(fmaxf(a, -448.f), 448.f); b = fminf(fmaxf(b, -448.f), 448.f); c = fminf(fmaxf(c, -448.f), 448.f); d = fminf(fmaxf(d, -448.f), 448.f);
    unsigned w = 0u; w = __builtin_amdgcn_cvt_pk_fp8_f32(a, b, w, false); w = __builtin_amdgcn_cvt_pk_fp8_f32(c, d, w, true); return w;
}
struct EpiSwiGLU8 {
    static constexpr bool PERM = true, AFTER_DRAIN = false;
    unsigned char* O; int ldc; int pn_mod; float inv, oscale;
    __device__ __forceinline__ void operator()(const f32x4 (&acc)[2][2][4][2], const Unit& u, int wr, int wc, int fr_, int fq_) const {
        int fr = fr_, fq = fq_; asm volatile("" : "+v"(fr), "+v"(fq));
        const int row0 = u.pm * BM + wr * 64 + fr, col0 = (u.pn % pn_mod) * HALF + wc * 32 + 8 * fq;
#pragma unroll
        for (int ai = 0; ai < 2; ++ai)
#pragma unroll
            for (int m = 0; m < 4; ++m) { unsigned char* rowp = O + (size_t)(row0 + ai * HALF + m * 16) * ldc + col0;
                const f32x4 g0 = acc[ai][0][m][0] * inv, g1 = acc[ai][0][m][1] * inv, u0 = acc[ai][1][m][0] * (inv * oscale), u1 = acc[ai][1][m][1] * (inv * oscale);
                u32x2 w; w.x = pk4_fp8(silu_f(g0[0]) * u0[0], silu_f(g0[1]) * u0[1], silu_f(g0[2]) * u0[2], silu_f(g0[3]) * u0[3]);
                w.y = pk4_fp8(silu_f(g1[0]) * u1[0], silu_f(g1[1]) * u1[1], silu_f(g1[2]) * u1[2], silu_f(g1[3]) * u1[3]);
                *(u32x2*)rowp = w; }
    }
};
template <class Epi, class Sched, bool ALIGN_EPI = false, bool SP2 = false, bool FP8 = false>
__device__ __forceinline__ void gemm_phase(PG8_LAS unsigned char* lds, const Gemm g, const Sched& S, const Epi& E) {
    int tid_ = threadIdx.x; asm volatile("" : "+v"(tid_));
    const int tid = tid_, wid = __builtin_amdgcn_readfirstlane(tid >> 6), lane = tid & 63, wr = wid >> 2, wc = wid & 3, fr = lane & 15, fq = lane >> 4;
    const int K = g.K, nt = K / BK;
    unsigned voffA[2], voffB[2];
#pragma unroll
    for (int i = 0; i < 2; ++i) { int R, C; stage_rc(tid * 16 + i * 8192, R, C); const int Rb = Epi::PERM ? ((R & ~31) + perm32(R & 31)) : R;
        voffA[i] = (unsigned)(R * K + C) * 2u; voffB[i] = (unsigned)(Rb * K + C) * 2u; }
    const size_t kstep = (size_t)(BK * 2);
    const size_t hstep = (size_t)HALF * K * 2;
    const size_t tstep = 2 * hstep;
    const unsigned ldsw = (unsigned)wid * 1024u;
    const int aoff = lds_byte(wr * 64 + fr, fq * 8), boff = lds_byte(wc * 32 + fr, fq * 8);
#define PG8_SA(b, h) (((b) * 2 + (h)) * HTB)
#define PG8_SB(b, h) ((4 + (b) * 2 + (h)) * HTB)
#define PG8_STAGE(bufoff, gbase, voff) do { _Pragma("unroll") for (int _i = 0; _i < 2; ++_i) \
        __builtin_amdgcn_global_load_lds((const unsigned*)((const char*)(gbase) + (voff)[_i]), (PG8_LAS unsigned*)(lds + (bufoff) + ldsw + _i * 8192), 16, 0, 0); } while (0)
#define PG8_LDA(dst, b, h) do { if constexpr (FP8) { _Pragma("unroll") for (int m = 0; m < 4; ++m) dst##8[m] = __builtin_shufflevector(*(const PG8_LAS i32x4*)(lds + PG8_SA(b, h) + aoff + m * 2048), *(const PG8_LAS i32x4*)(lds + PG8_SA(b, h) + aoff + m * 2048 + 1024), 0, 1, 2, 3, 4, 5, 6, 7); } \
    else { _Pragma("unroll") for (int m = 0; m < 4; ++m) _Pragma("unroll") for (int k = 0; k < 2; ++k) dst[m][k] = *(const PG8_LAS bf16x8*)(lds + PG8_SA(b, h) + aoff + m * 2048 + k * 1024); } } while (0)
#define PG8_LDB(dst, b, h) do { if constexpr (FP8) { _Pragma("unroll") for (int n = 0; n < 2; ++n) dst##8[n] = __builtin_shufflevector(*(const PG8_LAS i32x4*)(lds + PG8_SB(b, h) + boff + n * 2048), *(const PG8_LAS i32x4*)(lds + PG8_SB(b, h) + boff + n * 2048 + 1024), 0, 1, 2, 3, 4, 5, 6, 7); } \
    else { _Pragma("unroll") for (int n = 0; n < 2; ++n) _Pragma("unroll") for (int k = 0; k < 2; ++k) dst[n][k] = *(const PG8_LAS bf16x8*)(lds + PG8_SB(b, h) + boff + n * 2048 + k * 1024); } } while (0)
#define PG8_MMA(ai, bj, At, Bt) do { __builtin_amdgcn_s_setprio(1); \
    if constexpr (FP8) { _Pragma("unroll") for (int m = 0; m < 4; ++m) _Pragma("unroll") for (int n = 0; n < 2; ++n) \
        asm volatile("v_mfma_scale_f32_16x16x128_f8f6f4 %0, %1, %2, %0, %3, %3 op_sel_hi:[0,0,0]" : "+v"(acc[ai][bj][m][n]) : "v"(Bt##8[n]), "v"(At##8[m]), "v"(fp8_unit_scale)); } \
    else { _Pragma("unroll") for (int m = 0; m < 4; ++m) _Pragma("unroll") for (int n = 0; n < 2; ++n) _Pragma("unroll") for (int k = 0; k < 2; ++k) \
        acc[ai][bj][m][n] = __builtin_amdgcn_mfma_f32_16x16x32_bf16(Bt[n][k], At[m][k], acc[ai][bj][m][n], 0, 0, 0); } \
    __builtin_amdgcn_s_setprio(0); } while (0)
#define PG8_WAIT_V(n) asm volatile("s_waitcnt vmcnt(" #n ")" ::: "memory")
#define PG8_WAIT_L(n) asm volatile("s_waitcnt lgkmcnt(" #n ")" ::: "memory")
#define PG8_BAR __builtin_amdgcn_s_barrier()
#define PG8_SCHED __builtin_amdgcn_sched_barrier(0)
    Unit cur, nxt; int ui = 0;
    if (!S.next(0, cur)) return;
    f32x4 acc[2][2][4][2];
#pragma unroll
    for (int a = 0; a < 2; ++a)
#pragma unroll
        for (int b = 0; b < 2; ++b)
#pragma unroll
            for (int m = 0; m < 4; ++m)
#pragma unroll
                for (int n = 0; n < 2; ++n) acc[a][b][m][n] = (f32x4){0.f, 0.f, 0.f, 0.f};
    const int fp8_unit_scale = 0x7f7f7f7f;
    bf16x8 At[4][2], B0[2][2], B1[2][2]; i32x8 At8[4], B08[2], B18[2];
    const char* cA = (const char*)g.A + (size_t)cur.pm * tstep; const char* cB = (const char*)g.Bt + (size_t)cur.pn * tstep;
    S.a_ready(cur);
    if constexpr (SP2) {
        PG8_STAGE(PG8_SB(0, 0), cB, voffB); PG8_STAGE(PG8_SB(0, 1), cB + hstep, voffB); PG8_STAGE(PG8_SA(0, 0), cA, voffA); PG8_STAGE(PG8_SA(0, 1), cA + hstep, voffA);
        if (wr == 1) PG8_BAR;
        PG8_WAIT_V(2); PG8_BAR;
        PG8_STAGE(PG8_SB(1, 0), cB + kstep, voffB); PG8_STAGE(PG8_SA(1, 0), cA + kstep, voffA); PG8_STAGE(PG8_SB(1, 1), cB + hstep + kstep, voffB);
        PG8_WAIT_V(6); PG8_BAR;
    } else {
        PG8_STAGE(PG8_SB(0, 0), cB, voffB); PG8_STAGE(PG8_SA(0, 0), cA, voffA); PG8_STAGE(PG8_SB(0, 1), cB + hstep, voffB); PG8_STAGE(PG8_SA(0, 1), cA + hstep, voffA);
        if (wr == 1) PG8_BAR;
        PG8_WAIT_V(4); PG8_BAR;
        PG8_STAGE(PG8_SB(1, 0), cB + kstep, voffB); PG8_STAGE(PG8_SA(1, 0), cA + kstep, voffA); PG8_STAGE(PG8_SB(1, 1), cB + hstep + kstep, voffB);
        PG8_WAIT_V(6); PG8_BAR;
    }
    for (;;) {
        const bool has_next = S.next(ui + 1, nxt);
        const char* nA = has_next ? (const char*)g.A + (size_t)nxt.pm * tstep : cA; const char* nB = has_next ? (const char*)g.Bt + (size_t)nxt.pn * tstep : cB;
_Pragma("unroll 1")
        for (int t = 0; t < nt; t += 2) {
            const bool last = (t == nt - 2);
            const char* a1 = cA + (size_t)(t + 1) * kstep;
            const char* a2 = last ? nA : cA + (size_t)(t + 2) * kstep; const char* b2 = last ? nB : cB + (size_t)(t + 2) * kstep;
            const char* a3 = a2 + kstep; const char* b3 = b2 + kstep;
            if (last && has_next) S.a_ready(nxt);
            if constexpr (SP2) {
            PG8_LDB(B0, 0, 0); PG8_LDB(B1, 0, 1); PG8_SCHED; PG8_LDA(At, 0, 0); PG8_STAGE(PG8_SA(1, 1), a1 + hstep, voffA);
            PG8_WAIT_V(8); PG8_WAIT_L(0); PG8_BAR; PG8_MMA(0, 0, At, B0); PG8_MMA(0, 1, At, B1); PG8_BAR; PG8_SCHED;
            PG8_LDA(At, 0, 1); PG8_STAGE(PG8_SB(0, 0), b2, voffB); PG8_STAGE(PG8_SB(0, 1), b2 + hstep, voffB); PG8_STAGE(PG8_SA(0, 0), a2, voffA);
            PG8_WAIT_V(8); PG8_WAIT_L(0); PG8_BAR; PG8_MMA(1, 0, At, B0); PG8_MMA(1, 1, At, B1); PG8_BAR; PG8_SCHED;
            PG8_LDB(B0, 1, 0); PG8_LDB(B1, 1, 1); PG8_SCHED; PG8_LDA(At, 1, 0); PG8_STAGE(PG8_SA(0, 1), a2 + hstep, voffA);
            PG8_WAIT_V(8); PG8_WAIT_L(0); PG8_BAR; PG8_MMA(0, 0, At, B0); PG8_MMA(0, 1, At, B1); PG8_BAR; PG8_SCHED;
            PG8_LDA(At, 1, 1); PG8_STAGE(PG8_SB(1, 0), b3, voffB); PG8_STAGE(PG8_SB(1, 1), b3 + hstep, voffB); PG8_STAGE(PG8_SA(1, 0), a3, voffA);
            PG8_WAIT_V(8); PG8_WAIT_L(0); PG8_BAR; PG8_MMA(1, 0, At, B0); PG8_MMA(1, 1, At, B1); PG8_BAR; PG8_SCHED;
            } else {
            PG8_LDB(B0, 0, 0); PG8_SCHED; PG8_LDA(At, 0, 0); PG8_STAGE(PG8_SA(1, 1), a1 + hstep, voffA);
            PG8_WAIT_L(8); PG8_BAR; PG8_WAIT_L(0); PG8_MMA(0, 0, At, B0); PG8_BAR; PG8_SCHED;
            PG8_LDB(B1, 0, 1); PG8_STAGE(PG8_SB(0, 0), b2, voffB);
            PG8_BAR; PG8_WAIT_L(0); PG8_MMA(0, 1, At, B1); PG8_BAR;
            PG8_LDA(At, 0, 1); PG8_STAGE(PG8_SA(0, 0), a2, voffA);
            PG8_BAR; PG8_WAIT_L(0); PG8_MMA(1, 0, At, B0); PG8_BAR; PG8_SCHED;
            PG8_STAGE(PG8_SB(0, 1), b2 + hstep, voffB);
            PG8_WAIT_V(6); PG8_BAR; PG8_MMA(1, 1, At, B1); PG8_BAR;
            PG8_LDB(B0, 1, 0); PG8_SCHED; PG8_LDA(At, 1, 0); PG8_STAGE(PG8_SA(0, 1), a2 + hstep, voffA);
            PG8_WAIT_L(8); PG8_BAR; PG8_WAIT_L(0); PG8_MMA(0, 0, At, B0); PG8_BAR; PG8_SCHED;
            PG8_LDB(B1, 1, 1); PG8_STAGE(PG8_SB(1, 0), b3, voffB);
            PG8_BAR; PG8_WAIT_L(0); PG8_MMA(0, 1, At, B1); PG8_BAR;
            PG8_LDA(At, 1, 1); PG8_STAGE(PG8_SA(1, 0), a3, voffA);
            PG8_BAR; PG8_WAIT_L(0); PG8_MMA(1, 0, At, B0); PG8_BAR; PG8_SCHED;
            PG8_STAGE(PG8_SB(1, 1), b3 + hstep, voffB);
            PG8_WAIT_V(6); PG8_BAR; PG8_MMA(1, 1, At, B1); PG8_BAR;
            }
        }
        if constexpr (FP8) { asm volatile("s_nop 15\n\ts_nop 15" ::: "memory"); }
        if constexpr (ALIGN_EPI) { if (wr == 0) PG8_BAR; }
        if constexpr (!Epi::AFTER_DRAIN) { E(acc, cur, wr, wc, fr, fq); S.done(cur); }
        if (!has_next) break;
#pragma unroll
        for (int a = 0; a < 2; ++a)
#pragma unroll
            for (int b = 0; b < 2; ++b)
#pragma unroll
                for (int m = 0; m < 4; ++m)
#pragma unroll
                    for (int n = 0; n < 2; ++n) acc[a][b][m][n] = (f32x4){0.f, 0.f, 0.f, 0.f};
        cur = nxt; cA = nA; cB = nB; ++ui;
        if constexpr (ALIGN_EPI) { if (wr == 1) PG8_BAR; }
    }
    PG8_WAIT_V(0);
    if constexpr (!ALIGN_EPI) { if (wr == 0) PG8_BAR; }
    PG8_BAR;
    if constexpr (Epi::AFTER_DRAIN) { E.fused(acc, cur, wr, wc, fr, fq, lds, wid, lane); S.done(cur); }
#undef PG8_SA
#undef PG8_SB
#undef PG8_STAGE
#undef PG8_LDA
#undef PG8_LDB
#undef PG8_MMA
#undef PG8_WAIT_V
#undef PG8_WAIT_L
#undef PG8_BAR
#undef PG8_SCHED
}
}
constexpr int NB = 4, SEQ = 4096, D = 1024, CTXL = 256, DEPTH = 2, GRIDW = 64, NROWS = 64;
constexpr int MX = NB * SEQ, MC = NB * CTXL, MT = MX + MC;
constexpr int NIN = 2560, NE = 16, FH = 2816, CAPX = 512, CAPC = 32, NMOD = 6;
constexpr int EROWS = 2304;
constexpr int ETILES = EROWS / 256, FNT = FH / 128;
constexpr int PQ = 0, PK = 512, PV = 1024, PBG = 1536, PCG = 1792, PU = 2048, PF = 2304;
constexpr float RMS_EPS = 1e-6f;
constexpr float S_ACT = 16.f, S_WGU = 256.f, S_HID = 4.f, S_WDN = 256.f;
constexpr int NWAVES = 8;

constexpr size_t MiB = 1u << 20;
constexpr size_t WS_CTL = 0, CTL_ZERO_BYTES = 1 * MiB;
constexpr size_t WS_MODX = 64 * 1024;
constexpr size_t WS_WINT = 2 * MiB;
constexpr size_t WS_WOUTT = 12 * MiB;
constexpr size_t WS_WGUT = 16 * MiB;
constexpr size_t WS_WDT = 368 * MiB;
constexpr size_t WS_H = 544 * MiB;
constexpr size_t WS_P = 578 * MiB;
constexpr size_t WS_NA = 663 * MiB;
constexpr size_t WS_FO = 680 * MiB;
constexpr size_t WS_TT = 697 * MiB;
constexpr size_t WS_GC = 729 * MiB;
constexpr size_t WS_Y = 731 * MiB;
constexpr size_t WS_MO = 765 * MiB;
constexpr size_t WS_HID = 578 * MiB;
constexpr size_t WS_X1 = 833 * MiB;
constexpr size_t WS_X2 = 901 * MiB;
constexpr size_t WS_H2 = 969 * MiB;
constexpr size_t WS_AFF = 1003 * MiB;
constexpr size_t WS_SLOT = 1005 * MiB;
constexpr size_t WS_XS = 1007 * MiB;
constexpr size_t WS_YE = 1079 * MiB;
constexpr size_t WS_END = 1151 * MiB;
static_assert(WS_HID + (size_t)NE * EROWS * FH * 2 <= WS_X1, "HID overlay");
static_assert(WS_MODX + (size_t)DEPTH * 5 * NMOD * D * 4 <= CTL_ZERO_BYTES, "MODX inside memset region");
constexpr int CW_BAR = 4096;

constexpr int RING_OFF = 0, RING_BYTES = 131072;
constexpr int LDSCTL_OFF = RING_BYTES, MISC_OFF = LDSCTL_OFF + 320;
constexpr int TW64_OFF = LDSCTL_OFF + 512, TW256_OFF = LDSCTL_OFF + 1024;
constexpr int CT_OFF = LDSCTL_OFF + 4096, ST_OFF = LDSCTL_OFF + 12288;
constexpr int RPB_OFF = LDSCTL_OFF + 20480;
constexpr int LDS_BYTES = LDSCTL_OFF + 20480 + 7680;
#define GAS __attribute__((address_space(1)))
#define LAS __attribute__((address_space(3)))
typedef unsigned short bf16;
typedef unsigned v4u __attribute__((ext_vector_type(4)));
typedef float f32x4 __attribute__((ext_vector_type(4)));
typedef short bf16x8 __attribute__((ext_vector_type(8)));
typedef GAS unsigned gu32;
typedef GAS unsigned long long gu64;
#define RLX_AGENT __ATOMIC_RELAXED, __HIP_MEMORY_SCOPE_AGENT
#define LDS_WAIT() asm volatile("s_waitcnt lgkmcnt(0)" ::: "memory")
#define VM_WAIT() asm volatile("s_waitcnt vmcnt(0)" ::: "memory")
__device__ __forceinline__ unsigned long long rt() { return __builtin_amdgcn_s_memrealtime(); }
__device__ __forceinline__ unsigned f2bf(float f) { unsigned u = __builtin_bit_cast(unsigned, f); return (u + 0x7fffu + ((u >> 16) & 1u)) >> 16; }
__device__ __forceinline__ unsigned pk2(float lo, float hi) { return f2bf(lo) | (f2bf(hi) << 16); }

#define XB_TMO      128
#define XB_XCNT(j)  (256  + 64 * (j))
#define XB_XSUB(j)  (1280 + 64 * (j))
#define XB_XGEN(j)  (2304 + 64 * (j))
#define XB_TOP      3328
#define XB_TOPGEN   3392
#define XCD_BAR_WORDS 3456
#define XB_SPIN_CAP (1u << 18)

__device__ __forceinline__ unsigned xb_ld(unsigned* p)              { return __hip_atomic_load(p, __ATOMIC_RELAXED, __HIP_MEMORY_SCOPE_AGENT); }
__device__ __forceinline__ unsigned xb_add(unsigned* p, unsigned v) { return __hip_atomic_fetch_add(p, v, __ATOMIC_RELAXED, __HIP_MEMORY_SCOPE_AGENT); }
__device__ __forceinline__ unsigned xb_xcc_id() { return (unsigned)__builtin_amdgcn_s_getreg((3 << 11) | 20) & 0xFu; }
#define XB_SPIN(cond, bar) do { unsigned _sp = 0; while (cond) { __builtin_amdgcn_s_sleep(1); \
    if ((++_sp & 255u) == 0u) { if (xb_ld(&(bar)[XB_TMO])) break; if (_sp > XB_SPIN_CAP) { atomicAdd(&(bar)[XB_TMO], 1u); break; } } } } while (0)

struct XcdBarrier {
    unsigned* bar; unsigned x;
    volatile LAS unsigned* st;
};

__device__ __forceinline__ XcdBarrier xcd_barrier_post(unsigned* bar, volatile LAS unsigned* st) {
    XcdBarrier b; b.bar = bar; b.x = xb_xcc_id(); b.st = st;
    if (threadIdx.x == 0) (void)xb_add(&bar[XB_XCNT(b.x)], 1u);
    return b;
}
__device__ __forceinline__ void xcd_barrier_complete(unsigned* bar, unsigned x, unsigned& nloc, unsigned& nx) {
    const unsigned G = gridDim.x * gridDim.y * gridDim.z;
    unsigned sum, cnt, mine, sp = 0u;
    for (;;) {
        sum = 0u; cnt = 0u; mine = 0u;
#pragma unroll
        for (unsigned j = 0; j < 16; ++j) { const unsigned c = xb_ld(&bar[XB_XCNT(j)]); sum += c; cnt += (c > 0u) ? 1u : 0u; mine = (j == x) ? c : mine; }
        if (sum == G) break;
        __builtin_amdgcn_s_sleep(1);
        if ((++sp & 255u) == 0u) { if (xb_ld(&bar[XB_TMO])) break; if (sp > XB_SPIN_CAP) { atomicAdd(&bar[XB_TMO], 1u); break; } }
    }
    nloc = mine > 0u ? mine : 1u; nx = cnt > 0u ? cnt : 1u;
}

__device__ __forceinline__ void xcd_barrier(const XcdBarrier& b) {
    asm volatile("s_waitcnt vmcnt(0)" ::: "memory");
    __syncthreads();
    if (threadIdx.x == 0) {
        unsigned* bar = b.bar;
        __builtin_amdgcn_s_waitcnt(0);
        unsigned nloc = b.st[0], nx = b.st[1];
        if (nloc == 0u) { xcd_barrier_complete(bar, b.x, nloc, nx); b.st[0] = nloc; b.st[1] = nx; }
        const unsigned old = xb_add(&bar[XB_XSUB(b.x)], 1u);
        const unsigned gen = old / nloc;
        if (old + 1u == (gen + 1u) * nloc) {
            __builtin_amdgcn_fence(__ATOMIC_RELEASE, "agent");
            asm volatile("s_waitcnt vmcnt(0)" ::: "memory");
            const unsigned og = xb_add(&bar[XB_TOP], 1u);
            const unsigned tg = og / nx;
            if (og + 1u == (tg + 1u) * nx) xb_add(&bar[XB_TOPGEN], 1u);
            else XB_SPIN(xb_ld(&bar[XB_TOPGEN]) == tg, bar);
            __builtin_amdgcn_fence(__ATOMIC_ACQUIRE, "agent");
            xb_add(&bar[XB_XGEN(b.x)], 1u);
            asm volatile("s_waitcnt vmcnt(0)" ::: "memory");
        } else {
            XB_SPIN(xb_ld(&bar[XB_XGEN(b.x)]) == gen, bar);
            __builtin_amdgcn_fence(__ATOMIC_ACQUIRE, "agent");
            asm volatile("s_waitcnt vmcnt(0)" ::: "memory");
        }
    }
    __syncthreads();
}
typedef LAS float lfloat;
typedef float f32x2 __attribute__((ext_vector_type(2)));
typedef unsigned u32x2 __attribute__((ext_vector_type(2)));
__device__ __forceinline__ float bflo(unsigned w) { return __uint_as_float(w << 16); }
__device__ __forceinline__ float bfhi(unsigned w) { return __uint_as_float(w & 0xffff0000u); }
__device__ __forceinline__ float bf2f(bf16 h) { return __uint_as_float((unsigned)h << 16); }
__device__ __forceinline__ float wave_sum(float v) {
#pragma unroll
    for (int o = 1; o < 64; o <<= 1) v += __shfl_xor(v, o);
    return v;
}
__device__ __forceinline__ float wave_max(float v) {
#pragma unroll
    for (int o = 1; o < 64; o <<= 1) v = fmaxf(v, __shfl_xor(v, o));
    return v;
}
__device__ __forceinline__ float silu(float x) { return x / (1.0f + __expf(-x)); }

struct Ctx {
    unsigned char* ws; LAS unsigned char* lds;
    int tid, lane, wave, G, gw, NGW;
};
#define IN_X 0
#define IN_C 1
#define IN_CTX 2
#define IN_CCTX 3
#define IN_WMOD 4
#define IN_BMOD 5
#define IN_GPREMIX 6
#define IN_GPOSTMIX 7
#define IN_GPREFFN 8
#define IN_GPOSTFFN 9
#define IN_WIN 10
#define IN_RPB 11
#define IN_CONVW 12
#define IN_GMIXOUT 13
#define IN_WOUT 14
#define IN_WROUTER 15
#define IN_WGATE 16
#define IN_WUP 17
#define IN_WDOWN 18

__device__ __forceinline__ int mod_row(int row) { return row < MX ? (row >> 12) : 4; }
__device__ __forceinline__ const float* modx(const Ctx& C, int layer, int mr, int which) { return (const float*)(C.ws + WS_MODX) + ((size_t)(layer * 5 + mr) * NMOD + which) * D; }

__device__ __forceinline__ void transpose_item(const float* W, int K, int N, bf16* WT, int item, int mode, lfloat* scr, int lane) {
    const int nblk = N / 32, kb = item / nblk, nb = item % nblk, k0 = 64 * kb, n0 = 32 * nb;
#pragma unroll 8
    for (int i = 0; i < 32; ++i) { const int kk = 2 * i + (lane >> 5); scr[kk * 33 + (lane & 31)] = W[(size_t)(k0 + kk) * N + n0 + (lane & 31)]; }
    LDS_WAIT(); asm volatile("" ::: "memory");
    const int rowbase = mode == 0 ? n0 : ((n0 >> 7) * 256 + (n0 & 127) + (mode == 2 ? 128 : 0));
    const int c = lane & 7;
#pragma unroll
    for (int j = 0; j < 4; ++j) { const int n = (lane >> 3) + 8 * j; const lfloat* s = scr + (8 * c) * 33 + n;
        v4u o; o.x = pk2(s[0 * 33], s[1 * 33]); o.y = pk2(s[2 * 33], s[3 * 33]); o.z = pk2(s[4 * 33], s[5 * 33]); o.w = pk2(s[6 * 33], s[7 * 33]);
        *(GAS v4u*)(WT + (size_t)(rowbase + n) * K + k0 + 8 * c) = o; }
    LDS_WAIT(); asm volatile("" ::: "memory");
}
__device__ __forceinline__ void transpose_item8(const float* W, int K, int N, unsigned char* WT, int item, int mode, float scale, lfloat* scr, int lane) {
    const int nblk = N / 32, kb = item / nblk, nb = item % nblk, k0 = 64 * kb, n0 = 32 * nb;
#pragma unroll 8
    for (int i = 0; i < 32; ++i) { const int kk = 2 * i + (lane >> 5); scr[kk * 33 + (lane & 31)] = W[(size_t)(k0 + kk) * N + n0 + (lane & 31)] * scale; }
    LDS_WAIT(); asm volatile("" ::: "memory");
    const int rowbase = mode == 0 ? n0 : ((n0 >> 7) * 256 + (n0 & 127) + (mode == 2 ? 128 : 0));
    const int c = lane & 3;
#pragma unroll
    for (int j = 0; j < 2; ++j) { const int n = (lane >> 2) + 16 * j; const lfloat* s = scr + (16 * c) * 33 + n;
        v4u o; o.x = pg8::pk4_fp8(s[0 * 33], s[1 * 33], s[2 * 33], s[3 * 33]); o.y = pg8::pk4_fp8(s[4 * 33], s[5 * 33], s[6 * 33], s[7 * 33]);
        o.z = pg8::pk4_fp8(s[8 * 33], s[9 * 33], s[10 * 33], s[11 * 33]); o.w = pg8::pk4_fp8(s[12 * 33], s[13 * 33], s[14 * 33], s[15 * 33]);
        *(GAS v4u*)(WT + (size_t)(rowbase + n) * K + k0 + 16 * c) = o; }
    LDS_WAIT(); asm volatile("" ::: "memory");
}
constexpr int IT_WIN = (D / 64) * (NIN / 32), IT_WOUT = (D / 64) * (D / 32), IT_GU = (D / 64) * (FH / 32), IT_DN = (FH / 64) * (D / 32);
constexpr int N_T_ITEMS = DEPTH * IT_WIN + DEPTH * IT_WOUT + DEPTH * NE * (2 * IT_GU + IT_DN);
__device__ __forceinline__ void p0_prologue(const Ctx& C, const float* const (&in)[19]) {
    {
        lfloat* part = (lfloat*)(C.lds + RING_OFF);
        for (int it = blockIdx.x; it < DEPTH * (NMOD * D / 64); it += C.G) {
            const int l = it / (NMOD * D / 64), cb = it % (NMOD * D / 64), col = cb * 64 + C.lane;
            const float* wm = in[IN_WMOD] + (size_t)l * D * NMOD * D + col;
            float acc[5] = {0.f, 0.f, 0.f, 0.f, 0.f};
#pragma unroll 8
            for (int k = C.wave * 128; k < C.wave * 128 + 128; ++k) {
                const float wv = wm[(size_t)k * (NMOD * D)];
#pragma unroll
                for (int r = 0; r < 4; ++r) acc[r] += silu(in[IN_C][r * D + k]) * wv;
                acc[4] += silu(in[IN_CCTX][k]) * wv;
            }
#pragma unroll
            for (int r = 0; r < 5; ++r) part[(C.wave * 5 + r) * 64 + C.lane] = acc[r];
            __syncthreads();
            if (C.wave < 5) { const int r = C.wave; float sum = in[IN_BMOD][l * NMOD * D + col];
#pragma unroll
                for (int w = 0; w < 8; ++w) sum += part[(w * 5 + r) * 64 + C.lane];
                ((float*)(C.ws + WS_MODX))[(size_t)(l * 5 + r) * NMOD * D + col] = sum; }
            __syncthreads();
        }
    }
    lfloat* scr = (lfloat*)(C.lds + RING_OFF + C.wave * 16384);
    bf16* WINT = (bf16*)(C.ws + WS_WINT); bf16* WOUTT = (bf16*)(C.ws + WS_WOUTT); unsigned char* WGUT = C.ws + WS_WGUT; unsigned char* WDT = C.ws + WS_WDT;
    for (int it = C.gw; it < N_T_ITEMS; it += C.NGW) {
        int r = it;
        if (r < DEPTH * IT_WIN) { const int l = r / IT_WIN; transpose_item(in[IN_WIN] + (size_t)l * D * NIN, D, NIN, WINT + (size_t)l * NIN * D, r % IT_WIN, 0, scr, C.lane); continue; } r -= DEPTH * IT_WIN;
        if (r < DEPTH * IT_WOUT) { const int l = r / IT_WOUT; transpose_item(in[IN_WOUT] + (size_t)l * D * D, D, D, WOUTT + (size_t)l * D * D, r % IT_WOUT, 0, scr, C.lane); continue; } r -= DEPTH * IT_WOUT;
        if (r < DEPTH * NE * IT_GU) { const int le = r / IT_GU; transpose_item8(in[IN_WGATE] + (size_t)le * D * FH, D, FH, WGUT + (size_t)le * 2 * FH * D, r % IT_GU, 1, S_WGU, scr, C.lane); continue; } r -= DEPTH * NE * IT_GU;
        if (r < DEPTH * NE * IT_GU) { const int le = r / IT_GU; transpose_item8(in[IN_WUP] + (size_t)le * D * FH, D, FH, WGUT + (size_t)le * 2 * FH * D, r % IT_GU, 2, S_WGU, scr, C.lane); continue; } r -= DEPTH * NE * IT_GU;
        { const int le = r / IT_DN; transpose_item8(in[IN_WDOWN] + (size_t)le * FH * D, FH, D, WDT + (size_t)le * D * FH, r % IT_DN, 0, S_WDN, scr, C.lane); }
    }
}

__device__ __forceinline__ void norm_mod_store(const f32x4 (&v)[4], float ss, const float* g, const float* sh, const float* sc, bf16* orow, int lane) {
    const float rstd = 1.0f / sqrtf(ss * (1.f / D) + RMS_EPS);
#pragma unroll
    for (int j = 0; j < 4; ++j) {
        const f32x4 gg = ((const f32x4*)g)[lane + 64 * j], hh = ((const f32x4*)sh)[lane + 64 * j], cc = ((const f32x4*)sc)[lane + 64 * j];
        const f32x4 o = (v[j] * rstd * gg) * (cc + 1.0f) + hh;
        u32x2 w; w.x = pk2(o.x, o.y); w.y = pk2(o.z, o.w);
        ((u32x2*)orow)[lane + 64 * j] = w;
    }
}
__device__ __forceinline__ void p1_h0(const Ctx& C, const float* const (&in)[19]) {
    bf16* H = (bf16*)(C.ws + WS_H);
    for (int row = C.gw; row < MT; row += C.NGW) {
        const float* xr = row < MX ? in[IN_X] + (size_t)row * D : in[IN_CTX] + (size_t)(row - MX) * D;
        f32x4 v[4]; float ss = 0.f;
#pragma unroll
        for (int j = 0; j < 4; ++j) { v[j] = ((const f32x4*)xr)[C.lane + 64 * j]; ss += (v[j].x * v[j].x + v[j].y * v[j].y) + (v[j].z * v[j].z + v[j].w * v[j].w); }
        ss = wave_sum(ss);
        const int mr = mod_row(row);
        norm_mod_store(v, ss, in[IN_GPREMIX], modx(C, 0, mr, 0), modx(C, 0, mr, 1), H + (size_t)row * D, C.lane);
    }
}
__device__ __forceinline__ float dot64(const float (&q)[64], const bf16* krow) {
    const v4u* p = (const v4u*)krow; float a = 0.f;
#pragma unroll
    for (int t = 0; t < 8; ++t) { const v4u w = p[t];
        a += q[8 * t + 0] * bflo(w.x) + q[8 * t + 1] * bfhi(w.x) + q[8 * t + 2] * bflo(w.y) + q[8 * t + 3] * bfhi(w.y)
           + q[8 * t + 4] * bflo(w.z) + q[8 * t + 5] * bfhi(w.z) + q[8 * t + 6] * bflo(w.w) + q[8 * t + 7] * bfhi(w.w); }
    return a;
}
__device__ __forceinline__ void axpy64(float (&o)[64], float p, const bf16* vrow) {
    const v4u* pp = (const v4u*)vrow;
#pragma unroll
    for (int t = 0; t < 8; ++t) { const v4u w = pp[t];
        o[8 * t + 0] += p * bflo(w.x); o[8 * t + 1] += p * bfhi(w.x); o[8 * t + 2] += p * bflo(w.y); o[8 * t + 3] += p * bfhi(w.y);
        o[8 * t + 4] += p * bflo(w.z); o[8 * t + 5] += p * bfhi(w.z); o[8 * t + 6] += p * bflo(w.w); o[8 * t + 7] += p * bfhi(w.w); }
}
__device__ __forceinline__ void attn_key(const float (&q)[64], float (&o)[64], float& m, float& l, float bias, const bf16* P, int key, int head) {
    const float s = dot64(q, P + (size_t)key * NIN + PK + head * 64) + bias;
    if (s > m) { const float alpha = __expf(m - s); l *= alpha;
#pragma unroll
        for (int d = 0; d < 64; ++d) o[d] *= alpha;
        m = s; }
    const float p = __expf(s - m); l += p;
    axpy64(o, p, P + (size_t)key * NIN + PV + head * 64);
}
__device__ __forceinline__ void p_attn_naive(const Ctx& C, const float* const (&in)[19], int layer) {
    const bf16* P = (const bf16*)(C.ws + WS_P); bf16* NA = (bf16*)(C.ws + WS_NA);
    const float* rpb = in[IN_RPB] + (size_t)layer * 8 * 15 * 31;
    const int nitems = layer == 0 ? 2048 + 128 : 2048;
    for (int id = C.gw; id < nitems; id += C.NGW) {
        const bool isctx = id >= 2048;
        int b, h, r = 0, c = 0, qrow;
        if (!isctx) { b = id >> 9; r = (id >> 3) & 63; h = id & 7; c = C.lane; qrow = b * SEQ + r * 64 + c; }
        else { const int j = id - 2048; b = j >> 5; h = (j >> 2) & 7; qrow = MX + b * CTXL + (j & 3) * 64 + C.lane; }
        float q[64], o[64];
        { const v4u* p = (const v4u*)(P + (size_t)qrow * NIN + PQ + h * 64);
#pragma unroll
          for (int t = 0; t < 8; ++t) { const v4u w = p[t];
              q[8 * t + 0] = 0.125f * bflo(w.x); q[8 * t + 1] = 0.125f * bfhi(w.x); q[8 * t + 2] = 0.125f * bflo(w.y); q[8 * t + 3] = 0.125f * bfhi(w.y);
              q[8 * t + 4] = 0.125f * bflo(w.z); q[8 * t + 5] = 0.125f * bfhi(w.z); q[8 * t + 6] = 0.125f * bflo(w.w); q[8 * t + 7] = 0.125f * bfhi(w.w); } }
#pragma unroll
        for (int d = 0; d < 64; ++d) o[d] = 0.f;
        float m = -1e30f, l = 0.f;
        if (!isctx) {
            const int rs = min(max(r - 4, 0), NROWS - 8), cs = min(max(c - 8, 0), GRIDW - 16);
            for (int kr = 0; kr < 8; ++kr) {
                const float* bp = rpb + (size_t)h * 465 + (rs + kr - r + 7) * 31 + 15;
#pragma unroll 1
                for (int i = 0; i < 16; ++i) { const int dc = min(max(cs + i - c, -15), 15); attn_key(q, o, m, l, bp[dc], P, b * SEQ + (rs + kr) * 64 + cs + i, h); }
            }
        }
#pragma unroll 1
        for (int j = 0; j < CTXL; ++j) attn_key(q, o, m, l, 0.f, P, MX + b * CTXL + j, h);
        const float inv = 1.0f / l;
        v4u* op = (v4u*)(NA + (size_t)qrow * 512 + h * 64);
#pragma unroll
        for (int t = 0; t < 8; ++t) { v4u w; w.x = pk2(o[8 * t] * inv, o[8 * t + 1] * inv); w.y = pk2(o[8 * t + 2] * inv, o[8 * t + 3] * inv);
            w.z = pk2(o[8 * t + 4] * inv, o[8 * t + 5] * inv); w.w = pk2(o[8 * t + 6] * inv, o[8 * t + 7] * inv); op[t] = w; }
    }
}

typedef short v4i16_t __attribute__((ext_vector_type(4)));
__device__ __forceinline__ bf16x8 pack8(const f32x4& a, const f32x4& b) {
    v4u w; w.x = pk2(a[0], a[1]); w.y = pk2(a[2], a[3]); w.z = pk2(b[0], b[1]); w.w = pk2(b[2], b[3]); return __builtin_bit_cast(bf16x8, w);
}
__device__ __forceinline__ bf16x8 neg8(const bf16x8& a) { v4u w = __builtin_bit_cast(v4u, a); w.x ^= 0x80008000u; w.y ^= 0x80008000u; w.z ^= 0x80008000u; w.w ^= 0x80008000u; return __builtin_bit_cast(bf16x8, w); }
#define MFMA16(a, b, c) __builtin_amdgcn_mfma_f32_16x16x32_bf16((a), (b), (c), 0, 0, 0)
constexpr float LOG2E = 1.4426950408889634f;
template <int NI>
__device__ __forceinline__ void attn_load_tile(LAS unsigned char* dst_lane, const bf16* src, unsigned lofs) {
#pragma unroll
    for (int i = 0; i < NI; ++i) { const char* bi = (const char*)src + (size_t)i * (8 * NIN * 2);
        const v4u w = *(const v4u*)(bi + lofs);
        *(LAS v4u*)(dst_lane + i * 1024) = w; }
}
struct AttnAddr { const LAS unsigned char* k[2]; const LAS unsigned char* v[4]; };
__device__ __forceinline__ AttnAddr attn_addr(const LAS unsigned char* KL, const LAS unsigned char* VL, int lr, int lq) {
    AttnAddr A;
#pragma unroll
    for (int ks = 0; ks < 2; ++ks) A.k[ks] = KL + lr * 128 + (((4 * ks + lq) ^ (lr & 7)) << 4);
    const int qq = lr >> 2, p = lr & 3, row = 4 * lq + qq;
#pragma unroll
    for (int dt = 0; dt < 4; ++dt) A.v[dt] = VL + row * 128 + (((2 * dt + (p >> 1)) ^ (row & 7)) << 4) + 8 * (p & 1);
    return A;
}
__device__ __forceinline__ bf16x8 attn_v_op(const LAS unsigned char* va, int kb0, int kb1) {
    const v4i16_t lo = __builtin_amdgcn_ds_read_tr16_b64_v4i16((LAS v4i16_t*)(va + kb0 * 128));
    const v4i16_t hi = __builtin_amdgcn_ds_read_tr16_b64_v4i16((LAS v4i16_t*)(va + kb1 * 128));
    return (bf16x8){lo[0], lo[1], lo[2], lo[3], hi[0], hi[1], hi[2], hi[3]};
}
__device__ __forceinline__ float xmax4(float v) { v = fmaxf(v, __shfl_xor(v, 16)); v = fmaxf(v, __shfl_xor(v, 32)); return v; }
template <int NT, bool WIN, int KB>
__device__ __forceinline__ void attn_block(const AttnAddr& A, const bf16x8 (&QB)[2], f32x4 (&O)[4], float& m, float& l, int lo, const LAS bf16* bias, int lq) {
    const f32x4 z4 = (f32x4){0.f, 0.f, 0.f, 0.f};
    constexpr float SC = 0.125f * LOG2E;
    float s[NT][4]; float mc = -1e30f;
#pragma unroll
    for (int t = 0; t < NT; ++t) {
        f32x4 a = MFMA16(*(const LAS bf16x8*)(A.k[0] + (KB + 16 * t) * 128), QB[0], z4);
        a = MFMA16(*(const LAS bf16x8*)(A.k[1] + (KB + 16 * t) * 128), QB[1], a);
#pragma unroll
        for (int r = 0; r < 4; ++r) { const int kk = 16 * t + 4 * lq + r; float v = a[r] * SC;
            if (WIN) { v += bf2f(bias[kk]); v = ((unsigned)(kk - lo) < 16u) ? v : -1e30f; }
            s[t][r] = v; mc = fmaxf(mc, v); }
        asm volatile("" ::: "memory");
    }
    mc = xmax4(mc);
    const float mn = fmaxf(m, mc), alpha = __builtin_amdgcn_exp2f(m - mn); m = mn;
    float ps = 0.f;
#pragma unroll
    for (int t = 0; t < NT; ++t)
#pragma unroll
        for (int r = 0; r < 4; ++r) { s[t][r] = __builtin_amdgcn_exp2f(s[t][r] - mn); ps += s[t][r]; }
    l = l * alpha + ps;
#pragma unroll
    for (int dt = 0; dt < 4; ++dt) O[dt] = O[dt] * alpha;
#pragma unroll
    for (int kp = 0; kp < NT / 2; ++kp) {
        const bf16x8 bp = pack8((f32x4){s[2 * kp][0], s[2 * kp][1], s[2 * kp][2], s[2 * kp][3]}, (f32x4){s[2 * kp + 1][0], s[2 * kp + 1][1], s[2 * kp + 1][2], s[2 * kp + 1][3]});
#pragma unroll
        for (int dt = 0; dt < 4; ++dt) { O[dt] = MFMA16(attn_v_op(A.v[dt], KB + 32 * kp, KB + 32 * kp + 16), bp, O[dt]); if (dt & 1) asm volatile("" ::: "memory"); }
    }
}
__device__ __forceinline__ void p_attn(const Ctx& C, const float* const (&in)[19], int layer) {
    const bf16* P = (const bf16*)(C.ws + WS_P); bf16* NA = (bf16*)(C.ws + WS_NA);
    LAS unsigned char* KL = C.lds + RING_OFF + C.wave * 16384; LAS unsigned char* VL = KL + 8192;
    LAS bf16* RPB = (LAS bf16*)(C.lds + RPB_OFF) + 32;
    { const float* rpb = in[IN_RPB] + (size_t)layer * 8 * 465;
      for (int u = C.tid; u < 8 * 465; u += NWAVES * 64) RPB[u] = (bf16)f2bf(rpb[u] * LOG2E);
      __syncthreads(); }
    const int lane = C.lane, lr = lane & 15, lq = lane >> 4;
    const AttnAddr AD = attn_addr(KL, VL, lr, lq);
    const unsigned lofs = (unsigned)(((lane >> 3) * NIN + (lane & 7) * 8) * 2);
    LAS unsigned char* kdst = KL + (lane >> 3) * 128 + (((lane & 7) ^ ((lane >> 3) & 7)) << 4); LAS unsigned char* vdst = kdst + 8192;
    const int nitems = layer == 0 ? 4096 + 256 : 4096;
    for (int id = C.gw; id < nitems; id += C.NGW) {
        const bool isctx = id >= 4096;
        int b, h, r = 0, half = 0, qtok0;
        if (!isctx) { b = id >> 10; r = (id >> 4) & 63; h = (id >> 1) & 7; half = id & 1; qtok0 = b * SEQ + r * 64 + 32 * half; }
        else { const int j = id - 4096; b = j >> 6; h = (j >> 3) & 7; qtok0 = MX + b * CTXL + (j & 7) * 32; }
        bf16x8 QB[2][2];
#pragma unroll
        for (int qb = 0; qb < 2; ++qb) { const bf16* qp = P + (size_t)(qtok0 + 16 * qb + lr) * NIN + PQ + h * 64 + 8 * lq; QB[qb][0] = *(const bf16x8*)qp; QB[qb][1] = *(const bf16x8*)(qp + 32); }
        f32x4 O[2][4]; float m[2], l[2];
#pragma unroll
        for (int qb = 0; qb < 2; ++qb) { m[qb] = -1e30f; l[qb] = 0.f;
#pragma unroll
            for (int dt = 0; dt < 4; ++dt) O[qb][dt] = (f32x4){0.f, 0.f, 0.f, 0.f}; }
        if (!isctx) {
            const int rs = min(max(r - 4, 0), NROWS - 8), kc0 = 24 * half;
#pragma unroll 1
            for (int kr = 0; kr < 8; ++kr) {
                const bf16* src = P + (size_t)(b * SEQ + (rs + kr) * 64 + kc0) * NIN + h * 64;
                attn_load_tile<5>(kdst, src + PK, lofs); attn_load_tile<5>(vdst, src + PV, lofs);
                LDS_WAIT(); asm volatile("" ::: "memory");
                const LAS bf16* brow = RPB + h * 465 + (rs + kr - r + 7) * 31;
#define ATTN_WIN(qb, ks0) { const int c = 32 * half + 16 * (qb) + lr, cs = min(max(c - 8, 0), GRIDW - 16); attn_block<2, true, ks0>(AD, QB[qb], O[qb], m[qb], l[qb], cs - (kc0 + (ks0)), brow + ((kc0 + (ks0)) - c + 15), lq); __builtin_amdgcn_sched_barrier(0); }
                ATTN_WIN(0, 0) ATTN_WIN(1, 8)
#undef ATTN_WIN
                LDS_WAIT(); asm volatile("" ::: "memory");
            }
        }
#pragma unroll 1
        for (int cc = 0; cc < 4; ++cc) {
            const bf16* src = P + (size_t)(MX + b * CTXL + cc * 64) * NIN + h * 64;
            attn_load_tile<8>(kdst, src + PK, lofs); attn_load_tile<8>(vdst, src + PV, lofs);
            LDS_WAIT(); asm volatile("" ::: "memory");
#pragma unroll
            for (int qb = 0; qb < 2; ++qb) { attn_block<4, false, 0>(AD, QB[qb], O[qb], m[qb], l[qb], 0, RPB, lq); __builtin_amdgcn_sched_barrier(0); }
            LDS_WAIT(); asm volatile("" ::: "memory");
        }
#pragma unroll
        for (int qb = 0; qb < 2; ++qb) {
            float lt = l[qb]; lt += __shfl_xor(lt, 16); lt += __shfl_xor(lt, 32);
            const float inv = 1.0f / lt;
            bf16* op = NA + (size_t)(qtok0 + 16 * qb + lr) * 512 + h * 64 + 4 * lq;
#pragma unroll
            for (int dt = 0; dt < 4; ++dt) { u32x2 w; w.x = pk2(O[qb][dt][0] * inv, O[qb][dt][1] * inv); w.y = pk2(O[qb][dt][2] * inv, O[qb][dt][3] * inv); *(u32x2*)(op + 16 * dt) = w; }
        }
    }
}

__device__ __forceinline__ void p_fft_a(const Ctx& C) {
    const bf16* P = (const bf16*)(C.ws + WS_P); bf16* TT = (bf16*)(C.ws + WS_TT);
    const LAS unsigned char* CT = C.lds + CT_OFF; const LAS unsigned char* ST = C.lds + ST_OFF;
    const int lane = C.lane, lr = lane & 15, lq = lane >> 4;
    const f32x4 z4 = (f32x4){0.f, 0.f, 0.f, 0.f};
    for (int id = C.gw; id < NB * 4 * 64; id += C.NGW) {
        const int b = id >> 8, g = (id >> 6) & 3, n2 = id & 63;
        bf16x8 FA[4][2];
#pragma unroll
        for (int mt = 0; mt < 4; ++mt) { const int n1 = 32 * (mt >> 1) + 8 * (lr >> 2) + 4 * (mt & 1) + (lr & 3);
            const bf16* fr = P + (size_t)(b * SEQ + 64 * n1 + n2) * NIN + PF + g * 64 + 8 * lq;
            FA[mt][0] = *(const bf16x8*)fr; FA[mt][1] = *(const bf16x8*)(fr + 32); }
        float tcs[4][4], tsn[4][4];
#pragma unroll
        for (int kt = 0; kt < 4; ++kt)
#pragma unroll
            for (int r = 0; r < 4; ++r) sincospif((float)((16 * kt + 4 * lq + r) * n2) * (1.0f / 2048.0f), &tsn[kt][r], &tcs[kt][r]);
#pragma unroll 1
        for (int jt = 0; jt < 4; ++jt) {
            bf16x8 cb[2], sb[2];
#pragma unroll
            for (int ks = 0; ks < 2; ++ks) { cb[ks] = *(const LAS bf16x8*)(CT + (16 * jt + lr) * 128 + (32 * ks + 8 * lq) * 2); sb[ks] = *(const LAS bf16x8*)(ST + (16 * jt + lr) * 128 + (32 * ks + 8 * lq) * 2); }
            f32x4 gr[4], gi[4];
#pragma unroll
            for (int mt = 0; mt < 4; ++mt) { gr[mt] = MFMA16(FA[mt][0], cb[0], z4); gr[mt] = MFMA16(FA[mt][1], cb[1], gr[mt]); gi[mt] = MFMA16(FA[mt][0], sb[0], z4); gi[mt] = MFMA16(FA[mt][1], sb[1], gi[mt]); }
            bf16x8 BGr[2], BGi[2], BnGi[2];
#pragma unroll
            for (int p = 0; p < 2; ++p) { BGr[p] = pack8(gr[2 * p], gr[2 * p + 1]); BGi[p] = pack8(gi[2 * p], gi[2 * p + 1]); BnGi[p] = neg8(BGi[p]); }
#pragma unroll
            for (int kt = 0; kt < 4; ++kt) {
                f32x4 tr = z4, nti = z4;
#pragma unroll
                for (int p = 0; p < 2; ++p) { const bf16x8 ca = *(const LAS bf16x8*)(CT + (16 * kt + lr) * 128 + (32 * p + 8 * lq) * 2), sa = *(const LAS bf16x8*)(ST + (16 * kt + lr) * 128 + (32 * p + 8 * lq) * 2);
                    tr = MFMA16(ca, BGr[p], tr); tr = MFMA16(sa, BnGi[p], tr); nti = MFMA16(ca, BGi[p], nti); nti = MFMA16(sa, BGr[p], nti); }
#pragma unroll
                for (int r = 0; r < 4; ++r) { const int k1 = 16 * kt + 4 * lq + r; const float cs = tcs[kt][r], sn = tsn[kt][r];
                    const float tpr = cs * tr[r] - sn * nti[r], tpi = -cs * nti[r] - sn * tr[r];
                    bf16* dst = TT + ((size_t)(((b * 4 + g) * 64 + k1) * 2) * 64 + n2) * 64 + 16 * jt + lr;
                    dst[0] = (bf16)f2bf(tpr); dst[64 * 64] = (bf16)f2bf(tpi); }
            }
        }
    }
}
__device__ __forceinline__ void p_fft_b(const Ctx& C) {
    const bf16* TT = (const bf16*)(C.ws + WS_TT); float* FO = (float*)(C.ws + WS_FO);
    const LAS unsigned char* CT = C.lds + CT_OFF; const LAS unsigned char* ST = C.lds + ST_OFF;
    LAS unsigned char* scr = C.lds + RING_OFF + C.wave * 16384;
    const int lane = C.lane, lr = lane & 15, lq = lane >> 4;
    const f32x4 z4 = (f32x4){0.f, 0.f, 0.f, 0.f};
    for (int id = C.gw; id < NB * 4 * 64; id += C.NGW) {
        const int b = id >> 8, g = (id >> 6) & 3, k1 = id & 63;
        const v4u* src = (const v4u*)(TT + (size_t)(((b * 4 + g) * 64 + k1) * 2) * 64 * 64);
#pragma unroll
        for (int i = 0; i < 16; ++i) { const v4u w = src[i * 64 + lane]; *(LAS v4u*)(scr + (i * 64 + lane) * 16) = w; }
        LDS_WAIT(); asm volatile("" ::: "memory");
        f32x4 acc[4][4];
#pragma unroll
        for (int kt = 0; kt < 4; ++kt)
#pragma unroll
            for (int jt = 0; jt < 4; ++jt) acc[kt][jt] = z4;
#pragma unroll
        for (int ri = 0; ri < 2; ++ri)
#pragma unroll
            for (int ks = 0; ks < 2; ++ks) {
                bf16x8 Bop[4];
#pragma unroll
                for (int jt = 0; jt < 4; ++jt) {
                    const int r0 = 32 * ks + 8 * lq; const LAS unsigned char* pa = scr + ri * 8192 + (r0 + (lr >> 2)) * 128 + (16 * jt + 4 * (lr & 3)) * 2;
                    const v4i16_t lo = __builtin_amdgcn_ds_read_tr16_b64_v4i16((LAS v4i16_t*)pa), hi = __builtin_amdgcn_ds_read_tr16_b64_v4i16((LAS v4i16_t*)(pa + 4 * 128));
                    Bop[jt] = (bf16x8){lo[0], lo[1], lo[2], lo[3], hi[0], hi[1], hi[2], hi[3]}; }
#pragma unroll
                for (int kt = 0; kt < 4; ++kt) { const bf16x8 aop = *(const LAS bf16x8*)((ri == 0 ? CT : ST) + (16 * kt + lr) * 128 + (32 * ks + 8 * lq) * 2);
#pragma unroll
                    for (int jt = 0; jt < 4; ++jt) acc[kt][jt] = MFMA16(aop, Bop[jt], acc[kt][jt]); }
            }
#pragma unroll
        for (int kt = 0; kt < 4; ++kt)
#pragma unroll
            for (int r = 0; r < 4; ++r) { const int k2 = 16 * kt + 4 * lq + r; float* dst = FO + (size_t)(b * SEQ + k1 + 64 * k2) * 256 + g * 64 + lr;
#pragma unroll
                for (int jt = 0; jt < 4; ++jt) dst[16 * jt] = acc[kt][jt][r] * (1.0f / 512.0f); }
        LDS_WAIT(); asm volatile("" ::: "memory");
    }
}
__device__ __forceinline__ void p_fft_ctx1(const Ctx& C) {
    const bf16* P = (const bf16*)(C.ws + WS_P); f32x2* GC = (f32x2*)(C.ws + WS_GC);
    const LAS f32x2* tw64 = (const LAS f32x2*)(C.lds + TW64_OFF);
    const int lane = C.lane;
    for (int id = C.gw; id < NB * 4 * CTXL; id += C.NGW) {
        const int b = id >> 10, g = (id >> 8) & 3, n = id & 255;
        const float fv = bf2f(P[(size_t)(MX + b * CTXL + n) * NIN + PF + g * 64 + lane]);
        float gr = 0.f, gi = 0.f;
#pragma unroll
        for (int c = 0; c < 64; ++c) { const float f = __builtin_bit_cast(float, __builtin_amdgcn_readlane(__builtin_bit_cast(int, fv), c)); const f32x2 t = tw64[(lane * c) & 63]; gr += f * t.x; gi -= f * t.y; }
        GC[(size_t)((b * 4 + g) * CTXL + n) * 64 + lane] = (f32x2){gr, gi};
    }
}
__device__ __forceinline__ void p_fft_ctx2(const Ctx& C) {
    const f32x2* GC = (const f32x2*)(C.ws + WS_GC); float* FO = (float*)(C.ws + WS_FO);
    const LAS f32x2* tw256 = (const LAS f32x2*)(C.lds + TW256_OFF);
    const int lane = C.lane;
    for (int id = C.gw; id < NB * 4 * 16; id += C.NGW) {
        const int b = id >> 6, g = (id >> 4) & 3, kc = id & 15;
        float acc[16];
#pragma unroll
        for (int kk = 0; kk < 16; ++kk) acc[kk] = 0.f;
#pragma unroll 4
        for (int n = 0; n < CTXL; ++n) {
            const f32x2 gv = GC[(size_t)((b * 4 + g) * CTXL + n) * 64 + lane];
#pragma unroll
            for (int kk = 0; kk < 16; ++kk) { const f32x2 t = tw256[((kc * 16 + kk) * n) & 255]; acc[kk] += t.x * gv.x + t.y * gv.y; }
        }
#pragma unroll
        for (int kk = 0; kk < 16; ++kk) FO[(size_t)(MX + b * CTXL + kc * 16 + kk) * 256 + g * 64 + lane] = acc[kk] * (1.0f / 128.0f);
    }
}

__device__ __forceinline__ void p_merge(const Ctx& C, const float* const (&in)[19], int layer) {
    const bf16* P = (const bf16*)(C.ws + WS_P); const bf16* NA = (const bf16*)(C.ws + WS_NA); const float* FO = (const float*)(C.ws + WS_FO); bf16* Y = (bf16*)(C.ws + WS_Y);
    const float* cw = in[IN_CONVW] + (size_t)layer * 3 * 256; const float* gm = in[IN_GMIXOUT] + (size_t)layer * D;
    const int nrows = layer == 0 ? MT : MX, lane = C.lane;
    for (int row = C.gw; row < nrows; row += C.NGW) {
        const bool isctx = row >= MX; const int slen = isctx ? CTXL : SEQ, pos = isctx ? ((row - MX) & (CTXL - 1)) : (row & (SEQ - 1));
        float na[8]; { const v4u w = *(const v4u*)(NA + (size_t)row * 512 + 8 * lane);
            na[0] = bflo(w.x); na[1] = bfhi(w.x); na[2] = bflo(w.y); na[3] = bfhi(w.y); na[4] = bflo(w.z); na[5] = bfhi(w.z); na[6] = bflo(w.w); na[7] = bfhi(w.w); }
        float s_na = 0.f;
#pragma unroll
        for (int i = 0; i < 8; ++i) s_na += na[i] * na[i];
        const bf16* pr = P + (size_t)row * NIN;
        float z[3][4];
#pragma unroll
        for (int dk = 0; dk < 3; ++dk) { const int pp = pos + dk - 1; const bool ok = pp >= 0 && pp < slen;
            const bf16* pq = pr + (ptrdiff_t)(dk - 1) * NIN;
            u32x2 cg = (u32x2){0u, 0u}, uu = (u32x2){0u, 0u};
            if (ok) { cg = *(const u32x2*)(pq + PCG + 4 * lane); uu = *(const u32x2*)(pq + PU + 4 * lane); }
            z[dk][0] = bflo(cg.x) * bflo(uu.x); z[dk][1] = bfhi(cg.x) * bfhi(uu.x); z[dk][2] = bflo(cg.y) * bflo(uu.y); z[dk][3] = bfhi(cg.y) * bfhi(uu.y); }
        const u32x2 bgw = *(const u32x2*)(pr + PBG + 4 * lane);
        const f32x4 w0 = *(const f32x4*)(cw + 4 * lane), w1 = *(const f32x4*)(cw + 256 + 4 * lane), w2 = *(const f32x4*)(cw + 512 + 4 * lane);
        float cv[4];
        cv[0] = bflo(bgw.x) * (w0.x * z[0][0] + w1.x * z[1][0] + w2.x * z[2][0]); cv[1] = bfhi(bgw.x) * (w0.y * z[0][1] + w1.y * z[1][1] + w2.y * z[2][1]);
        cv[2] = bflo(bgw.y) * (w0.z * z[0][2] + w1.z * z[1][2] + w2.z * z[2][2]); cv[3] = bfhi(bgw.y) * (w0.w * z[0][3] + w1.w * z[1][3] + w2.w * z[2][3]);
        float s_cv = cv[0] * cv[0] + cv[1] * cv[1] + cv[2] * cv[2] + cv[3] * cv[3];
        const f32x4 fo = *(const f32x4*)(FO + (size_t)row * 256 + 4 * lane);
        float s_fo = fo.x * fo.x + fo.y * fo.y + fo.z * fo.z + fo.w * fo.w;
        s_na = wave_sum(s_na); s_cv = wave_sum(s_cv); s_fo = wave_sum(s_fo);
        const float r_na = 1.0f / sqrtf(s_na * (1.f / 512.f) + RMS_EPS), r_cv = 1.0f / sqrtf(s_cv * (1.f / 256.f) + RMS_EPS), r_fo = 1.0f / sqrtf(s_fo * (1.f / 256.f) + RMS_EPS);
        bf16* yr = Y + (size_t)row * D;
        { const f32x4 g0 = *(const f32x4*)(gm + 8 * lane), g1 = *(const f32x4*)(gm + 8 * lane + 4);
          v4u w; w.x = pk2(na[0] * r_na * g0.x, na[1] * r_na * g0.y); w.y = pk2(na[2] * r_na * g0.z, na[3] * r_na * g0.w);
          w.z = pk2(na[4] * r_na * g1.x, na[5] * r_na * g1.y); w.w = pk2(na[6] * r_na * g1.z, na[7] * r_na * g1.w); *(v4u*)(yr + 8 * lane) = w; }
        { const f32x4 g0 = *(const f32x4*)(gm + 512 + 4 * lane); u32x2 w; w.x = pk2(cv[0] * r_cv * g0.x, cv[1] * r_cv * g0.y); w.y = pk2(cv[2] * r_cv * g0.z, cv[3] * r_cv * g0.w); *(u32x2*)(yr + 512 + 4 * lane) = w; }
        { const f32x4 g0 = *(const f32x4*)(gm + 768 + 4 * lane); u32x2 w; w.x = pk2(fo.x * r_fo * g0.x, fo.y * r_fo * g0.y); w.y = pk2(fo.z * r_fo * g0.z, fo.w * r_fo * g0.w); *(u32x2*)(yr + 768 + 4 * lane) = w; }
    }
}
__device__ __forceinline__ const float* xin_row(const Ctx& C, const float* const (&in)[19], int layer, int row) {
    if (layer == 0) return row < MX ? in[IN_X] + (size_t)row * D : in[IN_CTX] + (size_t)(row - MX) * D;
    return (const float*)(C.ws + WS_X2) + (size_t)row * D;
}
__device__ __forceinline__ void p_postmix(const Ctx& C, const float* const (&in)[19], int layer) {
    const float* MO = (const float*)(C.ws + WS_MO); float* X1 = (float*)(C.ws + WS_X1); unsigned char* H2 = C.ws + WS_H2; float* AFF = (float*)(C.ws + WS_AFF);
    const float* gpost = in[IN_GPOSTMIX] + (size_t)layer * D; const float* gpre = in[IN_GPREFFN] + (size_t)layer * D; const float* wr = in[IN_WROUTER] + (size_t)layer * D * NE;
    const int nrows = layer == 0 ? MT : MX, lane = C.lane;
    for (int row = C.gw; row < nrows; row += C.NGW) {
        const int mr = mod_row(row);
        const float* g1 = modx(C, layer, mr, 2); const float* sh2 = modx(C, layer, mr, 3); const float* sc2 = modx(C, layer, mr, 4);
        const float* xr = xin_row(C, in, layer, row);
        f32x4 v[4]; float ss = 0.f;
#pragma unroll
        for (int j = 0; j < 4; ++j) { v[j] = ((const f32x4*)(MO + (size_t)row * D))[lane + 64 * j]; ss += (v[j].x * v[j].x + v[j].y * v[j].y) + (v[j].z * v[j].z + v[j].w * v[j].w); }
        ss = wave_sum(ss);
        const float r1 = 1.0f / sqrtf(ss * (1.f / D) + RMS_EPS);
        float ss2 = 0.f;
#pragma unroll
        for (int j = 0; j < 4; ++j) { const f32x4 xx = ((const f32x4*)xr)[lane + 64 * j], gg = ((const f32x4*)gpost)[lane + 64 * j], g1v = ((const f32x4*)g1)[lane + 64 * j];
            v[j] = xx + g1v * (v[j] * r1 * gg); ((f32x4*)(X1 + (size_t)row * D))[lane + 64 * j] = v[j];
            ss2 += (v[j].x * v[j].x + v[j].y * v[j].y) + (v[j].z * v[j].z + v[j].w * v[j].w); }
        ss2 = wave_sum(ss2);
        const float r2 = 1.0f / sqrtf(ss2 * (1.f / D) + RMS_EPS);
        float acc[NE];
#pragma unroll
        for (int e = 0; e < NE; ++e) acc[e] = 0.f;
#pragma unroll
        for (int j = 0; j < 4; ++j) {
            const f32x4 gg = ((const f32x4*)gpre)[lane + 64 * j], hh = ((const f32x4*)sh2)[lane + 64 * j], cc = ((const f32x4*)sc2)[lane + 64 * j];
            const f32x4 h = (v[j] * r2 * gg) * (cc + 1.0f) + hh;
            ((unsigned*)(H2 + (size_t)row * D))[lane + 64 * j] = pg8::pk4_fp8(h.x * S_ACT, h.y * S_ACT, h.z * S_ACT, h.w * S_ACT);
            const float hv[4] = {h.x, h.y, h.z, h.w};
#pragma unroll
            for (int i = 0; i < 4; ++i) { const f32x4* wp = (const f32x4*)(wr + (size_t)(4 * (lane + 64 * j) + i) * NE);
#pragma unroll
                for (int q4 = 0; q4 < 4; ++q4) { const f32x4 ww = wp[q4]; acc[4 * q4] += hv[i] * ww.x; acc[4 * q4 + 1] += hv[i] * ww.y; acc[4 * q4 + 2] += hv[i] * ww.z; acc[4 * q4 + 3] += hv[i] * ww.w; } }
        }
        float mx = -1e30f;
#pragma unroll
        for (int e = 0; e < NE; ++e) { acc[e] = wave_sum(acc[e]); mx = fmaxf(mx, acc[e]); }
        float sum = 0.f;
#pragma unroll
        for (int e = 0; e < NE; ++e) { acc[e] = expf(acc[e] - mx); sum += acc[e]; }
        const float inv = 1.0f / sum;
        if (lane == 0) {
#pragma unroll
            for (int q4 = 0; q4 < 4; ++q4) ((f32x4*)(AFF + (size_t)row * NE))[q4] = (f32x4){acc[4 * q4] * inv, acc[4 * q4 + 1] * inv, acc[4 * q4 + 2] * inv, acc[4 * q4 + 3] * inv};
        }
    }
}

__device__ __forceinline__ int wave_isum(int v) {
#pragma unroll
    for (int o = 1; o < 64; o <<= 1) v += __shfl_xor(v, o);
    return v;
}
__device__ __forceinline__ void p_route(const Ctx& C, int layer) {
    const float* AFF = (const float*)(C.ws + WS_AFF); int* SLOT = (int*)(C.ws + WS_SLOT); const unsigned char* H2 = C.ws + WS_H2; unsigned char* XS = C.ws + WS_XS;
    LAS int* red = (LAS int*)(C.lds + RING_OFF);
    LAS int* list = (LAS int*)(C.lds + RING_OFF + 1024); LAS int* cnt = (LAS int*)(C.lds + RING_OFF + 512);
    const int nitems = layer == 0 ? 256 + 64 : 256;
    for (int item = blockIdx.x; item < nitems; item += C.G) {
        int b, e, NT, rowbase, cap, tok0, ntok, xsbase;
        if (item < 256) { b = item >> 6; e = (item >> 2) & 15; NT = SEQ; rowbase = b * SEQ; cap = CAPX; tok0 = (item & 3) * 1024; ntok = 1024; xsbase = e * EROWS + b * CAPX; }
        else { const int j = item - 256; b = j >> 4; e = j & 15; NT = CTXL; rowbase = MX + b * CTXL; cap = CAPC; tok0 = 0; ntok = CTXL; xsbase = e * EROWS + NB * CAPX + b * CAPC; }
        unsigned v[8];
#pragma unroll
        for (int j = 0; j < 8; ++j) { const int t = C.tid * 8 + j; v[j] = t < NT ? __float_as_uint(AFF[(size_t)(rowbase + t) * NE + e]) : 0u; }
        if (C.tid == 0) *cnt = 0;
        unsigned T = 0u;
        for (int bit = 30; bit >= 0; --bit) {
            const unsigned cand = T | (1u << bit); int c = 0;
#pragma unroll
            for (int j = 0; j < 8; ++j) c += (v[j] >= cand) ? 1 : 0;
            c = wave_isum(c);
            LAS int* r = red + (bit & 1) * 8;
            if (C.lane == 0) r[C.wave] = c;
            __syncthreads();
            int tot = 0;
#pragma unroll
            for (int w = 0; w < 8; ++w) tot += r[w];
            if (tot >= cap) T = cand;
        }
        int cg = 0, ce = 0;
#pragma unroll
        for (int j = 0; j < 8; ++j) { cg += (v[j] > T) ? 1 : 0; ce += (v[j] == T && (C.tid * 8 + j) < NT) ? 1 : 0; }
        int sg = cg, se = ce;
#pragma unroll
        for (int o = 1; o < 64; o <<= 1) { const int ag = __shfl_up(sg, o), ae = __shfl_up(se, o); if (C.lane >= o) { sg += ag; se += ae; } }
        LAS int* sc = red + 64;
        __syncthreads();
        if (C.lane == 63) { sc[C.wave] = sg; sc[8 + C.wave] = se; }
        __syncthreads();
        int bg = 0, be = 0, totg = 0;
#pragma unroll
        for (int w = 0; w < 8; ++w) { const int xg = sc[w], xe = sc[8 + w]; if (w < C.wave) { bg += xg; be += xe; } totg += xg; }
        int pg = bg + sg - cg, pe = be + se - ce;
        const int need_eq = cap - totg;
#pragma unroll
        for (int j = 0; j < 8; ++j) {
            const int t = C.tid * 8 + j; const bool gt = v[j] > T, eq = (v[j] == T) && t < NT;
            const bool sel = gt || (eq && pe < need_eq);
            const int slot = pg + min(pe, need_eq);
            if (t >= tok0 && t < tok0 + ntok) {
                SLOT[(size_t)(rowbase + t) * NE + e] = sel ? slot : -1;
                if (sel) { const int pos = atomicAdd((int*)cnt, 1); list[2 * pos] = t; list[2 * pos + 1] = slot; }
            }
            pg += gt ? 1 : 0; pe += eq ? 1 : 0;
        }
        __syncthreads();
        const int n = *cnt;
        for (int idx = C.wave; idx < n; idx += NWAVES) { const int t = list[2 * idx], slot = list[2 * idx + 1];
            const v4u* src = (const v4u*)(H2 + (size_t)(rowbase + t) * D); v4u* dst = (v4u*)(XS + (size_t)(xsbase + slot) * D);
            dst[C.lane] = src[C.lane]; }
        __syncthreads();
    }
}

__device__ __forceinline__ void p_combine(const Ctx& C, const float* const (&in)[19], float* out, int layer) {
    const float* AFF = (const float*)(C.ws + WS_AFF); const int* SLOT = (const int*)(C.ws + WS_SLOT); const bf16* YE = (const bf16*)(C.ws + WS_YE); const float* X1 = (const float*)(C.ws + WS_X1);
    float* XO = layer == 0 ? (float*)(C.ws + WS_X2) : out; bf16* H = (bf16*)(C.ws + WS_H);
    const float* gpost = in[IN_GPOSTFFN] + (size_t)layer * D;
    const int nrows = layer == 0 ? MT : MX, lane = C.lane;
    for (int row = C.gw; row < nrows; row += C.NGW) {
        const int mr = mod_row(row);
        const int ebase = row < MX ? (row >> 12) * CAPX : NB * CAPX + ((row - MX) >> 8) * CAPC;
        f32x4 a[4];
#pragma unroll
        for (int j = 0; j < 4; ++j) a[j] = (f32x4){0.f, 0.f, 0.f, 0.f};
        for (int e = 0; e < NE; ++e) {
            const int s = SLOT[(size_t)row * NE + e];
            if (s >= 0) { const float gt = AFF[(size_t)row * NE + e]; const u32x2* yr = (const u32x2*)(YE + (size_t)(e * EROWS + ebase + s) * D);
#pragma unroll
                for (int j = 0; j < 4; ++j) { const u32x2 w = yr[lane + 64 * j]; a[j].x += gt * bflo(w.x); a[j].y += gt * bfhi(w.x); a[j].z += gt * bflo(w.y); a[j].w += gt * bfhi(w.y); } }
        }
        float ss = 0.f;
#pragma unroll
        for (int j = 0; j < 4; ++j) ss += (a[j].x * a[j].x + a[j].y * a[j].y) + (a[j].z * a[j].z + a[j].w * a[j].w);
        ss = wave_sum(ss);
        const float r = 1.0f / sqrtf(ss * (1.f / D) + RMS_EPS);
        const float* g2 = modx(C, layer, mr, 5);
        float ss2 = 0.f;
#pragma unroll
        for (int j = 0; j < 4; ++j) { const f32x4 xx = ((const f32x4*)(X1 + (size_t)row * D))[lane + 64 * j], gg = ((const f32x4*)gpost)[lane + 64 * j], g2v = ((const f32x4*)g2)[lane + 64 * j];
            a[j] = xx + g2v * (a[j] * r * gg); ((f32x4*)(XO + (size_t)row * D))[lane + 64 * j] = a[j];
            ss2 += (a[j].x * a[j].x + a[j].y * a[j].y) + (a[j].z * a[j].z + a[j].w * a[j].w); }
        if (layer == 0) {
            ss2 = wave_sum(ss2);
            norm_mod_store(a, ss2, in[IN_GPREMIX] + D, modx(C, 1, mr, 0), modx(C, 1, mr, 1), H + (size_t)row * D, lane);
        }
    }
}
constexpr int NPH = 22;
#ifndef MK_PER_PHASE
#define MK_PER_PHASE 0
#endif
struct Args { const float* in[19]; float* out; unsigned char* ws; int ph_lo, ph_hi; };
__global__ void __launch_bounds__(NWAVES * 64, 2) mk_fwd(Args args) {
    extern __shared__ __attribute__((aligned(16))) unsigned char lds_raw[];
    Ctx C;
    C.ws = args.ws; C.lds = (LAS unsigned char*)lds_raw;
    C.tid = threadIdx.x; C.lane = C.tid & 63; C.wave = __builtin_amdgcn_readfirstlane(C.tid >> 6); C.G = gridDim.x;
    C.gw = blockIdx.x * NWAVES + C.wave; C.NGW = C.G * NWAVES;
    volatile LAS unsigned* MISC = (volatile LAS unsigned*)(C.lds + MISC_OFF);
    for (int u = C.tid; u < (512 - 0) / 4; u += NWAVES * 64) ((LAS unsigned*)(C.lds + LDSCTL_OFF))[u] = 0u;
    if (C.tid < 64) { float s, c; sincospif((float)C.tid * (1.0f / 32.0f), &s, &c); ((LAS f32x2*)(C.lds + TW64_OFF))[C.tid] = (f32x2){c, s}; }
    if (C.tid < 256) { float s, c; sincospif((float)C.tid * (1.0f / 128.0f), &s, &c); ((LAS f32x2*)(C.lds + TW256_OFF))[C.tid] = (f32x2){c, s}; }
    for (int u = C.tid; u < 4096; u += NWAVES * 64) { float s, c; sincospif((float)(((u >> 6) * (u & 63)) & 63) * (1.0f / 32.0f), &s, &c); ((LAS bf16*)(C.lds + CT_OFF))[u] = (bf16)f2bf(c); ((LAS bf16*)(C.lds + ST_OFF))[u] = (bf16)f2bf(s); }
    __syncthreads();
    gu32* ctl = (gu32*)(C.ws + WS_CTL);
    XcdBarrier bar = xcd_barrier_post((unsigned*)(ctl + CW_BAR), MISC + 8);
    const int lo = args.ph_lo, hi = args.ph_hi;
#ifndef DBG_MASK
#define DBG_MASK 0xffffffffu
#endif
#define PH_ON(k) (((DBG_MASK) >> (k)) & 1u)
#ifndef DBG_REP
#define DBG_REP 0u
#endif
#define REP(k) _Pragma("unroll") for (int rep_ = 0; rep_ < 1 + (int)(((DBG_REP) >> (k)) & 1u); ++rep_)
#define IN(k) (lo <= (k) && (k) < hi)
#define SEAM(k) do { if (IN(k) && IN((k) + 1)) xcd_barrier(bar); } while (0)

    if (PH_ON(0) && IN(0)) REP(0) p0_prologue(C, args.in);
    SEAM(0);
    if (PH_ON(1) && IN(1)) REP(1) p1_h0(C, args.in);
    SEAM(1);
    for (int layer = 0; layer < DEPTH; ++layer) {
        const int pb = 2 + 10 * layer;
        Ctx L = C; asm volatile("" : "+v"(L.tid), "+v"(L.lane)); asm volatile("" : "+s"(L.wave), "+s"(L.gw));
        if (PH_ON(2) && IN(pb + 0)) REP(2) {
            pg8::Gemm g{(const pg8::bf16_t*)(L.ws + WS_H), (const pg8::bf16_t*)(L.ws + WS_WINT) + (size_t)layer * NIN * D, MT, NIN, D};
            pg8::TileOrder S; S.init(MT / 256, NIN / 256, L.G, (int)blockIdx.x);
            pg8::EpiBf16Map E{(pg8::bf16_t*)(L.ws + WS_P), NIN, 1 << 30, 1.0f};
            pg8::gemm_phase<pg8::EpiBf16Map, pg8::TileOrder, true, true>(L.lds + RING_OFF, g, S, E);
        }
        SEAM(pb + 0);
        if (IN(pb + 1)) { if (PH_ON(3)) REP(3) p_attn(L, args.in, layer); if (PH_ON(4)) REP(4) p_fft_a(L); if (PH_ON(5) && layer == 0) REP(5) p_fft_ctx1(L); }
        SEAM(pb + 1);
        if (IN(pb + 2)) { if (PH_ON(6)) REP(6) p_fft_b(L); if (PH_ON(5) && layer == 0) REP(5) p_fft_ctx2(L); }
        SEAM(pb + 2);
        if (PH_ON(7) && IN(pb + 3)) REP(7) p_merge(L, args.in, layer);
        SEAM(pb + 3);
        if (PH_ON(8) && IN(pb + 4)) REP(8) {
            pg8::Gemm g{(const pg8::bf16_t*)(L.ws + WS_Y), (const pg8::bf16_t*)(L.ws + WS_WOUTT) + (size_t)layer * D * D, MT, D, D};
            pg8::TileOrder S; S.init((layer == 0 ? MT : MX) / 256, D / 256, L.G, (int)blockIdx.x);
            pg8::EpiF32 E{(float*)(L.ws + WS_MO), D};
            pg8::gemm_phase<pg8::EpiF32, pg8::TileOrder, true, true>(L.lds + RING_OFF, g, S, E);
        }
        SEAM(pb + 4);
        if (PH_ON(9) && IN(pb + 5)) REP(9) p_postmix(L, args.in, layer);
        SEAM(pb + 5);
        if (PH_ON(10) && IN(pb + 6)) REP(10) p_route(L, layer);
        SEAM(pb + 6);
        if (PH_ON(11) && IN(pb + 7)) REP(11) {
            pg8::Gemm g{(const pg8::bf16_t*)(L.ws + WS_XS), (const pg8::bf16_t*)(L.ws + WS_WGUT + (size_t)layer * NE * 2 * FH * D), NE * EROWS, NE * 2 * FH, D / 2};
            pg8::GroupOrder S; S.init(NE, layer == 0 ? ETILES : ETILES - 1, ETILES, FNT, L.G, (int)blockIdx.x);
            pg8::EpiSwiGLU8 E{L.ws + WS_HID, FH, FNT, 1.0f / (S_ACT * S_WGU), S_HID};
            pg8::gemm_phase<pg8::EpiSwiGLU8, pg8::GroupOrder, true, true, true>(L.lds + RING_OFF, g, S, E);
        }
        SEAM(pb + 7);
        if (PH_ON(12) && IN(pb + 8)) REP(12) {
            pg8::Gemm g{(const pg8::bf16_t*)(L.ws + WS_HID), (const pg8::bf16_t*)(L.ws + WS_WDT + (size_t)layer * NE * D * FH), NE * EROWS, NE * D, FH / 2};
            pg8::GroupOrder S; S.init(NE, layer == 0 ? ETILES : ETILES - 1, ETILES, D / 256, L.G, (int)blockIdx.x);
            pg8::EpiBf16Map E{(pg8::bf16_t*)(L.ws + WS_YE), D, D / 256, 1.0f / (S_HID * S_WDN)};
            pg8::gemm_phase<pg8::EpiBf16Map, pg8::GroupOrder, true, true, true>(L.lds + RING_OFF, g, S, E);
        }
        SEAM(pb + 8);
        if (PH_ON(13) && IN(pb + 9)) REP(13) p_combine(L, args.in, args.out, layer);
        SEAM(pb + 9);
    }
#undef IN
#undef SEAM
}

extern "C" void kernel_launch(void* const* d_in, const int* in_sizes, int n_in, void* d_out, int out_size, void* d_ws, size_t ws_size, hipStream_t stream) {
    static int grid = 0;
    if (grid == 0) {
        if (n_in != 19 || in_sizes[0] != MX * D || out_size != MX * D || ws_size < WS_END) { fprintf(stderr, "kernel_launch: unexpected shapes (n_in %d, in0 %d, out %d, ws %zu < %zu); nothing launched\n", n_in, n_in > 0 ? in_sizes[0] : -1, out_size, ws_size, (size_t)WS_END); grid = -1; return; }
        int dev = 0, cus = 0, per_cu = 0;
        if (hipGetDevice(&dev) != hipSuccess || hipDeviceGetAttribute(&cus, hipDeviceAttributeMultiprocessorCount, dev) != hipSuccess) { fprintf(stderr, "kernel_launch: device query failed\n"); grid = -1; return; }
        if (hipFuncSetAttribute((const void*)mk_fwd, hipFuncAttributeMaxDynamicSharedMemorySize, LDS_BYTES) != hipSuccess) { fprintf(stderr, "kernel_launch: hipFuncSetAttribute failed\n"); grid = -1; return; }
        if (hipOccupancyMaxActiveBlocksPerMultiprocessor(&per_cu, (const void*)mk_fwd, NWAVES * 64, LDS_BYTES) != hipSuccess || per_cu < 1)
            fprintf(stderr, "kernel_launch: note: occupancy query reports %d workgroups per CU\n", per_cu);
        (void)hipGetLastError();
        grid = cus;
    }
    if (grid < 0) return;
    if (hipMemsetAsync((char*)d_ws + WS_CTL, 0, CTL_ZERO_BYTES, stream) != hipSuccess) { fprintf(stderr, "kernel_launch: memset failed\n"); return; }
    Args a{};
    for (int i = 0; i < 19; ++i) a.in[i] = (const float*)d_in[i];
    a.out = (float*)d_out; a.ws = (unsigned char*)d_ws;
#if MK_PER_PHASE
    for (int ph = 0; ph < NPH; ++ph) { a.ph_lo = ph; a.ph_hi = ph + 1; hipLaunchKernelGGL(mk_fwd, dim3(grid), dim3(NWAVES * 64), LDS_BYTES, stream, a); }
#else
    a.ph_lo = 0; a.ph_hi = NPH;
    hipLaunchKernelGGL(mk_fwd, dim3(grid), dim3(NWAVES * 64), LDS_BYTES, stream, a);
#endif
    const hipError_t le = hipPeekAtLastError();
    if (le != hipSuccess) fprintf(stderr, "kernel_launch: launch failed: %s\n", hipGetErrorName(le));
}
```

```cpp
#include <hip/hip_runtime.h>
#include <cstdio>
#include <cstdint>
namespace pg8 {
#define PG8_LAS __attribute__((address_space(3)))
typedef unsigned short bf16_t;
typedef short bf16x8 __attribute__((ext_vector_type(8)));
typedef float f32x4 __attribute__((ext_vector_type(4)));
typedef unsigned u32x4 __attribute__((ext_vector_type(4)));
typedef int i32x4 __attribute__((ext_vector_type(4)));
typedef int i32x8 __attribute__((ext_vector_type(8)));
typedef unsigned u32x2 __attribute__((ext_vector_type(2)));
constexpr int BM = 256, BK = 64, HALF = 128, HTB = HALF * BK * 2  , STAGE_BYTES = 8 * HTB, NXCD = 8, WGM = 8;

__host__ __device__ __forceinline__ int lds_byte(int r, int c) { const int st = (r >> 4) * 2 + (c >> 5), rr = r & 15, cc = c & 31, ob = rr * 64 + cc * 2; return st * 1024 + (ob ^ (((ob >> 9) & 1) << 5)); }
__host__ __device__ __forceinline__ void stage_rc(int b, int& R, int& C) { const int st = b / 1024, sb = b % 1024, swz = sb ^ (((sb >> 9) & 1) << 5); R = (st >> 1) * 16 + swz / 64; C = (st & 1) * 32 + (swz % 64) / 2; }
__host__ __device__ __forceinline__ int perm32(int rho) { const int n = rho >> 4, i = rho & 15; return 8 * (i >> 2) + 4 * n + (i & 3); }

struct Unit { int pm, pn; };
struct Gemm { const bf16_t* A; const bf16_t* Bt; int M, N, K; };

struct StaticOrder {
    int nM, nN, nwg, G, c;
    __host__ __device__ void init(int M, int N, int G_, int c_) { nM = M / BM; nN = N / BM; nwg = nM * nN; G = G_; c = c_; }
    __host__ __device__ bool next(int i, Unit& u) const {
        const long L = (long)i * G + c; if (L >= nwg) return false;
        int wgid = (int)L; { const int q = nwg / NXCD, r = nwg % NXCD, xcd = wgid % NXCD, off = wgid / NXCD; wgid = (xcd < r ? xcd * (q + 1) : r * (q + 1) + (xcd - r) * q) + off; }
        const int nig = WGM * nN, gid = wgid / nig, fm = gid * WGM, gsz = (nM - fm) < WGM ? (nM - fm) : WGM;
        u.pm = fm + ((wgid % nig) % gsz); u.pn = (wgid % nig) / gsz; return true;
    }
    __device__ __forceinline__ void a_ready(const Unit&) const {}
    __device__ __forceinline__ void done(const Unit&) const {}
};

__device__ __forceinline__ unsigned cvt_pk_bf16(float lo, float hi) { unsigned r; asm volatile("v_cvt_pk_bf16_f32 %0, %1, %2" : "=v"(r) : "v"(lo), "v"(hi)); return r; }
struct TileOrder {
    int nM, nN, nwg, G, c;
    __device__ void init(int nM_, int nN_, int G_, int c_) { nM = nM_; nN = nN_; nwg = nM * nN; G = G_; c = c_; }
    __device__ bool next(int i, Unit& u) const {
        int wgid;
        if ((G & 7) == 0) { const int per = G >> 3; wgid = (i * 8 + (c & 7)) * per + (c >> 3); } else wgid = i * G + c;
        if (wgid >= nwg) return false;
        const int nig = WGM * nN, gid = wgid / nig, fm = gid * WGM, gsz = (nM - fm) < WGM ? (nM - fm) : WGM;
        u.pm = fm + ((wgid % nig) % gsz); u.pn = (wgid % nig) / gsz; return true;
    }
    __device__ __forceinline__ void a_ready(const Unit&) const {}
    __device__ __forceinline__ void done(const Unit&) const {}
};
struct GroupOrder {
    int nE, nMt, strideM, nNt, nwg, G, c;
    __device__ void init(int nE_, int nMt_, int strideM_, int nNt_, int G_, int c_) { nE = nE_; nMt = nMt_; strideM = strideM_; nNt = nNt_; nwg = nE * nMt * nNt; G = G_; c = c_; }
    __device__ bool next(int i, Unit& u) const {
        int wgid;
        if ((G & 7) == 0) { const int per = G >> 3; wgid = (i * 8 + (c & 7)) * per + (c >> 3); } else wgid = i * G + c;
        if (wgid >= nwg) return false;
        const int per_e = nMt * nNt, e = wgid / per_e, r = wgid % per_e, jn = r / nMt, im = r % nMt;
        u.pm = e * strideM + im; u.pn = e * nNt + jn; return true;
    }
    __device__ __forceinline__ void a_ready(const Unit&) const {}
    __device__ __forceinline__ void done(const Unit&) const {}
};
struct EpiBf16Map {
    static constexpr bool PERM = true, AFTER_DRAIN = false;
    bf16_t* O; int ldc; int pn_mod; float scale;
    __device__ __forceinline__ void operator()(const f32x4 (&acc)[2][2][4][2], const Unit& u, int wr, int wc, int fr_, int fq_) const {
        int fr = fr_, fq = fq_; asm volatile("" : "+v"(fr), "+v"(fq));
        const int row0 = u.pm * BM + wr * 64 + fr, col0 = (u.pn % pn_mod) * BM + wc * 32 + 8 * fq;
#pragma unroll
        for (int ai = 0; ai < 2; ++ai)
#pragma unroll
            for (int m = 0; m < 4; ++m) { bf16_t* rowp = O + (size_t)(row0 + ai * HALF + m * 16) * ldc + col0;
#pragma unroll
                for (int bj = 0; bj < 2; ++bj) { const f32x4 v0 = acc[ai][bj][m][0] * scale, v1 = acc[ai][bj][m][1] * scale;
                    u32x4 w; w.x = cvt_pk_bf16(v0[0], v0[1]); w.y = cvt_pk_bf16(v0[2], v0[3]); w.z = cvt_pk_bf16(v1[0], v1[1]); w.w = cvt_pk_bf16(v1[2], v1[3]);
                    *(u32x4*)(rowp + bj * HALF) = w; } }
    }
};
struct EpiF32 {
    static constexpr bool PERM = false, AFTER_DRAIN = false;
    float* O; int ldc;
    __device__ __forceinline__ void operator()(const f32x4 (&acc)[2][2][4][2], const Unit& u, int wr, int wc, int fr_, int fq_) const {
        int fr = fr_, fq = fq_; asm volatile("" : "+v"(fr), "+v"(fq));
        const int row0 = u.pm * BM + wr * 64 + fr, col0 = u.pn * BM + wc * 32 + 4 * fq;
#pragma unroll
        for (int ai = 0; ai < 2; ++ai)
#pragma unroll
            for (int m = 0; m < 4; ++m) { float* rowp = O + (size_t)(row0 + ai * HALF + m * 16) * ldc + col0;
#pragma unroll
                for (int bj = 0; bj < 2; ++bj)
#pragma unroll
                    for (int n = 0; n < 2; ++n) *(f32x4*)(rowp + bj * HALF + n * 16) = acc[ai][bj][m][n]; }
    }
};
__device__ __forceinline__ float silu_f(float g) { return g * __builtin_amdgcn_rcpf(1.0f + __builtin_amdgcn_exp2f(-1.4426950408889634f * g)); }
struct EpiSwiGLU {
    static constexpr bool PERM = true, AFTER_DRAIN = false;
    bf16_t* O; int ldc; int pn_mod;
    __device__ __forceinline__ void operator()(const f32x4 (&acc)[2][2][4][2], const Unit& u, int wr, int wc, int fr_, int fq_) const {
        int fr = fr_, fq = fq_; asm volatile("" : "+v"(fr), "+v"(fq));
        const int row0 = u.pm * BM + wr * 64 + fr, col0 = (u.pn % pn_mod) * HALF + wc * 32 + 8 * fq;
#pragma unroll
        for (int ai = 0; ai < 2; ++ai)
#pragma unroll
            for (int m = 0; m < 4; ++m) { bf16_t* rowp = O + (size_t)(row0 + ai * HALF + m * 16) * ldc + col0;
                const f32x4 g0 = acc[ai][0][m][0], g1 = acc[ai][0][m][1], u0 = acc[ai][1][m][0], u1 = acc[ai][1][m][1];
                u32x4 w; w.x = cvt_pk_bf16(silu_f(g0[0]) * u0[0], silu_f(g0[1]) * u0[1]); w.y = cvt_pk_bf16(silu_f(g0[2]) * u0[2], silu_f(g0[3]) * u0[3]);
                w.z = cvt_pk_bf16(silu_f(g1[0]) * u1[0], silu_f(g1[1]) * u1[1]); w.w = cvt_pk_bf16(silu_f(g1[2]) * u1[2], silu_f(g1[3]) * u1[3]);
                *(u32x4*)rowp = w; }
    }
};

__device__ __forceinline__ unsigned pk4_fp8(float a, float b, float c, float d) {
    a = fminf(fmaxf(a, -448.f), 448.f); b = fminf(fmaxf(b, -448.f), 448.f); c = fminf(fmaxf(c, -448.f), 448.f); d = fminf(fmaxf(d, -448.f), 448.f);
    unsigned w = 0u; w = __builtin_amdgcn_cvt_pk_fp8_f32(a, b, w, false); w = __builtin_amdgcn_cvt_pk_fp8_f32(c, d, w, true); return w;
}
struct EpiSwiGLU8 {
    static constexpr bool PERM = true, AFTER_DRAIN = false;
    unsigned char* O; int ldc; int pn_mod; float inv, oscale;
    __device__ __forceinline__ void operator()(const f32x4 (&acc)[2][2][4][2], const Unit& u, int wr, int wc, int fr_, int fq_) const {
        int fr = fr_, fq = fq_; asm volatile("" : "+v"(fr), "+v"(fq));
        const int row0 = u.pm * BM + wr * 64 + fr, col0 = (u.pn % pn_mod) * HALF + wc * 32 + 8 * fq;
#pragma unroll
        for (int ai = 0; ai < 2; ++ai)
#pragma unroll
            for (int m = 0; m < 4; ++m) { unsigned char* rowp = O + (size_t)(row0 + ai * HALF + m * 16) * ldc + col0;
                const f32x4 g0 = acc[ai][0][m][0] * inv, g1 = acc[ai][0][m][1] * inv, u0 = acc[ai][1][m][0] * (inv * oscale), u1 = acc[ai][1][m][1] * (inv * oscale);
                u32x2 w; w.x = pk4_fp8(silu_f(g0[0]) * u0[0], silu_f(g0[1]) * u0[1], silu_f(g0[2]) * u0[2], silu_f(g0[3]) * u0[3]);
                w.y = pk4_fp8(silu_f(g1[0]) * u1[0], silu_f(g1[1]) * u1[1], silu_f(g1[2]) * u1[2], silu_f(g1[3]) * u1[3]);
                *(u32x2*)rowp = w; }
    }
};
template <class Epi, class Sched, bool ALIGN_EPI = false, bool SP2 = false, bool FP8 = false>
__device__ __forceinline__ void gemm_phase(PG8_LAS unsigned char* lds, const Gemm g, const Sched& S, const Epi& E) {
    int tid_ = threadIdx.x; asm volatile("" : "+v"(tid_));
    const int tid = tid_, wid = __builtin_amdgcn_readfirstlane(tid >> 6), lane = tid & 63, wr = wid >> 2, wc = wid & 3, fr = lane & 15, fq = lane >> 4;
    const int K = g.K, nt = K / BK;
    unsigned voffA[2], voffB[2];
#pragma unroll
    for (int i = 0; i < 2; ++i) { int R, C; stage_rc(tid * 16 + i * 8192, R, C); const int Rb = Epi::PERM ? ((R & ~31) + perm32(R & 31)) : R;
        voffA[i] = (unsigned)(R * K + C) * 2u; voffB[i] = (unsigned)(Rb * K + C) * 2u; }
    const size_t kstep = (size_t)(BK * 2);
    const size_t hstep = (size_t)HALF * K * 2;
    const size_t tstep = 2 * hstep;
    const unsigned ldsw = (unsigned)wid * 1024u;
    const int aoff = lds_byte(wr * 64 + fr, fq * 8), boff = lds_byte(wc * 32 + fr, fq * 8);
#define PG8_SA(b, h) (((b) * 2 + (h)) * HTB)
#define PG8_SB(b, h) ((4 + (b) * 2 + (h)) * HTB)
#define PG8_STAGE(bufoff, gbase, voff) do { _Pragma("unroll") for (int _i = 0; _i < 2; ++_i) \
        __builtin_amdgcn_global_load_lds((const unsigned*)((const char*)(gbase) + (voff)[_i]), (PG8_LAS unsigned*)(lds + (bufoff) + ldsw + _i * 8192), 16, 0, 0); } while (0)
#define PG8_LDA(dst, b, h) do { if constexpr (FP8) { _Pragma("unroll") for (int m = 0; m < 4; ++m) dst##8[m] = __builtin_shufflevector(*(const PG8_LAS i32x4*)(lds + PG8_SA(b, h) + aoff + m * 2048), *(const PG8_LAS i32x4*)(lds + PG8_SA(b, h) + aoff + m * 2048 + 1024), 0, 1, 2, 3, 4, 5, 6, 7); } \
    else { _Pragma("unroll") for (int m = 0; m < 4; ++m) _Pragma("unroll") for (int k = 0; k < 2; ++k) dst[m][k] = *(const PG8_LAS bf16x8*)(lds + PG8_SA(b, h) + aoff + m * 2048 + k * 1024); } } while (0)
#define PG8_LDB(dst, b, h) do { if constexpr (FP8) { _Pragma("unroll") for (int n = 0; n < 2; ++n) dst##8[n] = __builtin_shufflevector(*(const PG8_LAS i32x4*)(lds + PG8_SB(b, h) + boff + n * 2048), *(const PG8_LAS i32x4*)(lds + PG8_SB(b, h) + boff + n * 2048 + 1024), 0, 1, 2, 3, 4, 5, 6, 7); } \
    else { _Pragma("unroll") for (int n = 0; n < 2; ++n) _Pragma("unroll") for (int k = 0; k < 2; ++k) dst[n][k] = *(const PG8_LAS bf16x8*)(lds + PG8_SB(b, h) + boff + n * 2048 + k * 1024); } } while (0)
#define PG8_MMA(ai, bj, At, Bt) do { __builtin_amdgcn_s_setprio(1); \
    if constexpr (FP8) { _Pragma("unroll") for (int m = 0; m < 4; ++m) _Pragma("unroll") for (int n = 0; n < 2; ++n) \
        asm volatile("v_mfma_scale_f32_16x16x128_f8f6f4 %0, %1, %2, %0, %3, %3 op_sel_hi:[0,0,0]" : "+v"(acc[ai][bj][m][n]) : "v"(Bt##8[n]), "v"(At##8[m]), "v"(fp8_unit_scale)); } \
    else { _Pragma("unroll") for (int m = 0; m < 4; ++m) _Pragma("unroll") for (int n = 0; n < 2; ++n) _Pragma("unroll") for (int k = 0; k < 2; ++k) \
        acc[ai][bj][m][n] = __builtin_amdgcn_mfma_f32_16x16x32_bf16(Bt[n][k], At[m][k], acc[ai][bj][m][n], 0, 0, 0); } \
    __builtin_amdgcn_s_setprio(0); } while (0)
#define PG8_WAIT_V(n) asm volatile("s_waitcnt vmcnt(" #n ")" ::: "memory")
#define PG8_WAIT_L(n) asm volatile("s_waitcnt lgkmcnt(" #n ")" ::: "memory")
#define PG8_BAR __builtin_amdgcn_s_barrier()
#define PG8_SCHED __builtin_amdgcn_sched_barrier(0)
    Unit cur, nxt; int ui = 0;
    if (!S.next(0, cur)) return;
    f32x4 acc[2][2][4][2];
#pragma unroll
    for (int a = 0; a < 2; ++a)
#pragma unroll
        for (int b = 0; b < 2; ++b)
#pragma unroll
            for (int m = 0; m < 4; ++m)
#pragma unroll
                for (int n = 0; n < 2; ++n) acc[a][b][m][n] = (f32x4){0.f, 0.f, 0.f, 0.f};
    const int fp8_unit_scale = 0x7f7f7f7f;
    bf16x8 At[4][2], B0[2][2], B1[2][2]; i32x8 At8[4], B08[2], B18[2];
    const char* cA = (const char*)g.A + (size_t)cur.pm * tstep; const char* cB = (const char*)g.Bt + (size_t)cur.pn * tstep;
    S.a_ready(cur);
    if constexpr (SP2) {
        PG8_STAGE(PG8_SB(0, 0), cB, voffB); PG8_STAGE(PG8_SB(0, 1), cB + hstep, voffB); PG8_STAGE(PG8_SA(0, 0), cA, voffA); PG8_STAGE(PG8_SA(0, 1), cA + hstep, voffA);
        if (wr == 1) PG8_BAR;
        PG8_WAIT_V(2); PG8_BAR;
        PG8_STAGE(PG8_SB(1, 0), cB + kstep, voffB); PG8_STAGE(PG8_SA(1, 0), cA + kstep, voffA); PG8_STAGE(PG8_SB(1, 1), cB + hstep + kstep, voffB);
        PG8_WAIT_V(6); PG8_BAR;
    } else {
        PG8_STAGE(PG8_SB(0, 0), cB, voffB); PG8_STAGE(PG8_SA(0, 0), cA, voffA); PG8_STAGE(PG8_SB(0, 1), cB + hstep, voffB); PG8_STAGE(PG8_SA(0, 1), cA + hstep, voffA);
        if (wr == 1) PG8_BAR;
        PG8_WAIT_V(4); PG8_BAR;
        PG8_STAGE(PG8_SB(1, 0), cB + kstep, voffB); PG8_STAGE(PG8_SA(1, 0), cA + kstep, voffA); PG8_STAGE(PG8_SB(1, 1), cB + hstep + kstep, voffB);
        PG8_WAIT_V(6); PG8_BAR;
    }
    for (;;) {
        const bool has_next = S.next(ui + 1, nxt);
        const char* nA = has_next ? (const char*)g.A + (size_t)nxt.pm * tstep : cA; const char* nB = has_next ? (const char*)g.Bt + (size_t)nxt.pn * tstep : cB;
_Pragma("unroll 1")
        for (int t = 0; t < nt; t += 2) {
            const bool last = (t == nt - 2);
            const char* a1 = cA + (size_t)(t + 1) * kstep;
            const char* a2 = last ? nA : cA + (size_t)(t + 2) * kstep; const char* b2 = last ? nB : cB + (size_t)(t + 2) * kstep;
            const char* a3 = a2 + kstep; const char* b3 = b2 + kstep;
            if (last && has_next) S.a_ready(nxt);
            if constexpr (SP2) {
            PG8_LDB(B0, 0, 0); PG8_LDB(B1, 0, 1); PG8_SCHED; PG8_LDA(At, 0, 0); PG8_STAGE(PG8_SA(1, 1), a1 + hstep, voffA);
            PG8_WAIT_V(8); PG8_WAIT_L(0); PG8_BAR; PG8_MMA(0, 0, At, B0); PG8_MMA(0, 1, At, B1); PG8_BAR; PG8_SCHED;
            PG8_LDA(At, 0, 1); PG8_STAGE(PG8_SB(0, 0), b2, voffB); PG8_STAGE(PG8_SB(0, 1), b2 + hstep, voffB); PG8_STAGE(PG8_SA(0, 0), a2, voffA);
            PG8_WAIT_V(8); PG8_WAIT_L(0); PG8_BAR; PG8_MMA(1, 0, At, B0); PG8_MMA(1, 1, At, B1); PG8_BAR; PG8_SCHED;
            PG8_LDB(B0, 1, 0); PG8_LDB(B1, 1, 1); PG8_SCHED; PG8_LDA(At, 1, 0); PG8_STAGE(PG8_SA(0, 1), a2 + hstep, voffA);
            PG8_WAIT_V(8); PG8_WAIT_L(0); PG8_BAR; PG8_MMA(0, 0, At, B0); PG8_MMA(0, 1, At, B1); PG8_BAR; PG8_SCHED;
            PG8_LDA(At, 1, 1); PG8_STAGE(PG8_SB(1, 0), b3, voffB); PG8_STAGE(PG8_SB(1, 1), b3 + hstep, voffB); PG8_STAGE(PG8_SA(1, 0), a3, voffA);
            PG8_WAIT_V(8); PG8_WAIT_L(0); PG8_BAR; PG8_MMA(1, 0, At, B0); PG8_MMA(1, 1, At, B1); PG8_BAR; PG8_SCHED;
            } else {
            PG8_LDB(B0, 0, 0); PG8_SCHED; PG8_LDA(At, 0, 0); PG8_STAGE(PG8_SA(1, 1), a1 + hstep, voffA);
            PG8_WAIT_L(8); PG8_BAR; PG8_WAIT_L(0); PG8_MMA(0, 0, At, B0); PG8_BAR; PG8_SCHED;
            PG8_LDB(B1, 0, 1); PG8_STAGE(PG8_SB(0, 0), b2, voffB);
            PG8_BAR; PG8_WAIT_L(0); PG8_MMA(0, 1, At, B1); PG8_BAR;
            PG8_LDA(At, 0, 1); PG8_STAGE(PG8_SA(0, 0), a2, voffA);
            PG8_BAR; PG8_WAIT_L(0); PG8_MMA(1, 0, At, B0); PG8_BAR; PG8_SCHED;
            PG8_STAGE(PG8_SB(0, 1), b2 + hstep, voffB);
            PG8_WAIT_V(6); PG8_BAR; PG8_MMA(1, 1, At, B1); PG8_BAR;
            PG8_LDB(B0, 1, 0); PG8_SCHED; PG8_LDA(At, 1, 0); PG8_STAGE(PG8_SA(0, 1), a2 + hstep, voffA);
            PG8_WAIT_L(8); PG8_BAR; PG8_WAIT_L(0); PG8_MMA(0, 0, At, B0); PG8_BAR; PG8_SCHED;
            PG8_LDB(B1, 1, 1); PG8_STAGE(PG8_SB(1, 0), b3, voffB);
            PG8_BAR; PG8_WAIT_L(0); PG8_MMA(0, 1, At, B1); PG8_BAR;
            PG8_LDA(At, 1, 1); PG8_STAGE(PG8_SA(1, 0), a3, voffA);
            PG8_BAR; PG8_WAIT_L(0); PG8_MMA(1, 0, At, B0); PG8_BAR; PG8_SCHED;
            PG8_STAGE(PG8_SB(1, 1), b3 + hstep, voffB);
            PG8_WAIT_V(6); PG8_BAR; PG8_MMA(1, 1, At, B1); PG8_BAR;
            }
        }
        if constexpr (FP8) { asm volatile("s_nop 15\n\ts_nop 15" ::: "memory"); }
        if constexpr (ALIGN_EPI) { if (wr == 0) PG8_BAR; }
        if constexpr (!Epi::AFTER_DRAIN) { E(acc, cur, wr, wc, fr, fq); S.done(cur); }
        if (!has_next) break;
#pragma unroll
        for (int a = 0; a < 2; ++a)
#pragma unroll
            for (int b = 0; b < 2; ++b)
#pragma unroll
                for (int m = 0; m < 4; ++m)
#pragma unroll
                    for (int n = 0; n < 2; ++n) acc[a][b][m][n] = (f32x4){0.f, 0.f, 0.f, 0.f};
        cur = nxt; cA = nA; cB = nB; ++ui;
        if constexpr (ALIGN_EPI) { if (wr == 1) PG8_BAR; }
    }
    PG8_WAIT_V(0);
    if constexpr (!ALIGN_EPI) { if (wr == 0) PG8_BAR; }
    PG8_BAR;
    if constexpr (Epi::AFTER_DRAIN) { E.fused(acc, cur, wr, wc, fr, fq, lds, wid, lane); S.done(cur); }
#undef PG8_SA
#undef PG8_SB
#undef PG8_STAGE
#undef PG8_LDA
#undef PG8_LDB
#undef PG8_MMA
#undef PG8_WAIT_V
#undef PG8_WAIT_L
#undef PG8_BAR
#undef PG8_SCHED
}
}
constexpr int NB = 4, SEQ = 4096, D = 1024, CTXL = 256, DEPTH = 2, GRIDW = 64, NROWS = 64;
constexpr int MX = NB * SEQ, MC = NB * CTXL, MT = MX + MC;
constexpr int NIN = 2560, NE = 16, FH = 2816, CAPX = 512, CAPC = 32, NMOD = 6;
constexpr int EROWS = 2304;
constexpr int ETILES = EROWS / 256, FNT = FH / 128;
constexpr int PQ = 0, PK = 512, PV = 1024, PBG = 1536, PCG = 1792, PU = 2048, PF = 2304;
constexpr float RMS_EPS = 1e-6f;
constexpr float S_ACT = 16.f, S_WGU = 256.f, S_HID = 4.f, S_WDN = 256.f;
constexpr int NWAVES = 8;

constexpr size_t MiB = 1u << 20;
constexpr size_t WS_CTL = 0, CTL_ZERO_BYTES = 1 * MiB;
constexpr size_t WS_MODX = 64 * 1024;
constexpr size_t WS_WINT = 2 * MiB;
constexpr size_t WS_WOUTT = 12 * MiB;
constexpr size_t WS_WGUT = 16 * MiB;
constexpr size_t WS_WDT = 368 * MiB;
constexpr size_t WS_H = 544 * MiB;
constexpr size_t WS_P = 578 * MiB;
constexpr size_t WS_NA = 663 * MiB;
constexpr size_t WS_FO = 680 * MiB;
constexpr size_t WS_TT = 697 * MiB;
constexpr size_t WS_GC = 729 * MiB;
constexpr size_t WS_Y = 731 * MiB;
constexpr size_t WS_MO = 765 * MiB;
constexpr size_t WS_HID = 578 * MiB;
constexpr size_t WS_X1 = 833 * MiB;
constexpr size_t WS_X2 = 901 * MiB;
constexpr size_t WS_H2 = 969 * MiB;
constexpr size_t WS_AFF = 1003 * MiB;
constexpr size_t WS_SLOT = 1005 * MiB;
constexpr size_t WS_XS = 1007 * MiB;
constexpr size_t WS_YE = 1079 * MiB;
constexpr size_t WS_END = 1151 * MiB;
static_assert(WS_HID + (size_t)NE * EROWS * FH * 2 <= WS_X1, "HID overlay");
static_assert(WS_MODX + (size_t)DEPTH * 5 * NMOD * D * 4 <= CTL_ZERO_BYTES, "MODX inside memset region");
constexpr int CW_BAR = 4096;

constexpr int RING_OFF = 0, RING_BYTES = 131072;
constexpr int LDSCTL_OFF = RING_BYTES, MISC_OFF = LDSCTL_OFF + 320;
constexpr int TW64_OFF = LDSCTL_OFF + 512, TW256_OFF = LDSCTL_OFF + 1024, TW4K_OFF = LDSCTL_OFF + 3072;
constexpr int CT_OFF = LDSCTL_OFF + 4096, ST_OFF = LDSCTL_OFF + 12288;
constexpr int RPB_OFF = LDSCTL_OFF + 20480;
constexpr int LDS_BYTES = LDSCTL_OFF + 20480 + 7680;
#define GAS __attribute__((address_space(1)))
#define LAS __attribute__((address_space(3)))
typedef unsigned short bf16;
typedef unsigned v4u __attribute__((ext_vector_type(4)));
typedef float f32x4 __attribute__((ext_vector_type(4)));
typedef short bf16x8 __attribute__((ext_vector_type(8)));
typedef GAS unsigned gu32;
typedef GAS unsigned long long gu64;
#define RLX_AGENT __ATOMIC_RELAXED, __HIP_MEMORY_SCOPE_AGENT
#define LDS_WAIT() asm volatile("s_waitcnt lgkmcnt(0)" ::: "memory")
#define VM_WAIT() asm volatile("s_waitcnt vmcnt(0)" ::: "memory")
__device__ __forceinline__ unsigned long long rt() { return __builtin_amdgcn_s_memrealtime(); }
__device__ __forceinline__ unsigned f2bf(float f) { unsigned u = __builtin_bit_cast(unsigned, f); return (u + 0x7fffu + ((u >> 16) & 1u)) >> 16; }
__device__ __forceinline__ unsigned pk2(float lo, float hi) { return f2bf(lo) | (f2bf(hi) << 16); }

#define XB_TMO      128
#define XB_XCNT(j)  (256  + 64 * (j))
#define XB_XSUB(j)  (1280 + 64 * (j))
#define XB_XGEN(j)  (2304 + 64 * (j))
#define XB_TOP      3328
#define XB_TOPGEN   3392
#define XCD_BAR_WORDS 3456
#define XB_SPIN_CAP (1u << 18)

__device__ __forceinline__ unsigned xb_ld(unsigned* p)              { return __hip_atomic_load(p, __ATOMIC_RELAXED, __HIP_MEMORY_SCOPE_AGENT); }
__device__ __forceinline__ unsigned xb_add(unsigned* p, unsigned v) { return __hip_atomic_fetch_add(p, v, __ATOMIC_RELAXED, __HIP_MEMORY_SCOPE_AGENT); }
__device__ __forceinline__ unsigned xb_xcc_id() { return (unsigned)__builtin_amdgcn_s_getreg((3 << 11) | 20) & 0xFu; }
#define XB_SPIN(cond, bar) do { unsigned _sp = 0; while (cond) { __builtin_amdgcn_s_sleep(1); \
    if ((++_sp & 255u) == 0u) { if (xb_ld(&(bar)[XB_TMO])) break; if (_sp > XB_SPIN_CAP) { atomicAdd(&(bar)[XB_TMO], 1u); break; } } } } while (0)

struct XcdBarrier {
    unsigned* bar; unsigned x;
    volatile LAS unsigned* st;
};

__device__ __forceinline__ XcdBarrier xcd_barrier_post(unsigned* bar, volatile LAS unsigned* st) {
    XcdBarrier b; b.bar = bar; b.x = xb_xcc_id(); b.st = st;
    if (threadIdx.x == 0) (void)xb_add(&bar[XB_XCNT(b.x)], 1u);
    return b;
}
__device__ __forceinline__ void xcd_barrier_complete(unsigned* bar, unsigned x, unsigned& nloc, unsigned& nx) {
    const unsigned G = gridDim.x * gridDim.y * gridDim.z;
    unsigned sum, cnt, mine, sp = 0u;
    for (;;) {
        sum = 0u; cnt = 0u; mine = 0u;
#pragma unroll
        for (unsigned j = 0; j < 16; ++j) { const unsigned c = xb_ld(&bar[XB_XCNT(j)]); sum += c; cnt += (c > 0u) ? 1u : 0u; mine = (j == x) ? c : mine; }
        if (sum == G) break;
        __builtin_amdgcn_s_sleep(1);
        if ((++sp & 255u) == 0u) { if (xb_ld(&bar[XB_TMO])) break; if (sp > XB_SPIN_CAP) { atomicAdd(&bar[XB_TMO], 1u); break; } }
    }
    nloc = mine > 0u ? mine : 1u; nx = cnt > 0u ? cnt : 1u;
}

__device__ __forceinline__ void xcd_barrier(const XcdBarrier& b) {
    asm volatile("s_waitcnt vmcnt(0)" ::: "memory");
    __syncthreads();
    if (threadIdx.x == 0) {
        unsigned* bar = b.bar;
        __builtin_amdgcn_s_waitcnt(0);
        unsigned nloc = b.st[0], nx = b.st[1];
        if (nloc == 0u) { xcd_barrier_complete(bar, b.x, nloc, nx); b.st[0] = nloc; b.st[1] = nx; }
        const unsigned old = xb_add(&bar[XB_XSUB(b.x)], 1u);
        const unsigned gen = old / nloc;
        if (old + 1u == (gen + 1u) * nloc) {
            __builtin_amdgcn_fence(__ATOMIC_RELEASE, "agent");
            asm volatile("s_waitcnt vmcnt(0)" ::: "memory");
            const unsigned og = xb_add(&bar[XB_TOP], 1u);
            const unsigned tg = og / nx;
            if (og + 1u == (tg + 1u) * nx) xb_add(&bar[XB_TOPGEN], 1u);
            else XB_SPIN(xb_ld(&bar[XB_TOPGEN]) == tg, bar);
            __builtin_amdgcn_fence(__ATOMIC_ACQUIRE, "agent");
            xb_add(&bar[XB_XGEN(b.x)], 1u);
            asm volatile("s_waitcnt vmcnt(0)" ::: "memory");
        } else {
            XB_SPIN(xb_ld(&bar[XB_XGEN(b.x)]) == gen, bar);
            __builtin_amdgcn_fence(__ATOMIC_ACQUIRE, "agent");
            asm volatile("s_waitcnt vmcnt(0)" ::: "memory");
        }
    }
    __syncthreads();
}
typedef LAS float lfloat;
typedef float f32x2 __attribute__((ext_vector_type(2)));
typedef unsigned u32x2 __attribute__((ext_vector_type(2)));
__device__ __forceinline__ float bflo(unsigned w) { return __uint_as_float(w << 16); }
__device__ __forceinline__ float bfhi(unsigned w) { return __uint_as_float(w & 0xffff0000u); }
__device__ __forceinline__ float bf2f(bf16 h) { return __uint_as_float((unsigned)h << 16); }
template <int CTRL> __device__ __forceinline__ float dppf(float v) { return __builtin_bit_cast(float, __builtin_amdgcn_update_dpp(0, __builtin_bit_cast(int, v), CTRL, 0xf, 0xf, true)); }
__device__ __forceinline__ float wave_sum(float v) {
    v += dppf<0xB1>(v); v += dppf<0x4E>(v); v += dppf<0x141>(v); v += dppf<0x140>(v);
    const float r0 = __builtin_bit_cast(float, __builtin_amdgcn_readlane(__builtin_bit_cast(int, v), 0)), r1 = __builtin_bit_cast(float, __builtin_amdgcn_readlane(__builtin_bit_cast(int, v), 16));
    const float r2 = __builtin_bit_cast(float, __builtin_amdgcn_readlane(__builtin_bit_cast(int, v), 32)), r3 = __builtin_bit_cast(float, __builtin_amdgcn_readlane(__builtin_bit_cast(int, v), 48));
    return (r0 + r1) + (r2 + r3);
}
__device__ __forceinline__ float wave_max(float v) {
#pragma unroll
    for (int o = 1; o < 64; o <<= 1) v = fmaxf(v, __shfl_xor(v, o));
    return v;
}
__device__ __forceinline__ float silu(float x) { return x / (1.0f + __expf(-x)); }

struct Ctx {
    unsigned char* ws; LAS unsigned char* lds;
    int tid, lane, wave, G, gw, NGW;
};
#define IN_X 0
#define IN_C 1
#define IN_CTX 2
#define IN_CCTX 3
#define IN_WMOD 4
#define IN_BMOD 5
#define IN_GPREMIX 6
#define IN_GPOSTMIX 7
#define IN_GPREFFN 8
#define IN_GPOSTFFN 9
#define IN_WIN 10
#define IN_RPB 11
#define IN_CONVW 12
#define IN_GMIXOUT 13
#define IN_WOUT 14
#define IN_WROUTER 15
#define IN_WGATE 16
#define IN_WUP 17
#define IN_WDOWN 18

__device__ __forceinline__ int mod_row(int row) { return row < MX ? (row >> 12) : 4; }
__device__ __forceinline__ const float* modx(const Ctx& C, int layer, int mr, int which) { return (const float*)(C.ws + WS_MODX) + ((size_t)(layer * 5 + mr) * NMOD + which) * D; }

__device__ __forceinline__ void transpose_item(const float* W, int K, int N, bf16* WT, int item, int mode, lfloat* scr, int lane) {
    const int nblk = N / 32, kb = item / nblk, nb = item % nblk, k0 = 64 * kb, n0 = 32 * nb;
#pragma unroll 8
    for (int i = 0; i < 32; ++i) { const int kk = 2 * i + (lane >> 5); scr[kk * 33 + (lane & 31)] = W[(size_t)(k0 + kk) * N + n0 + (lane & 31)]; }
    LDS_WAIT(); asm volatile("" ::: "memory");
    const int rowbase = mode == 0 ? n0 : ((n0 >> 7) * 256 + (n0 & 127) + (mode == 2 ? 128 : 0));
    const int c = lane & 7;
#pragma unroll
    for (int j = 0; j < 4; ++j) { const int n = (lane >> 3) + 8 * j; const lfloat* s = scr + (8 * c) * 33 + n;
        v4u o; o.x = pk2(s[0 * 33], s[1 * 33]); o.y = pk2(s[2 * 33], s[3 * 33]); o.z = pk2(s[4 * 33], s[5 * 33]); o.w = pk2(s[6 * 33], s[7 * 33]);
        *(GAS v4u*)(WT + (size_t)(rowbase + n) * K + k0 + 8 * c) = o; }
    LDS_WAIT(); asm volatile("" ::: "memory");
}
__device__ __forceinline__ void transpose_item8(const float* W, int K, int N, unsigned char* WT, int item, int mode, float scale, lfloat* scr, int lane) {
    const int nblk = N / 32, kb = item / nblk, nb = item % nblk, k0 = 128 * kb, n0 = 32 * nb;
    const int rowbase = mode == 0 ? n0 : ((n0 >> 7) * 256 + (n0 & 127) + (mode == 2 ? 128 : 0));
    const int c = lane & 3;
    v4u o[2][2];
#pragma unroll
    for (int hf = 0; hf < 2; ++hf) {
#pragma unroll 8
        for (int i = 0; i < 32; ++i) { const int kk = 2 * i + (lane >> 5); scr[kk * 33 + (lane & 31)] = W[(size_t)(k0 + 64 * hf + kk) * N + n0 + (lane & 31)] * scale; }
        LDS_WAIT(); asm volatile("" ::: "memory");
#pragma unroll
        for (int j = 0; j < 2; ++j) { const int n = (lane >> 2) + 16 * j; const lfloat* s = scr + (16 * c) * 33 + n;
            o[hf][j].x = pg8::pk4_fp8(s[0 * 33], s[1 * 33], s[2 * 33], s[3 * 33]); o[hf][j].y = pg8::pk4_fp8(s[4 * 33], s[5 * 33], s[6 * 33], s[7 * 33]);
            o[hf][j].z = pg8::pk4_fp8(s[8 * 33], s[9 * 33], s[10 * 33], s[11 * 33]); o[hf][j].w = pg8::pk4_fp8(s[12 * 33], s[13 * 33], s[14 * 33], s[15 * 33]); }
        LDS_WAIT(); asm volatile("" ::: "memory");
    }
#pragma unroll
    for (int j = 0; j < 2; ++j) { const int n = (lane >> 2) + 16 * j; unsigned char* dst = WT + (size_t)(rowbase + n) * K + k0 + 16 * c;
        *(GAS v4u*)dst = o[0][j]; *(GAS v4u*)(dst + 64) = o[1][j]; }
}
struct ExpItem { const float* src; unsigned char* dst; int N, K, mode; float scale; };
constexpr int IT_EXP = (D / 128) * (FH / 32);
static_assert((FH / 128) * (D / 32) == IT_EXP, "item counts");
constexpr int N_EXP_ITEMS = 3 * DEPTH * NE * IT_EXP;
__device__ __forceinline__ ExpItem exp_item(const float* const (&in)[19], unsigned char* ws, int it) {
    const int mat = it / (DEPTH * NE * IT_EXP), r = it % (DEPTH * NE * IT_EXP), le = r / IT_EXP, item = r % IT_EXP;
    ExpItem e;
    if (mat < 2) { const int nblk = FH / 32, kb = item / nblk, nb = item % nblk, k0 = 128 * kb, n0 = 32 * nb;
        e.N = FH; e.K = D; e.scale = S_WGU; e.src = in[mat == 0 ? IN_WGATE : IN_WUP] + (size_t)le * D * FH + (size_t)k0 * FH + n0;
        const int rowbase = (n0 >> 7) * 256 + (n0 & 127) + (mat == 1 ? 128 : 0);
        e.dst = ws + WS_WGUT + (size_t)le * 2 * FH * D + (size_t)rowbase * D + k0; }
    else { const int nblk = D / 32, kb = item / nblk, nb = item % nblk, k0 = 128 * kb, n0 = 32 * nb;
        e.N = D; e.K = FH; e.scale = S_WDN; e.src = in[IN_WDOWN] + (size_t)le * FH * D + (size_t)k0 * D + n0;
        e.dst = ws + WS_WDT + (size_t)le * D * FH + (size_t)n0 * FH + k0; }
    e.mode = 0;
    return e;
}
__device__ __forceinline__ void exp_issue(float (&r)[32], const float* src, int N, int lane) {
    const int lofs = (lane >> 5) * N + (lane & 31);
#pragma unroll
    for (int i = 0; i < 32; ++i) { const float* rowp = src + (size_t)(2 * i) * N; r[i] = rowp[lofs]; }
}
__device__ __forceinline__ void exp_half(const float (&r)[32], float scale, lfloat* scr, int lane, v4u (&o)[2]) {
#pragma unroll
    for (int i = 0; i < 32; ++i) scr[(2 * i + (lane >> 5)) * 33 + (lane & 31)] = r[i] * scale;
    LDS_WAIT(); asm volatile("" ::: "memory");
    const int c = lane & 3;
#pragma unroll
    for (int j = 0; j < 2; ++j) { const int n = (lane >> 2) + 16 * j; const lfloat* s = scr + (16 * c) * 33 + n;
        o[j].x = pg8::pk4_fp8(s[0 * 33], s[1 * 33], s[2 * 33], s[3 * 33]); o[j].y = pg8::pk4_fp8(s[4 * 33], s[5 * 33], s[6 * 33], s[7 * 33]);
        o[j].z = pg8::pk4_fp8(s[8 * 33], s[9 * 33], s[10 * 33], s[11 * 33]); o[j].w = pg8::pk4_fp8(s[12 * 33], s[13 * 33], s[14 * 33], s[15 * 33]); }
    LDS_WAIT(); asm volatile("" ::: "memory");
}
__device__ __forceinline__ void p0_expert_stream(const Ctx& C, const float* const (&in)[19], int it0, int it_end, int stride) {
    lfloat* scr = (lfloat*)(C.lds + RING_OFF + C.wave * 16384);
    const int lane = C.lane;
    int it = it0; float ra[32], rb[32];
    if (it >= it_end) return;
    ExpItem e = exp_item(in, C.ws, it);
    exp_issue(ra, e.src, e.N, lane);
    while (it < it_end) {
        exp_issue(rb, e.src + (size_t)64 * e.N, e.N, lane);
        v4u o0[2], o1[2];
        exp_half(ra, e.scale, scr, lane, o0);
        const int nit = it + stride; ExpItem ne = e;
        if (nit < it_end) { ne = exp_item(in, C.ws, nit); exp_issue(ra, ne.src, ne.N, lane); }
        exp_half(rb, e.scale, scr, lane, o1);
#pragma unroll
        for (int j = 0; j < 2; ++j) { const int n = (lane >> 2) + 16 * j; unsigned char* dst = e.dst + (size_t)n * e.K + 16 * (lane & 3);
            *(GAS v4u*)dst = o0[j]; *(GAS v4u*)(dst + 64) = o1[j]; }
        e = ne; it = nit;
    }
}
constexpr int IT_WIN = (D / 64) * (NIN / 32), IT_WOUT = (D / 64) * (D / 32), IT_GU = (D / 128) * (FH / 32), IT_DN = (FH / 128) * (D / 32);
constexpr int N_T_ITEMS = DEPTH * IT_WIN + DEPTH * IT_WOUT;
__device__ __forceinline__ void p0_prologue(const Ctx& C, const float* const (&in)[19]) {
    {
        lfloat* part = (lfloat*)(C.lds + RING_OFF);
        for (int it = blockIdx.x; it < DEPTH * (NMOD * D / 64); it += C.G) {
            const int l = it / (NMOD * D / 64), cb = it % (NMOD * D / 64), col = cb * 64 + C.lane;
            const float* wm = in[IN_WMOD] + (size_t)l * D * NMOD * D + col;
            float acc[5] = {0.f, 0.f, 0.f, 0.f, 0.f};
#pragma unroll 8
            for (int k = C.wave * 128; k < C.wave * 128 + 128; ++k) {
                const float wv = wm[(size_t)k * (NMOD * D)];
#pragma unroll
                for (int r = 0; r < 4; ++r) acc[r] += silu(in[IN_C][r * D + k]) * wv;
                acc[4] += silu(in[IN_CCTX][k]) * wv;
            }
#pragma unroll
            for (int r = 0; r < 5; ++r) part[(C.wave * 5 + r) * 64 + C.lane] = acc[r];
            __syncthreads();
            if (C.wave < 5) { const int r = C.wave; float sum = in[IN_BMOD][l * NMOD * D + col];
#pragma unroll
                for (int w = 0; w < 8; ++w) sum += part[(w * 5 + r) * 64 + C.lane];
                ((float*)(C.ws + WS_MODX))[(size_t)(l * 5 + r) * NMOD * D + col] = sum; }
            __syncthreads();
        }
    }
    lfloat* scr = (lfloat*)(C.lds + RING_OFF + C.wave * 16384);
    bf16* WINT = (bf16*)(C.ws + WS_WINT); bf16* WOUTT = (bf16*)(C.ws + WS_WOUTT);
    for (int it = C.gw; it < N_T_ITEMS; it += C.NGW) {
        int r = it;
        if (r < DEPTH * IT_WIN) { const int l = r / IT_WIN; transpose_item(in[IN_WIN] + (size_t)l * D * NIN, D, NIN, WINT + (size_t)l * NIN * D, r % IT_WIN, 0, scr, C.lane); continue; } r -= DEPTH * IT_WIN;
        { const int l = r / IT_WOUT; transpose_item(in[IN_WOUT] + (size_t)l * D * D, D, D, WOUTT + (size_t)l * D * D, r % IT_WOUT, 0, scr, C.lane); }
    }
    p0_expert_stream(C, in, C.gw, N_EXP_ITEMS, C.NGW);
}

__device__ __forceinline__ void norm_mod_store(const f32x4 (&v)[4], float ss, const float* g, const float* sh, const float* sc, bf16* orow, int lane) {
    const float rstd = 1.0f / sqrtf(ss * (1.f / D) + RMS_EPS);
#pragma unroll
    for (int j = 0; j < 4; ++j) {
        const f32x4 gg = ((const f32x4*)g)[lane + 64 * j], hh = ((const f32x4*)sh)[lane + 64 * j], cc = ((const f32x4*)sc)[lane + 64 * j];
        const f32x4 o = (v[j] * rstd * gg) * (cc + 1.0f) + hh;
        u32x2 w; w.x = pk2(o.x, o.y); w.y = pk2(o.z, o.w);
        ((u32x2*)orow)[lane + 64 * j] = w;
    }
}
__device__ __forceinline__ void stage_vec4(LAS float* dst, const float* src, int n4, int tid) { for (int i = tid; i < n4; i += NWAVES * 64) ((LAS f32x4*)dst)[i] = ((const f32x4*)src)[i]; }
__device__ __forceinline__ float sumsq4(const f32x4 (&v)[4]) { float ss = 0.f;
#pragma unroll
    for (int j = 0; j < 4; ++j) ss += (v[j].x * v[j].x + v[j].y * v[j].y) + (v[j].z * v[j].z + v[j].w * v[j].w);
    return ss; }
__device__ __forceinline__ void norm_mod_store_lds(const f32x4 (&v)[4], float ss, const LAS float* g, const LAS float* sh, const LAS float* sc, bf16* orow, int lane) {
    const float rstd = 1.0f / sqrtf(ss * (1.f / D) + RMS_EPS);
#pragma unroll
    for (int j = 0; j < 4; ++j) {
        const f32x4 gg = ((const LAS f32x4*)g)[lane + 64 * j], hh = ((const LAS f32x4*)sh)[lane + 64 * j], cc = ((const LAS f32x4*)sc)[lane + 64 * j];
        const f32x4 o = (v[j] * rstd * gg) * (cc + 1.0f) + hh;
        u32x2 w; w.x = pk2(o.x, o.y); w.y = pk2(o.z, o.w);
        ((u32x2*)orow)[lane + 64 * j] = w;
    }
}
__device__ __forceinline__ void p1_h0(const Ctx& C, const float* const (&in)[19]) {
    bf16* H = (bf16*)(C.ws + WS_H);
    LAS float* LG = (LAS float*)(C.lds + RING_OFF); LAS float* LM = LG + D;
    stage_vec4(LG, in[IN_GPREMIX], D / 4, C.tid);
    for (int r = 0; r < 5; ++r) stage_vec4(LM + r * 2 * D, modx(C, 0, r, 0), 2 * D / 4, C.tid);
    __syncthreads();
    const int lane = C.lane;
    int row = C.gw; f32x4 v[4], nv[4];
    if (row < MT) { const float* xr = row < MX ? in[IN_X] + (size_t)row * D : in[IN_CTX] + (size_t)(row - MX) * D;
#pragma unroll
        for (int j = 0; j < 4; ++j) v[j] = ((const f32x4*)xr)[lane + 64 * j]; }
    while (row < MT) {
        const int nrow = row + C.NGW;
        if (nrow < MT) { const float* xr = nrow < MX ? in[IN_X] + (size_t)nrow * D : in[IN_CTX] + (size_t)(nrow - MX) * D;
#pragma unroll
            for (int j = 0; j < 4; ++j) nv[j] = ((const f32x4*)xr)[lane + 64 * j]; }
        const float ss = wave_sum(sumsq4(v)); const int mr = mod_row(row);
        norm_mod_store_lds(v, ss, LG, LM + mr * 2 * D, LM + mr * 2 * D + D, H + (size_t)row * D, lane);
#pragma unroll
        for (int j = 0; j < 4; ++j) v[j] = nv[j];
        row = nrow;
    }
}
__device__ __forceinline__ float dot64(const float (&q)[64], const bf16* krow) {
    const v4u* p = (const v4u*)krow; float a = 0.f;
#pragma unroll
    for (int t = 0; t < 8; ++t) { const v4u w = p[t];
        a += q[8 * t + 0] * bflo(w.x) + q[8 * t + 1] * bfhi(w.x) + q[8 * t + 2] * bflo(w.y) + q[8 * t + 3] * bfhi(w.y)
           + q[8 * t + 4] * bflo(w.z) + q[8 * t + 5] * bfhi(w.z) + q[8 * t + 6] * bflo(w.w) + q[8 * t + 7] * bfhi(w.w); }
    return a;
}
__device__ __forceinline__ void axpy64(float (&o)[64], float p, const bf16* vrow) {
    const v4u* pp = (const v4u*)vrow;
#pragma unroll
    for (int t = 0; t < 8; ++t) { const v4u w = pp[t];
        o[8 * t + 0] += p * bflo(w.x); o[8 * t + 1] += p * bfhi(w.x); o[8 * t + 2] += p * bflo(w.y); o[8 * t + 3] += p * bfhi(w.y);
        o[8 * t + 4] += p * bflo(w.z); o[8 * t + 5] += p * bfhi(w.z); o[8 * t + 6] += p * bflo(w.w); o[8 * t + 7] += p * bfhi(w.w); }
}
__device__ __forceinline__ void attn_key(const float (&q)[64], float (&o)[64], float& m, float& l, float bias, const bf16* P, int key, int head) {
    const float s = dot64(q, P + (size_t)key * NIN + PK + head * 64) + bias;
    if (s > m) { const float alpha = __expf(m - s); l *= alpha;
#pragma unroll
        for (int d = 0; d < 64; ++d) o[d] *= alpha;
        m = s; }
    const float p = __expf(s - m); l += p;
    axpy64(o, p, P + (size_t)key * NIN + PV + head * 64);
}
__device__ __forceinline__ void p_attn_naive(const Ctx& C, const float* const (&in)[19], int layer) {
    const bf16* P = (const bf16*)(C.ws + WS_P); bf16* NA = (bf16*)(C.ws + WS_NA);
    const float* rpb = in[IN_RPB] + (size_t)layer * 8 * 15 * 31;
    const int nitems = layer == 0 ? 2048 + 128 : 2048;
    for (int id = C.gw; id < nitems; id += C.NGW) {
        const bool isctx = id >= 2048;
        int b, h, r = 0, c = 0, qrow;
        if (!isctx) { b = id >> 9; r = (id >> 3) & 63; h = id & 7; c = C.lane; qrow = b * SEQ + r * 64 + c; }
        else { const int j = id - 2048; b = j >> 5; h = (j >> 2) & 7; qrow = MX + b * CTXL + (j & 3) * 64 + C.lane; }
        float q[64], o[64];
        { const v4u* p = (const v4u*)(P + (size_t)qrow * NIN + PQ + h * 64);
#pragma unroll
          for (int t = 0; t < 8; ++t) { const v4u w = p[t];
              q[8 * t + 0] = 0.125f * bflo(w.x); q[8 * t + 1] = 0.125f * bfhi(w.x); q[8 * t + 2] = 0.125f * bflo(w.y); q[8 * t + 3] = 0.125f * bfhi(w.y);
              q[8 * t + 4] = 0.125f * bflo(w.z); q[8 * t + 5] = 0.125f * bfhi(w.z); q[8 * t + 6] = 0.125f * bflo(w.w); q[8 * t + 7] = 0.125f * bfhi(w.w); } }
#pragma unroll
        for (int d = 0; d < 64; ++d) o[d] = 0.f;
        float m = -1e30f, l = 0.f;
        if (!isctx) {
            const int rs = min(max(r - 4, 0), NROWS - 8), cs = min(max(c - 8, 0), GRIDW - 16);
            for (int kr = 0; kr < 8; ++kr) {
                const float* bp = rpb + (size_t)h * 465 + (rs + kr - r + 7) * 31 + 15;
#pragma unroll 1
                for (int i = 0; i < 16; ++i) { const int dc = min(max(cs + i - c, -15), 15); attn_key(q, o, m, l, bp[dc], P, b * SEQ + (rs + kr) * 64 + cs + i, h); }
            }
        }
#pragma unroll 1
        for (int j = 0; j < CTXL; ++j) attn_key(q, o, m, l, 0.f, P, MX + b * CTXL + j, h);
        const float inv = 1.0f / l;
        v4u* op = (v4u*)(NA + (size_t)qrow * 512 + h * 64);
#pragma unroll
        for (int t = 0; t < 8; ++t) { v4u w; w.x = pk2(o[8 * t] * inv, o[8 * t + 1] * inv); w.y = pk2(o[8 * t + 2] * inv, o[8 * t + 3] * inv);
            w.z = pk2(o[8 * t + 4] * inv, o[8 * t + 5] * inv); w.w = pk2(o[8 * t + 6] * inv, o[8 * t + 7] * inv); op[t] = w; }
    }
}

typedef short v4i16_t __attribute__((ext_vector_type(4)));
__device__ __forceinline__ bf16x8 pack8(const f32x4& a, const f32x4& b) {
    v4u w; w.x = pk2(a[0], a[1]); w.y = pk2(a[2], a[3]); w.z = pk2(b[0], b[1]); w.w = pk2(b[2], b[3]); return __builtin_bit_cast(bf16x8, w);
}
__device__ __forceinline__ bf16x8 neg8(const bf16x8& a) { v4u w = __builtin_bit_cast(v4u, a); w.x ^= 0x80008000u; w.y ^= 0x80008000u; w.z ^= 0x80008000u; w.w ^= 0x80008000u; return __builtin_bit_cast(bf16x8, w); }
#define MFMA16(a, b, c) __builtin_amdgcn_mfma_f32_16x16x32_bf16((a), (b), (c), 0, 0, 0)
constexpr float LOG2E = 1.4426950408889634f;
struct AttnStage { v4u k[5], v[5]; };
__device__ __forceinline__ void attn_issue(AttnStage& R, const bf16* src, unsigned lofs) {
#pragma unroll
    for (int i = 0; i < 5; ++i) { const char* bi = (const char*)src + (size_t)i * (8 * NIN * 2);
        R.k[i] = *(const v4u*)(bi + lofs); R.v[i] = *(const v4u*)(bi + (PV - PK) * 2 + lofs); }
}
__device__ __forceinline__ void attn_commit(const AttnStage& R, LAS unsigned char* kdst) {
#pragma unroll
    for (int i = 0; i < 5; ++i) { *(LAS v4u*)(kdst + i * 1024) = R.k[i]; *(LAS v4u*)(kdst + 8192 + i * 1024) = R.v[i]; }
}
struct AttnAddr { const LAS unsigned char* k[2]; const LAS unsigned char* v[4]; };
__device__ __forceinline__ AttnAddr attn_addr(const LAS unsigned char* KL, const LAS unsigned char* VL, int lr, int lq) {
    AttnAddr A;
#pragma unroll
    for (int ks = 0; ks < 2; ++ks) A.k[ks] = KL + lr * 128 + (((4 * ks + lq) ^ (lr & 7)) << 4);
    const int qq = lr >> 2, p = lr & 3, row = 4 * lq + qq;
#pragma unroll
    for (int dt = 0; dt < 4; ++dt) A.v[dt] = VL + row * 128 + (((2 * dt + (p >> 1)) ^ (row & 7)) << 4) + 8 * (p & 1);
    return A;
}
__device__ __forceinline__ bf16x8 attn_v_op(const LAS unsigned char* va, int kb0, int kb1) {
    const v4i16_t lo = __builtin_amdgcn_ds_read_tr16_b64_v4i16((LAS v4i16_t*)(va + kb0 * 128));
    const v4i16_t hi = __builtin_amdgcn_ds_read_tr16_b64_v4i16((LAS v4i16_t*)(va + kb1 * 128));
    return (bf16x8){lo[0], lo[1], lo[2], lo[3], hi[0], hi[1], hi[2], hi[3]};
}
__device__ __forceinline__ float xmax4(float v) { v = fmaxf(v, __shfl_xor(v, 16)); v = fmaxf(v, __shfl_xor(v, 32)); return v; }
template <int NT, bool WIN, int KB>
__device__ __forceinline__ void attn_block(const AttnAddr& A, const bf16x8 (&QB)[2], f32x4 (&O)[4], float& m, float& l, bool first, int lo, const LAS bf16* bias, int lq) {
    const f32x4 z4 = (f32x4){0.f, 0.f, 0.f, 0.f};
    constexpr float SC = 0.125f * LOG2E;
    float s[NT][4];
#pragma unroll
    for (int t = 0; t < NT; ++t) {
        f32x4 a = MFMA16(*(const LAS bf16x8*)(A.k[0] + (KB + 16 * t) * 128), QB[0], z4);
        a = MFMA16(*(const LAS bf16x8*)(A.k[1] + (KB + 16 * t) * 128), QB[1], a);
#pragma unroll
        for (int r = 0; r < 4; ++r) { const int kk = 16 * t + 4 * lq + r; float v = a[r] * SC;
            if (WIN) { v += bf2f(bias[kk]); v = ((unsigned)(kk - lo) < 16u) ? v : -1e30f; }
            s[t][r] = v; }
        asm volatile("" ::: "memory");
    }
    if (first) { float mc = -1e30f;
#pragma unroll
        for (int t = 0; t < NT; ++t)
#pragma unroll
            for (int r = 0; r < 4; ++r) mc = fmaxf(mc, s[t][r]);
        m = xmax4(mc); }
    float ps = 0.f;
#pragma unroll
    for (int t = 0; t < NT; ++t)
#pragma unroll
        for (int r = 0; r < 4; ++r) { s[t][r] = __builtin_amdgcn_exp2f(fminf(s[t][r] - m, 100.f)); ps += s[t][r]; }
    l += ps;
#pragma unroll
    for (int kp = 0; kp < NT / 2; ++kp) {
        const bf16x8 bp = pack8((f32x4){s[2 * kp][0], s[2 * kp][1], s[2 * kp][2], s[2 * kp][3]}, (f32x4){s[2 * kp + 1][0], s[2 * kp + 1][1], s[2 * kp + 1][2], s[2 * kp + 1][3]});
#pragma unroll
        for (int dt = 0; dt < 4; ++dt) { O[dt] = MFMA16(attn_v_op(A.v[dt], KB + 32 * kp, KB + 32 * kp + 16), bp, O[dt]); if (dt & 1) asm volatile("" ::: "memory"); }
    }
}
__device__ __forceinline__ void p_attn(const Ctx& C, const float* const (&in)[19], int layer) {
    const bf16* P = (const bf16*)(C.ws + WS_P); bf16* NA = (bf16*)(C.ws + WS_NA);
    LAS unsigned char* KL = C.lds + RING_OFF + C.wave * 16384; LAS unsigned char* VL = KL + 8192;
    LAS bf16* RPB = (LAS bf16*)(C.lds + RPB_OFF) + 32;
    { const float* rpb = in[IN_RPB] + (size_t)layer * 8 * 465;
      for (int u = C.tid; u < 8 * 465; u += NWAVES * 64) RPB[u] = (bf16)f2bf(rpb[u] * LOG2E);
      __syncthreads(); }
    const int lane = C.lane, lr = lane & 15, lq = lane >> 4;
    const AttnAddr AD = attn_addr(KL, VL, lr, lq);
    const unsigned lofs = (unsigned)(((lane >> 3) * NIN + (lane & 7) * 8) * 2);
    LAS unsigned char* kdst = KL + (lane >> 3) * 128 + (((lane & 7) ^ ((lane >> 3) & 7)) << 4); LAS unsigned char* vdst = kdst + 8192;
    const int nitems = layer == 0 ? 4096 + 256 : 4096;
    for (int id = C.gw; id < nitems; id += C.NGW) {
        const bool isctx = id >= 4096;
        int b, h, r = 0, half = 0, qtok0;
        if (!isctx) { b = id >> 10; r = (id >> 4) & 63; h = (id >> 1) & 7; half = id & 1; qtok0 = b * SEQ + r * 64 + 32 * half; }
        else { const int j = id - 4096; b = j >> 6; h = (j >> 3) & 7; qtok0 = MX + b * CTXL + (j & 7) * 32; }
        bf16x8 QB[2][2];
#pragma unroll
        for (int qb = 0; qb < 2; ++qb) { const bf16* qp = P + (size_t)(qtok0 + 16 * qb + lr) * NIN + PQ + h * 64 + 8 * lq; QB[qb][0] = *(const bf16x8*)qp; QB[qb][1] = *(const bf16x8*)(qp + 32); }
        f32x4 O[2][4]; float m[2], l[2];
#pragma unroll
        for (int qb = 0; qb < 2; ++qb) { m[qb] = -1e30f; l[qb] = 0.f;
#pragma unroll
            for (int dt = 0; dt < 4; ++dt) O[qb][dt] = (f32x4){0.f, 0.f, 0.f, 0.f}; }
        const int rs = min(max(r - 4, 0), NROWS - 8), kc0 = 24 * half;
        const bf16* wsrc = P + (size_t)(b * SEQ + rs * 64 + kc0) * NIN + h * 64 + PK;
        const bf16* csrc = P + (size_t)(MX + b * CTXL) * NIN + h * 64 + PK;
        const int c0 = isctx ? 8 : 0; int c = c0;
        AttnStage R;
        attn_issue(R, c < 8 ? wsrc + (size_t)c * 64 * NIN : csrc + (size_t)(c - 8) * 32 * NIN, lofs);
#pragma unroll 1
        for (; c < 16; ++c) {
            attn_commit(R, kdst);
            if (c + 1 < 16) attn_issue(R, (c + 1) < 8 ? wsrc + (size_t)(c + 1) * 64 * NIN : csrc + (size_t)(c - 7) * 32 * NIN, lofs);
            LDS_WAIT(); asm volatile("" ::: "memory");
            if (c < 8) {
                const LAS bf16* brow = RPB + h * 465 + (rs + c - r + 7) * 31;
#define ATTN_WIN(qb, ks0) { const int col = 32 * half + 16 * (qb) + lr, cs = min(max(col - 8, 0), GRIDW - 16); attn_block<2, true, ks0>(AD, QB[qb], O[qb], m[qb], l[qb], c == c0, cs - (kc0 + (ks0)), brow + ((kc0 + (ks0)) - col + 15), lq); __builtin_amdgcn_sched_barrier(0); }
                ATTN_WIN(0, 0) ATTN_WIN(1, 8)
#undef ATTN_WIN
            } else {
#pragma unroll
                for (int qb = 0; qb < 2; ++qb) { attn_block<2, false, 0>(AD, QB[qb], O[qb], m[qb], l[qb], c == c0, 0, RPB, lq); __builtin_amdgcn_sched_barrier(0); }
            }
            asm volatile("" ::: "memory");
        }
#pragma unroll
        for (int qb = 0; qb < 2; ++qb) {
            float lt = l[qb]; lt += __shfl_xor(lt, 16); lt += __shfl_xor(lt, 32);
            const float inv = 1.0f / lt;
            bf16* op = NA + (size_t)(qtok0 + 16 * qb + lr) * 512 + h * 64 + 4 * lq;
#pragma unroll
            for (int dt = 0; dt < 4; ++dt) { u32x2 w; w.x = pk2(O[qb][dt][0] * inv, O[qb][dt][1] * inv); w.y = pk2(O[qb][dt][2] * inv, O[qb][dt][3] * inv); *(u32x2*)(op + 16 * dt) = w; }
        }
    }
}

__device__ __forceinline__ void p_fft_a(const Ctx& C) {
    const bf16* P = (const bf16*)(C.ws + WS_P); bf16* TT = (bf16*)(C.ws + WS_TT);
    const LAS unsigned char* CT = C.lds + CT_OFF; const LAS unsigned char* ST = C.lds + ST_OFF;
    const LAS f32x2* tw64 = (const LAS f32x2*)(C.lds + TW64_OFF); const LAS f32x2* tw4k = (const LAS f32x2*)(C.lds + TW4K_OFF);
    const int lane = C.lane, lr = lane & 15, lq = lane >> 4;
    const f32x4 z4 = (f32x4){0.f, 0.f, 0.f, 0.f};
    for (int id = C.wave * C.G + (int)blockIdx.x; id < NB * 4 * 64; id += C.NGW)     {
        const int b = id >> 8, g = (id >> 6) & 3, n2 = id & 63;
        bf16x8 FA[4][2];
#pragma unroll
        for (int mt = 0; mt < 4; ++mt) { const int n1 = 32 * (mt >> 1) + 8 * (lr >> 2) + 4 * (mt & 1) + (lr & 3);
            const bf16* fr = P + (size_t)(b * SEQ + 64 * n1 + n2) * NIN + PF + g * 64 + 8 * lq;
            FA[mt][0] = *(const bf16x8*)fr; FA[mt][1] = *(const bf16x8*)(fr + 32); }
        float tcs[4][4], tsn[4][4];
#pragma unroll
        for (int kt = 0; kt < 4; ++kt)
#pragma unroll
            for (int r = 0; r < 4; ++r) { const int kn = (16 * kt + 4 * lq + r) * n2; const f32x2 wa = tw64[(kn >> 6) & 63], wb = tw4k[kn & 63];
                tcs[kt][r] = wa.x * wb.x - wa.y * wb.y; tsn[kt][r] = wa.y * wb.x + wa.x * wb.y; }
#pragma unroll 1
        for (int jt = 0; jt < 4; ++jt) {
            bf16x8 cb[2], sb[2];
#pragma unroll
            for (int ks = 0; ks < 2; ++ks) { cb[ks] = *(const LAS bf16x8*)(CT + (16 * jt + lr) * 128 + (32 * ks + 8 * lq) * 2); sb[ks] = *(const LAS bf16x8*)(ST + (16 * jt + lr) * 128 + (32 * ks + 8 * lq) * 2); }
            f32x4 gr[4], gi[4];
#pragma unroll
            for (int mt = 0; mt < 4; ++mt) { gr[mt] = MFMA16(FA[mt][0], cb[0], z4); gr[mt] = MFMA16(FA[mt][1], cb[1], gr[mt]); gi[mt] = MFMA16(FA[mt][0], sb[0], z4); gi[mt] = MFMA16(FA[mt][1], sb[1], gi[mt]); }
            bf16x8 BGr[2], BGi[2], BnGi[2];
#pragma unroll
            for (int p = 0; p < 2; ++p) { BGr[p] = pack8(gr[2 * p], gr[2 * p + 1]); BGi[p] = pack8(gi[2 * p], gi[2 * p + 1]); BnGi[p] = neg8(BGi[p]); }
#pragma unroll
            for (int kt = 0; kt < 4; ++kt) {
                f32x4 tr = z4, nti = z4;
#pragma unroll
                for (int p = 0; p < 2; ++p) { const bf16x8 ca = *(const LAS bf16x8*)(CT + (16 * kt + lr) * 128 + (32 * p + 8 * lq) * 2), sa = *(const LAS bf16x8*)(ST + (16 * kt + lr) * 128 + (32 * p + 8 * lq) * 2);
                    tr = MFMA16(ca, BGr[p], tr); tr = MFMA16(sa, BnGi[p], tr); nti = MFMA16(ca, BGi[p], nti); nti = MFMA16(sa, BGr[p], nti); }
#pragma unroll
                for (int r = 0; r < 4; ++r) { const int k1 = 16 * kt + 4 * lq + r; const float cs = tcs[kt][r], sn = tsn[kt][r];
                    const float tpr = cs * tr[r] - sn * nti[r], tpi = -cs * nti[r] - sn * tr[r];
                    bf16* dst = TT + ((size_t)(((b * 4 + g) * 64 + k1) * 2) * 64 + n2) * 64 + 16 * jt + lr;
                    dst[0] = (bf16)f2bf(tpr); dst[64 * 64] = (bf16)f2bf(tpi); }
            }
        }
    }
}
__device__ __forceinline__ void p_fft_b(const Ctx& C) {
    const bf16* TT = (const bf16*)(C.ws + WS_TT); float* FO = (float*)(C.ws + WS_FO);
    const LAS unsigned char* CT = C.lds + CT_OFF; const LAS unsigned char* ST = C.lds + ST_OFF;
    LAS unsigned char* scr = C.lds + RING_OFF + C.wave * 16384;
    const int lane = C.lane, lr = lane & 15, lq = lane >> 4;
    const f32x4 z4 = (f32x4){0.f, 0.f, 0.f, 0.f};
    for (int id = C.wave * C.G + (int)blockIdx.x; id < NB * 4 * 64; id += C.NGW)     {
        const int b = id >> 8, g = (id >> 6) & 3, k1 = id & 63;
        const v4u* src = (const v4u*)(TT + (size_t)(((b * 4 + g) * 64 + k1) * 2) * 64 * 64);
#pragma unroll
        for (int i = 0; i < 16; ++i) { const v4u w = src[i * 64 + lane]; *(LAS v4u*)(scr + (i * 64 + lane) * 16) = w; }
        LDS_WAIT(); asm volatile("" ::: "memory");
        f32x4 acc[4][4];
#pragma unroll
        for (int kt = 0; kt < 4; ++kt)
#pragma unroll
            for (int jt = 0; jt < 4; ++jt) acc[kt][jt] = z4;
#pragma unroll
        for (int ri = 0; ri < 2; ++ri)
#pragma unroll
            for (int ks = 0; ks < 2; ++ks) {
                bf16x8 Bop[4];
#pragma unroll
                for (int jt = 0; jt < 4; ++jt) {
                    const int r0 = 32 * ks + 8 * lq; const LAS unsigned char* pa = scr + ri * 8192 + (r0 + (lr >> 2)) * 128 + (16 * jt + 4 * (lr & 3)) * 2;
                    const v4i16_t lo = __builtin_amdgcn_ds_read_tr16_b64_v4i16((LAS v4i16_t*)pa), hi = __builtin_amdgcn_ds_read_tr16_b64_v4i16((LAS v4i16_t*)(pa + 4 * 128));
                    Bop[jt] = (bf16x8){lo[0], lo[1], lo[2], lo[3], hi[0], hi[1], hi[2], hi[3]}; }
#pragma unroll
                for (int kt = 0; kt < 4; ++kt) { const bf16x8 aop = *(const LAS bf16x8*)((ri == 0 ? CT : ST) + (16 * kt + lr) * 128 + (32 * ks + 8 * lq) * 2);
#pragma unroll
                    for (int jt = 0; jt < 4; ++jt) acc[kt][jt] = MFMA16(aop, Bop[jt], acc[kt][jt]); }
            }
#pragma unroll
        for (int kt = 0; kt < 4; ++kt)
#pragma unroll
            for (int r = 0; r < 4; ++r) { const int k2 = 16 * kt + 4 * lq + r; float* dst = FO + (size_t)(b * SEQ + k1 + 64 * k2) * 256 + g * 64 + lr;
#pragma unroll
                for (int jt = 0; jt < 4; ++jt) dst[16 * jt] = acc[kt][jt][r] * (1.0f / 512.0f); }
        LDS_WAIT(); asm volatile("" ::: "memory");
    }
}
__device__ __forceinline__ void p_fft_ctx1(const Ctx& C) {
    const bf16* P = (const bf16*)(C.ws + WS_P); f32x2* GC = (f32x2*)(C.ws + WS_GC);
    const LAS f32x2* tw64 = (const LAS f32x2*)(C.lds + TW64_OFF);
    const int lane = C.lane;
    for (int id = C.gw; id < NB * 4 * CTXL; id += C.NGW) {
        const int b = id >> 10, g = (id >> 8) & 3, n = id & 255;
        const float fv = bf2f(P[(size_t)(MX + b * CTXL + n) * NIN + PF + g * 64 + lane]);
        float gr = 0.f, gi = 0.f;
#pragma unroll
        for (int c = 0; c < 64; ++c) { const float f = __builtin_bit_cast(float, __builtin_amdgcn_readlane(__builtin_bit_cast(int, fv), c)); const f32x2 t = tw64[(lane * c) & 63]; gr += f * t.x; gi -= f * t.y; }
        GC[(size_t)((b * 4 + g) * CTXL + n) * 64 + lane] = (f32x2){gr, gi};
    }
}
__device__ __forceinline__ void p_fft_ctx2(const Ctx& C) {
    const f32x2* GC = (const f32x2*)(C.ws + WS_GC); float* FO = (float*)(C.ws + WS_FO);
    const LAS f32x2* tw256 = (const LAS f32x2*)(C.lds + TW256_OFF);
    const int lane = C.lane;
    for (int id = C.wave * C.G + (int)blockIdx.x; id < NB * 4 * 64; id += C.NGW) {
        const int b = id >> 8, g = (id >> 6) & 3, kc = id & 63;
        float acc[4] = {0.f, 0.f, 0.f, 0.f};
        const f32x2* gp = GC + (size_t)((b * 4 + g) * CTXL) * 64 + lane;
#pragma unroll 16
        for (int n = 0; n < CTXL; ++n) {
            const f32x2 gv = gp[(size_t)n * 64];
#pragma unroll
            for (int kk = 0; kk < 4; ++kk) { const f32x2 t = tw256[((kc * 4 + kk) * n) & 255]; acc[kk] += t.x * gv.x + t.y * gv.y; }
        }
#pragma unroll
        for (int kk = 0; kk < 4; ++kk) FO[(size_t)(MX + b * CTXL + kc * 4 + kk) * 256 + g * 64 + lane] = acc[kk] * (1.0f / 128.0f);
    }
}

struct MergeIn { v4u na; u32x2 cg[3], uu[3], bg; f32x4 fo; };
__device__ __forceinline__ void merge_load(MergeIn& m, const bf16* P, const bf16* NA, const float* FO, int row, int lane) {
    const bool isctx = row >= MX; const int slen = isctx ? CTXL : SEQ, pos = isctx ? ((row - MX) & (CTXL - 1)) : (row & (SEQ - 1));
    m.na = *(const v4u*)(NA + (size_t)row * 512 + 8 * lane);
    const bf16* pr = P + (size_t)row * NIN;
#pragma unroll
    for (int dk = 0; dk < 3; ++dk) { const int pp = pos + dk - 1; const bool ok = pp >= 0 && pp < slen; const bf16* pq = pr + (ptrdiff_t)(dk - 1) * NIN;
        m.cg[dk] = (u32x2){0u, 0u}; m.uu[dk] = (u32x2){0u, 0u};
        if (ok) { m.cg[dk] = *(const u32x2*)(pq + PCG + 4 * lane); m.uu[dk] = *(const u32x2*)(pq + PU + 4 * lane); } }
    m.bg = *(const u32x2*)(pr + PBG + 4 * lane);
    m.fo = *(const f32x4*)(FO + (size_t)row * 256 + 4 * lane);
}
__device__ __forceinline__ void p_merge(const Ctx& C, const float* const (&in)[19], int layer) {
    const bf16* P = (const bf16*)(C.ws + WS_P); const bf16* NA = (const bf16*)(C.ws + WS_NA); const float* FO = (const float*)(C.ws + WS_FO); bf16* Y = (bf16*)(C.ws + WS_Y);
    LAS float* cw = (LAS float*)(C.lds + RING_OFF); LAS float* gm = cw + 768;
    stage_vec4(cw, in[IN_CONVW] + (size_t)layer * 3 * 256, 768 / 4, C.tid); stage_vec4(gm, in[IN_GMIXOUT] + (size_t)layer * D, D / 4, C.tid);
    __syncthreads();
    const int nrows = layer == 0 ? MT : MX, lane = C.lane;
    int row = C.gw; MergeIn m, nm;
    if (row < nrows) merge_load(m, P, NA, FO, row, lane);
    while (row < nrows) {
        const int nrow = row + C.NGW;
        if (nrow < nrows) merge_load(nm, P, NA, FO, nrow, lane);
        float na[8]; { const v4u w = m.na;
            na[0] = bflo(w.x); na[1] = bfhi(w.x); na[2] = bflo(w.y); na[3] = bfhi(w.y); na[4] = bflo(w.z); na[5] = bfhi(w.z); na[6] = bflo(w.w); na[7] = bfhi(w.w); }
        float s_na = 0.f;
#pragma unroll
        for (int i = 0; i < 8; ++i) s_na += na[i] * na[i];
        float z[3][4];
#pragma unroll
        for (int dk = 0; dk < 3; ++dk) { const u32x2 cg = m.cg[dk], uu = m.uu[dk];
            z[dk][0] = bflo(cg.x) * bflo(uu.x); z[dk][1] = bfhi(cg.x) * bfhi(uu.x); z[dk][2] = bflo(cg.y) * bflo(uu.y); z[dk][3] = bfhi(cg.y) * bfhi(uu.y); }
        const u32x2 bgw = m.bg;
        const f32x4 w0 = *(const LAS f32x4*)(cw + 4 * lane), w1 = *(const LAS f32x4*)(cw + 256 + 4 * lane), w2 = *(const LAS f32x4*)(cw + 512 + 4 * lane);
        float cv[4];
        cv[0] = bflo(bgw.x) * (w0.x * z[0][0] + w1.x * z[1][0] + w2.x * z[2][0]); cv[1] = bfhi(bgw.x) * (w0.y * z[0][1] + w1.y * z[1][1] + w2.y * z[2][1]);
        cv[2] = bflo(bgw.y) * (w0.z * z[0][2] + w1.z * z[1][2] + w2.z * z[2][2]); cv[3] = bfhi(bgw.y) * (w0.w * z[0][3] + w1.w * z[1][3] + w2.w * z[2][3]);
        float s_cv = cv[0] * cv[0] + cv[1] * cv[1] + cv[2] * cv[2] + cv[3] * cv[3];
        const f32x4 fo = m.fo;
        float s_fo = fo.x * fo.x + fo.y * fo.y + fo.z * fo.z + fo.w * fo.w;
        s_na = wave_sum(s_na); s_cv = wave_sum(s_cv); s_fo = wave_sum(s_fo);
        const float r_na = 1.0f / sqrtf(s_na * (1.f / 512.f) + RMS_EPS), r_cv = 1.0f / sqrtf(s_cv * (1.f / 256.f) + RMS_EPS), r_fo = 1.0f / sqrtf(s_fo * (1.f / 256.f) + RMS_EPS);
        bf16* yr = Y + (size_t)row * D;
        { const f32x4 g0 = *(const LAS f32x4*)(gm + 8 * lane), g1 = *(const LAS f32x4*)(gm + 8 * lane + 4);
          v4u w; w.x = pk2(na[0] * r_na * g0.x, na[1] * r_na * g0.y); w.y = pk2(na[2] * r_na * g0.z, na[3] * r_na * g0.w);
          w.z = pk2(na[4] * r_na * g1.x, na[5] * r_na * g1.y); w.w = pk2(na[6] * r_na * g1.z, na[7] * r_na * g1.w); *(v4u*)(yr + 8 * lane) = w; }
        { const f32x4 g0 = *(const LAS f32x4*)(gm + 512 + 4 * lane); u32x2 w; w.x = pk2(cv[0] * r_cv * g0.x, cv[1] * r_cv * g0.y); w.y = pk2(cv[2] * r_cv * g0.z, cv[3] * r_cv * g0.w); *(u32x2*)(yr + 512 + 4 * lane) = w; }
        { const f32x4 g0 = *(const LAS f32x4*)(gm + 768 + 4 * lane); u32x2 w; w.x = pk2(fo.x * r_fo * g0.x, fo.y * r_fo * g0.y); w.y = pk2(fo.z * r_fo * g0.z, fo.w * r_fo * g0.w); *(u32x2*)(yr + 768 + 4 * lane) = w; }
        m = nm; row = nrow;
    }
}
__device__ __forceinline__ const float* xin_row(const Ctx& C, const float* const (&in)[19], int layer, int row) {
    if (layer == 0) return row < MX ? in[IN_X] + (size_t)row * D : in[IN_CTX] + (size_t)(row - MX) * D;
    return (const float*)(C.ws + WS_X2) + (size_t)row * D;
}
__device__ __forceinline__ void postmix_rows(const Ctx& C, const float* const (&in)[19], int layer, int row0, int rstride, int rend, const LAS float* WR, const LAS float* GPOST, const LAS float* GPRE, const LAS float* G1, const LAS float* SH2, const LAS float* SC2) {
    const float* MO = (const float*)(C.ws + WS_MO); float* X1 = (float*)(C.ws + WS_X1); unsigned char* H2 = C.ws + WS_H2; float* AFF = (float*)(C.ws + WS_AFF);
    const int lane = C.lane;
    int row = row0; f32x4 v[4], xx[4], nv[4], nx[4];
    if (row < rend) { const float* xr = xin_row(C, in, layer, row);
#pragma unroll
        for (int j = 0; j < 4; ++j) { v[j] = ((const f32x4*)(MO + (size_t)row * D))[lane + 64 * j]; xx[j] = ((const f32x4*)xr)[lane + 64 * j]; } }
    while (row < rend) {
        const int nrow = row + rstride;
        if (nrow < rend) { const float* xr = xin_row(C, in, layer, nrow);
#pragma unroll
            for (int j = 0; j < 4; ++j) { nv[j] = ((const f32x4*)(MO + (size_t)nrow * D))[lane + 64 * j]; nx[j] = ((const f32x4*)xr)[lane + 64 * j]; } }
        const float r1 = 1.0f / sqrtf(wave_sum(sumsq4(v)) * (1.f / D) + RMS_EPS);
#pragma unroll
        for (int j = 0; j < 4; ++j) { const f32x4 gg = ((const LAS f32x4*)GPOST)[lane + 64 * j], g1v = ((const LAS f32x4*)G1)[lane + 64 * j];
            v[j] = xx[j] + g1v * (v[j] * r1 * gg); ((f32x4*)(X1 + (size_t)row * D))[lane + 64 * j] = v[j]; }
        const float r2 = 1.0f / sqrtf(wave_sum(sumsq4(v)) * (1.f / D) + RMS_EPS);
        float acc[NE];
#pragma unroll
        for (int e = 0; e < NE; ++e) acc[e] = 0.f;
#pragma unroll
        for (int j = 0; j < 4; ++j) {
            const f32x4 gg = ((const LAS f32x4*)GPRE)[lane + 64 * j], hh = ((const LAS f32x4*)SH2)[lane + 64 * j], cc = ((const LAS f32x4*)SC2)[lane + 64 * j];
            const f32x4 h = (v[j] * r2 * gg) * (cc + 1.0f) + hh;
            ((unsigned*)(H2 + (size_t)row * D))[lane + 64 * j] = pg8::pk4_fp8(h.x * S_ACT, h.y * S_ACT, h.z * S_ACT, h.w * S_ACT);
#pragma unroll
            for (int e = 0; e < NE; ++e) { const f32x4 ww = ((const LAS f32x4*)(WR + e * D))[lane + 64 * j]; acc[e] += (h.x * ww.x + h.y * ww.y) + (h.z * ww.z + h.w * ww.w);
                if ((e & 7) == 7) asm volatile("" ::: "memory"); }
        }
        float mx = -1e30f;
#pragma unroll
        for (int e = 0; e < NE; ++e) { acc[e] = wave_sum(acc[e]); mx = fmaxf(mx, acc[e]); }
        float sum = 0.f;
#pragma unroll
        for (int e = 0; e < NE; ++e) { acc[e] = expf(acc[e] - mx); sum += acc[e]; }
        const float inv = 1.0f / sum;
        if (lane == 0) {
#pragma unroll
            for (int q4 = 0; q4 < 4; ++q4) ((f32x4*)(AFF + (size_t)row * NE))[q4] = (f32x4){acc[4 * q4] * inv, acc[4 * q4 + 1] * inv, acc[4 * q4 + 2] * inv, acc[4 * q4 + 3] * inv};
        }
#pragma unroll
        for (int j = 0; j < 4; ++j) { v[j] = nv[j]; xx[j] = nx[j]; }
        row = nrow;
    }
}
__device__ __forceinline__ void p_postmix(const Ctx& C, const float* const (&in)[19], int layer) {
    LAS float* WR = (LAS float*)(C.lds + RING_OFF); LAS float* GPOST = WR + D * NE; LAS float* GPRE = GPOST + D; LAS float* G1 = GPRE + D; LAS float* SH2 = G1 + D; LAS float* SC2 = SH2 + D;
    { const float* wr = in[IN_WROUTER] + (size_t)layer * D * NE;
      for (int u = C.tid; u < D * NE / 4; u += NWAVES * 64) { const f32x4 w = ((const f32x4*)wr)[u]; const int d = u >> 2, e0 = (u & 3) * 4;
          WR[(e0 + 0) * D + d] = w.x; WR[(e0 + 1) * D + d] = w.y; WR[(e0 + 2) * D + d] = w.z; WR[(e0 + 3) * D + d] = w.w; } }
    stage_vec4(GPOST, in[IN_GPOSTMIX] + (size_t)layer * D, D / 4, C.tid); stage_vec4(GPRE, in[IN_GPREFFN] + (size_t)layer * D, D / 4, C.tid);
    const bool by_sample = (C.G & 3) == 0;
    const int npass = by_sample ? 1 : 4;
    for (int ps = 0; ps < npass; ++ps) {
        const int b = by_sample ? ((int)blockIdx.x & 3) : ps;
        if (ps > 0) __syncthreads();
        stage_vec4(G1, modx(C, layer, b, 2), 3 * D / 4, C.tid);
        __syncthreads();
        const int wgs = by_sample ? C.G / 4 : C.G, wgi = by_sample ? ((int)blockIdx.x >> 2) : (int)blockIdx.x;
        postmix_rows(C, in, layer, b * SEQ + wgi * NWAVES + C.wave, wgs * NWAVES, (b + 1) * SEQ, WR, GPOST, GPRE, G1, SH2, SC2);
    }
    if (layer == 0) {
        __syncthreads();
        stage_vec4(G1, modx(C, layer, 4, 2), 3 * D / 4, C.tid);
        __syncthreads();
        postmix_rows(C, in, layer, MX + C.gw, C.NGW, MT, WR, GPOST, GPRE, G1, SH2, SC2);
    }
}

__device__ __forceinline__ int wave_isum(int v) {
#pragma unroll
    for (int o = 1; o < 64; o <<= 1) v += __shfl_xor(v, o);
    return v;
}
__device__ __forceinline__ void p_route(const Ctx& C, int layer) {
    const float* AFF = (const float*)(C.ws + WS_AFF); int* SLOT = (int*)(C.ws + WS_SLOT); const unsigned char* H2 = C.ws + WS_H2; unsigned char* XS = C.ws + WS_XS;
    LAS int* red = (LAS int*)(C.lds + RING_OFF);
    LAS int* list = (LAS int*)(C.lds + RING_OFF + 1024); LAS int* cnt = (LAS int*)(C.lds + RING_OFF + 512);
    const int nitems = layer == 0 ? 256 + 64 : 256;
    for (int item = blockIdx.x; item < nitems; item += C.G) {
        int b, e, NT, rowbase, cap, tok0, ntok, xsbase;
        if (item < 256) { b = item >> 6; e = (item >> 2) & 15; NT = SEQ; rowbase = b * SEQ; cap = CAPX; tok0 = (item & 3) * 1024; ntok = 1024; xsbase = e * EROWS + b * CAPX; }
        else { const int j = item - 256; b = j >> 4; e = j & 15; NT = CTXL; rowbase = MX + b * CTXL; cap = CAPC; tok0 = 0; ntok = CTXL; xsbase = e * EROWS + NB * CAPX + b * CAPC; }
        unsigned v[8];
#pragma unroll
        for (int j = 0; j < 8; ++j) { const int t = C.tid * 8 + j; v[j] = t < NT ? __float_as_uint(AFF[(size_t)(rowbase + t) * NE + e]) : 0u; }
        if (C.tid == 0) *cnt = 0;
        unsigned T = 0u;
        for (int bit = 30; bit >= 0; --bit) {
            const unsigned cand = T | (1u << bit); int c = 0;
#pragma unroll
            for (int j = 0; j < 8; ++j) c += (v[j] >= cand) ? 1 : 0;
            c = wave_isum(c);
            LAS int* r = red + (bit & 1) * 8;
            if (C.lane == 0) r[C.wave] = c;
            __syncthreads();
            int tot = 0;
#pragma unroll
            for (int w = 0; w < 8; ++w) tot += r[w];
            if (tot >= cap) T = cand;
        }
        int cg = 0, ce = 0;
#pragma unroll
        for (int j = 0; j < 8; ++j) { cg += (v[j] > T) ? 1 : 0; ce += (v[j] == T && (C.tid * 8 + j) < NT) ? 1 : 0; }
        int sg = cg, se = ce;
#pragma unroll
        for (int o = 1; o < 64; o <<= 1) { const int ag = __shfl_up(sg, o), ae = __shfl_up(se, o); if (C.lane >= o) { sg += ag; se += ae; } }
        LAS int* sc = red + 64;
        __syncthreads();
        if (C.lane == 63) { sc[C.wave] = sg; sc[8 + C.wave] = se; }
        __syncthreads();
        int bg = 0, be = 0, totg = 0;
#pragma unroll
        for (int w = 0; w < 8; ++w) { const int xg = sc[w], xe = sc[8 + w]; if (w < C.wave) { bg += xg; be += xe; } totg += xg; }
        int pg = bg + sg - cg, pe = be + se - ce;
        const int need_eq = cap - totg;
#pragma unroll
        for (int j = 0; j < 8; ++j) {
            const int t = C.tid * 8 + j; const bool gt = v[j] > T, eq = (v[j] == T) && t < NT;
            const bool sel = gt || (eq && pe < need_eq);
            const int slot = pg + min(pe, need_eq);
            if (t >= tok0 && t < tok0 + ntok) {
                SLOT[(size_t)(rowbase + t) * NE + e] = sel ? slot : -1;
                if (sel) { const int pos = atomicAdd((int*)cnt, 1); list[2 * pos] = t; list[2 * pos + 1] = slot; }
            }
            pg += gt ? 1 : 0; pe += eq ? 1 : 0;
        }
        __syncthreads();
        const int n = *cnt;
        for (int idx = C.wave; idx < n; idx += NWAVES) { const int t = list[2 * idx], slot = list[2 * idx + 1];
            const v4u* src = (const v4u*)(H2 + (size_t)(rowbase + t) * D); v4u* dst = (v4u*)(XS + (size_t)(xsbase + slot) * D);
            dst[C.lane] = src[C.lane]; }
        __syncthreads();
    }
}

__device__ __forceinline__ void combine_rows(const Ctx& C, float* XO, int layer, int row0, int rstride, int rend, int ebase, const LAS float* GPF, const LAS float* G2, const LAS float* GP1, const LAS float* SH1, const LAS float* SC1) {
    const float* AFF = (const float*)(C.ws + WS_AFF); const int* SLOT = (const int*)(C.ws + WS_SLOT); const bf16* YE = (const bf16*)(C.ws + WS_YE); const float* X1 = (const float*)(C.ws + WS_X1); bf16* H = (bf16*)(C.ws + WS_H);
    const int lane = C.lane, le = lane & 15;
    int row = row0; f32x4 xx[4], nx[4]; int sl = -1, nsl = -1; float gt = 0.f, ngt = 0.f;
    if (row < rend) { sl = SLOT[(size_t)row * NE + le]; gt = AFF[(size_t)row * NE + le];
#pragma unroll
        for (int j = 0; j < 4; ++j) xx[j] = ((const f32x4*)(X1 + (size_t)row * D))[lane + 64 * j]; }
    while (row < rend) {
        const int nrow = row + rstride;
        if (nrow < rend) { nsl = SLOT[(size_t)nrow * NE + le]; ngt = AFF[(size_t)nrow * NE + le];
#pragma unroll
            for (int j = 0; j < 4; ++j) nx[j] = ((const f32x4*)(X1 + (size_t)nrow * D))[lane + 64 * j]; }
        f32x4 a[4];
#pragma unroll
        for (int j = 0; j < 4; ++j) a[j] = (f32x4){0.f, 0.f, 0.f, 0.f};
        unsigned mask = (unsigned)(__builtin_amdgcn_ballot_w64(sl >= 0) & 0xffffull);
        while (mask) {
            const int e0 = __builtin_ctz(mask); mask &= mask - 1u;
            const int s0 = __builtin_amdgcn_readlane(sl, e0); const float g0 = __builtin_bit_cast(float, __builtin_amdgcn_readlane(__builtin_bit_cast(int, gt), e0));
            const u32x2* y0 = (const u32x2*)(YE + (size_t)(e0 * EROWS + ebase + s0) * D);
            if (mask) {
                const int e1 = __builtin_ctz(mask); mask &= mask - 1u;
                const int s1 = __builtin_amdgcn_readlane(sl, e1); const float g1 = __builtin_bit_cast(float, __builtin_amdgcn_readlane(__builtin_bit_cast(int, gt), e1));
                const u32x2* y1 = (const u32x2*)(YE + (size_t)(e1 * EROWS + ebase + s1) * D);
                u32x2 w0[4], w1[4];
#pragma unroll
                for (int j = 0; j < 4; ++j) { w0[j] = y0[lane + 64 * j]; w1[j] = y1[lane + 64 * j]; }
#pragma unroll
                for (int j = 0; j < 4; ++j) { a[j].x += g0 * bflo(w0[j].x); a[j].y += g0 * bfhi(w0[j].x); a[j].z += g0 * bflo(w0[j].y); a[j].w += g0 * bfhi(w0[j].y); }
#pragma unroll
                for (int j = 0; j < 4; ++j) { a[j].x += g1 * bflo(w1[j].x); a[j].y += g1 * bfhi(w1[j].x); a[j].z += g1 * bflo(w1[j].y); a[j].w += g1 * bfhi(w1[j].y); }
            } else {
#pragma unroll
                for (int j = 0; j < 4; ++j) { const u32x2 w = y0[lane + 64 * j]; a[j].x += g0 * bflo(w.x); a[j].y += g0 * bfhi(w.x); a[j].z += g0 * bflo(w.y); a[j].w += g0 * bfhi(w.y); }
            }
        }
        const float r = 1.0f / sqrtf(wave_sum(sumsq4(a)) * (1.f / D) + RMS_EPS);
#pragma unroll
        for (int j = 0; j < 4; ++j) { const f32x4 gg = ((const LAS f32x4*)GPF)[lane + 64 * j], g2v = ((const LAS f32x4*)G2)[lane + 64 * j];
            a[j] = xx[j] + g2v * (a[j] * r * gg); ((f32x4*)(XO + (size_t)row * D))[lane + 64 * j] = a[j]; }
        if (layer == 0) norm_mod_store_lds(a, wave_sum(sumsq4(a)), GP1, SH1, SC1, H + (size_t)row * D, lane);
#pragma unroll
        for (int j = 0; j < 4; ++j) xx[j] = nx[j];
        sl = nsl; gt = ngt; row = nrow;
    }
}
__device__ __forceinline__ void p_combine(const Ctx& C, const float* const (&in)[19], float* out, int layer) {
    float* XO = layer == 0 ? (float*)(C.ws + WS_X2) : out;
    LAS float* GPF = (LAS float*)(C.lds + RING_OFF); LAS float* GP1 = GPF + D; LAS float* G2 = GP1 + D; LAS float* SH1 = G2 + D; LAS float* SC1 = SH1 + D;
    stage_vec4(GPF, in[IN_GPOSTFFN] + (size_t)layer * D, D / 4, C.tid);
    if (layer == 0) stage_vec4(GP1, in[IN_GPREMIX] + D, D / 4, C.tid);
    const bool by_sample = (C.G & 3) == 0; const int npass = by_sample ? 1 : 4;
    for (int ps = 0; ps < npass; ++ps) {
        const int b = by_sample ? ((int)blockIdx.x & 3) : ps;
        if (ps > 0) __syncthreads();
        stage_vec4(G2, modx(C, layer, b, 5), D / 4, C.tid);
        if (layer == 0) stage_vec4(SH1, modx(C, 1, b, 0), 2 * D / 4, C.tid);
        __syncthreads();
        const int wgs = by_sample ? C.G / 4 : C.G, wgi = by_sample ? ((int)blockIdx.x >> 2) : (int)blockIdx.x;
        combine_rows(C, XO, layer, b * SEQ + wgi * NWAVES + C.wave, wgs * NWAVES, (b + 1) * SEQ, b * CAPX, GPF, G2, GP1, SH1, SC1);
    }
    if (layer == 0) {
        for (int b = 0; b < NB; ++b) {
            __syncthreads();
            if (b == 0) { stage_vec4(G2, modx(C, layer, 4, 5), D / 4, C.tid); stage_vec4(SH1, modx(C, 1, 4, 0), 2 * D / 4, C.tid); }
            __syncthreads();
            combine_rows(C, XO, layer, MX + b * CTXL + C.gw, C.NGW, MX + (b + 1) * CTXL, NB * CAPX + b * CAPC, GPF, G2, GP1, SH1, SC1);
        }
    }
}
constexpr int NPH = 22;
#ifndef MK_PER_PHASE
#define MK_PER_PHASE 0
#endif
struct Args { const float* in[19]; float* out; unsigned char* ws; int ph_lo, ph_hi; };
__global__ void __launch_bounds__(NWAVES * 64, 2) mk_fwd(Args args) {
    extern __shared__ __attribute__((aligned(16))) unsigned char lds_raw[];
    Ctx C;
    C.ws = args.ws; C.lds = (LAS unsigned char*)lds_raw;
    C.tid = threadIdx.x; C.lane = C.tid & 63; C.wave = __builtin_amdgcn_readfirstlane(C.tid >> 6); C.G = gridDim.x;
    C.gw = blockIdx.x * NWAVES + C.wave; C.NGW = C.G * NWAVES;
    volatile LAS unsigned* MISC = (volatile LAS unsigned*)(C.lds + MISC_OFF);
    for (int u = C.tid; u < (512 - 0) / 4; u += NWAVES * 64) ((LAS unsigned*)(C.lds + LDSCTL_OFF))[u] = 0u;
    if (C.tid < 64) { float s, c; sincospif((float)C.tid * (1.0f / 32.0f), &s, &c); ((LAS f32x2*)(C.lds + TW64_OFF))[C.tid] = (f32x2){c, s}; }
    if (C.tid < 256) { float s, c; sincospif((float)C.tid * (1.0f / 128.0f), &s, &c); ((LAS f32x2*)(C.lds + TW256_OFF))[C.tid] = (f32x2){c, s}; }
    if (C.tid >= 256 && C.tid < 320) { float s, c; sincospif((float)(C.tid - 256) * (1.0f / 2048.0f), &s, &c); ((LAS f32x2*)(C.lds + TW4K_OFF))[C.tid - 256] = (f32x2){c, s}; }
    for (int u = C.tid; u < 4096; u += NWAVES * 64) { float s, c; sincospif((float)(((u >> 6) * (u & 63)) & 63) * (1.0f / 32.0f), &s, &c); ((LAS bf16*)(C.lds + CT_OFF))[u] = (bf16)f2bf(c); ((LAS bf16*)(C.lds + ST_OFF))[u] = (bf16)f2bf(s); }
    __syncthreads();
    gu32* ctl = (gu32*)(C.ws + WS_CTL);
    XcdBarrier bar = xcd_barrier_post((unsigned*)(ctl + CW_BAR), MISC + 8);
    const int lo = args.ph_lo, hi = args.ph_hi;
#ifndef DBG_MASK
#define DBG_MASK 0xffffffffu
#endif
#define PH_ON(k) (((DBG_MASK) >> (k)) & 1u)
#ifndef DBG_REP
#define DBG_REP 0u
#endif
#define REP(k) _Pragma("unroll") for (int rep_ = 0; rep_ < 1 + (int)(((DBG_REP) >> (k)) & 1u); ++rep_)
#define IN(k) (lo <= (k) && (k) < hi)
#define SEAM(k) do { if (IN(k) && IN((k) + 1)) xcd_barrier(bar); } while (0)

    if (PH_ON(0) && IN(0)) REP(0) p0_prologue(C, args.in);
    SEAM(0);
    if (PH_ON(1) && IN(1)) REP(1) p1_h0(C, args.in);
    SEAM(1);
    for (int layer = 0; layer < DEPTH; ++layer) {
        const int pb = 2 + 10 * layer;
        Ctx L = C; asm volatile("" : "+v"(L.tid), "+v"(L.lane)); asm volatile("" : "+s"(L.wave), "+s"(L.gw));
        if (PH_ON(2) && IN(pb + 0)) REP(2) {
            pg8::Gemm g{(const pg8::bf16_t*)(L.ws + WS_H), (const pg8::bf16_t*)(L.ws + WS_WINT) + (size_t)layer * NIN * D, MT, NIN, D};
            pg8::TileOrder S; S.init(MT / 256, NIN / 256, L.G, (int)blockIdx.x);
            pg8::EpiBf16Map E{(pg8::bf16_t*)(L.ws + WS_P), NIN, 1 << 30, 1.0f};
            pg8::gemm_phase<pg8::EpiBf16Map, pg8::TileOrder, true, true>(L.lds + RING_OFF, g, S, E);
        }
        SEAM(pb + 0);
        if (IN(pb + 1)) { if (PH_ON(3)) REP(3) p_attn(L, args.in, layer); if (PH_ON(4)) REP(4) p_fft_a(L); if (PH_ON(5) && layer == 0) REP(5) p_fft_ctx1(L); }
        SEAM(pb + 1);
        if (IN(pb + 2)) { if (PH_ON(6)) REP(6) p_fft_b(L); if (PH_ON(5) && layer == 0) REP(5) p_fft_ctx2(L); }
        SEAM(pb + 2);
        if (PH_ON(7) && IN(pb + 3)) REP(7) p_merge(L, args.in, layer);
        SEAM(pb + 3);
        if (PH_ON(8) && IN(pb + 4)) REP(8) {
            pg8::Gemm g{(const pg8::bf16_t*)(L.ws + WS_Y), (const pg8::bf16_t*)(L.ws + WS_WOUTT) + (size_t)layer * D * D, MT, D, D};
            pg8::TileOrder S; S.init((layer == 0 ? MT : MX) / 256, D / 256, L.G, (int)blockIdx.x);
            pg8::EpiF32 E{(float*)(L.ws + WS_MO), D};
            pg8::gemm_phase<pg8::EpiF32, pg8::TileOrder, true, true>(L.lds + RING_OFF, g, S, E);
        }
        SEAM(pb + 4);
        if (PH_ON(9) && IN(pb + 5)) REP(9) p_postmix(L, args.in, layer);
        SEAM(pb + 5);
        if (PH_ON(10) && IN(pb + 6)) REP(10) p_route(L, layer);
        SEAM(pb + 6);
        if (PH_ON(11) && IN(pb + 7)) REP(11) {
            pg8::Gemm g{(const pg8::bf16_t*)(L.ws + WS_XS), (const pg8::bf16_t*)(L.ws + WS_WGUT + (size_t)layer * NE * 2 * FH * D), NE * EROWS, NE * 2 * FH, D / 2};
            pg8::GroupOrder S; S.init(NE, layer == 0 ? ETILES : ETILES - 1, ETILES, FNT, L.G, (int)blockIdx.x);
            pg8::EpiSwiGLU8 E{L.ws + WS_HID, FH, FNT, 1.0f / (S_ACT * S_WGU), S_HID};
            pg8::gemm_phase<pg8::EpiSwiGLU8, pg8::GroupOrder, true, true, true>(L.lds + RING_OFF, g, S, E);
        }
        SEAM(pb + 7);
        if (PH_ON(12) && IN(pb + 8)) REP(12) {
            pg8::Gemm g{(const pg8::bf16_t*)(L.ws + WS_HID), (const pg8::bf16_t*)(L.ws + WS_WDT + (size_t)layer * NE * D * FH), NE * EROWS, NE * D, FH / 2};
            pg8::GroupOrder S; S.init(NE, layer == 0 ? ETILES : ETILES - 1, ETILES, D / 256, L.G, (int)blockIdx.x);
            pg8::EpiBf16Map E{(pg8::bf16_t*)(L.ws + WS_YE), D, D / 256, 1.0f / (S_HID * S_WDN)};
            pg8::gemm_phase<pg8::EpiBf16Map, pg8::GroupOrder, true, true, true>(L.lds + RING_OFF, g, S, E);
        }
        SEAM(pb + 8);
        if (PH_ON(13) && IN(pb + 9)) REP(13) p_combine(L, args.in, args.out, layer);
        SEAM(pb + 9);
#ifdef DBG_XBAR
        for (int xb = 0; xb < DBG_XBAR; ++xb) xcd_barrier(bar);
#endif
    }
#undef IN
#undef SEAM
}

extern "C" void kernel_launch(void* const* d_in, const int* in_sizes, int n_in, void* d_out, int out_size, void* d_ws, size_t ws_size, hipStream_t stream) {
    static int grid = 0;
    if (grid == 0) {
        if (n_in != 19 || in_sizes[0] != MX * D || out_size != MX * D || ws_size < WS_END) { fprintf(stderr, "kernel_launch: unexpected shapes (n_in %d, in0 %d, out %d, ws %zu < %zu); nothing launched\n", n_in, n_in > 0 ? in_sizes[0] : -1, out_size, ws_size, (size_t)WS_END); grid = -1; return; }
        int dev = 0, cus = 0, per_cu = 0;
        if (hipGetDevice(&dev) != hipSuccess || hipDeviceGetAttribute(&cus, hipDeviceAttributeMultiprocessorCount, dev) != hipSuccess) { fprintf(stderr, "kernel_launch: device query failed\n"); grid = -1; return; }
        if (hipFuncSetAttribute((const void*)mk_fwd, hipFuncAttributeMaxDynamicSharedMemorySize, LDS_BYTES) != hipSuccess) { fprintf(stderr, "kernel_launch: hipFuncSetAttribute failed\n"); grid = -1; return; }
        if (hipOccupancyMaxActiveBlocksPerMultiprocessor(&per_cu, (const void*)mk_fwd, NWAVES * 64, LDS_BYTES) != hipSuccess || per_cu < 1)
            fprintf(stderr, "kernel_launch: note: occupancy query reports %d workgroups per CU\n", per_cu);
        (void)hipGetLastError();
        grid = cus;
    }
    if (grid < 0) return;
    if (hipMemsetAsync((char*)d_ws + WS_CTL, 0, CTL_ZERO_BYTES, stream) != hipSuccess) { fprintf(stderr, "kernel_launch: memset failed\n"); return; }
    Args a{};
    for (int i = 0; i < 19; ++i) a.in[i] = (const float*)d_in[i];
    a.out = (float*)d_out; a.ws = (unsigned char*)d_ws;
#if MK_PER_PHASE
    for (int ph = 0; ph < NPH; ++ph) { a.ph_lo = ph; a.ph_hi = ph + 1; hipLaunchKernelGGL(mk_fwd, dim3(grid), dim3(NWAVES * 64), LDS_BYTES, stream, a); }
#else
    a.ph_lo = 0; a.ph_hi = NPH;
    hipLaunchKernelGGL(mk_fwd, dim3(grid), dim3(NWAVES * 64), LDS_BYTES, stream, a);
#endif
    const hipError_t le = hipPeekAtLastError();
    if (le != hipSuccess) fprintf(stderr, "kernel_launch: launch failed: %s\n", hipGetErrorName(le));
}
```

```cpp
#include <hip/hip_runtime.h>
#include <cstdio>
#include <cstdint>
namespace pg8 {
#define PG8_LAS __attribute__((address_space(3)))
typedef unsigned short bf16_t;
typedef short bf16x8 __attribute__((ext_vector_type(8)));
typedef float f32x4 __attribute__((ext_vector_type(4)));
typedef unsigned u32x4 __attribute__((ext_vector_type(4)));
typedef int i32x4 __attribute__((ext_vector_type(4)));
typedef int i32x8 __attribute__((ext_vector_type(8)));
typedef unsigned u32x2 __attribute__((ext_vector_type(2)));
constexpr int BM = 256, BK = 64, HALF = 128, HTB = HALF * BK * 2  , STAGE_BYTES = 8 * HTB, NXCD = 8, WGM = 8;

__host__ __device__ __forceinline__ int lds_byte(int r, int c) { const int st = (r >> 4) * 2 + (c >> 5), rr = r & 15, cc = c & 31, ob = rr * 64 + cc * 2; return st * 1024 + (ob ^ (((ob >> 9) & 1) << 5)); }
__host__ __device__ __forceinline__ void stage_rc(int b, int& R, int& C) { const int st = b / 1024, sb = b % 1024, swz = sb ^ (((sb >> 9) & 1) << 5); R = (st >> 1) * 16 + swz / 64; C = (st & 1) * 32 + (swz % 64) / 2; }
__host__ __device__ __forceinline__ int perm32(int rho) { const int n = rho >> 4, i = rho & 15; return 8 * (i >> 2) + 4 * n + (i & 3); }

struct Unit { int pm, pn; };
struct Gemm { const bf16_t* A; const bf16_t* Bt; int M, N, K; };

struct StaticOrder {
    int nM, nN, nwg, G, c;
    __host__ __device__ void init(int M, int N, int G_, int c_) { nM = M / BM; nN = N / BM; nwg = nM * nN; G = G_; c = c_; }
    __host__ __device__ bool next(int i, Unit& u) const {
        const long L = (long)i * G + c; if (L >= nwg) return false;
        int wgid = (int)L; { const int q = nwg / NXCD, r = nwg % NXCD, xcd = wgid % NXCD, off = wgid / NXCD; wgid = (xcd < r ? xcd * (q + 1) : r * (q + 1) + (xcd - r) * q) + off; }
        const int nig = WGM * nN, gid = wgid / nig, fm = gid * WGM, gsz = (nM - fm) < WGM ? (nM - fm) : WGM;
        u.pm = fm + ((wgid % nig) % gsz); u.pn = (wgid % nig) / gsz; return true;
    }
    __device__ __forceinline__ void a_ready(const Unit&) const {}
    __device__ __forceinline__ void done(const Unit&) const {}
};

__device__ __forceinline__ unsigned cvt_pk_bf16(float lo, float hi) { unsigned r; asm volatile("v_cvt_pk_bf16_f32 %0, %1, %2" : "=v"(r) : "v"(lo), "v"(hi)); return r; }
struct TileOrder {
    int nM, nN, nwg, G, c;
    __device__ void init(int nM_, int nN_, int G_, int c_) { nM = nM_; nN = nN_; nwg = nM * nN; G = G_; c = c_; }
    __device__ bool next(int i, Unit& u) const {
        int wgid;
        if ((G & 7) == 0) { const int per = G >> 3; wgid = (i * 8 + (c & 7)) * per + (c >> 3); } else wgid = i * G + c;
        if (wgid >= nwg) return false;
        const int nig = WGM * nN, gid = wgid / nig, fm = gid * WGM, gsz = (nM - fm) < WGM ? (nM - fm) : WGM;
        u.pm = fm + ((wgid % nig) % gsz); u.pn = (wgid % nig) / gsz; return true;
    }
    __device__ __forceinline__ void a_ready(const Unit&) const {}
    __device__ __forceinline__ void done(const Unit&) const {}
};
struct GroupOrder {
    int nE, nMt, strideM, nNt, nwg, G, c;
    __device__ void init(int nE_, int nMt_, int strideM_, int nNt_, int G_, int c_) { nE = nE_; nMt = nMt_; strideM = strideM_; nNt = nNt_; nwg = nE * nMt * nNt; G = G_; c = c_; }
    __device__ bool next(int i, Unit& u) const {
        int wgid;
        if ((G & 7) == 0) { const int per = G >> 3; wgid = (i * 8 + (c & 7)) * per + (c >> 3); } else wgid = i * G + c;
        if (wgid >= nwg) return false;
        const int per_e = nMt * nNt, e = wgid / per_e, r = wgid % per_e, jn = r / nMt, im = r % nMt;
        u.pm = e * strideM + im; u.pn = e * nNt + jn; return true;
    }
    __device__ __forceinline__ void a_ready(const Unit&) const {}
    __device__ __forceinline__ void done(const Unit&) const {}
};
struct EpiBf16Map {
    static constexpr bool PERM = true, AFTER_DRAIN = false;
    bf16_t* O; int ldc; int pn_mod; float scale;
    __device__ __forceinline__ void operator()(const f32x4 (&acc)[2][2][4][2], const Unit& u, int wr, int wc, int fr_, int fq_) const {
        int fr = fr_, fq = fq_; asm volatile("" : "+v"(fr), "+v"(fq));
        const int row0 = u.pm * BM + wr * 64 + fr, col0 = (u.pn % pn_mod) * BM + wc * 32 + 8 * fq;
#pragma unroll
        for (int ai = 0; ai < 2; ++ai)
#pragma unroll
            for (int m = 0; m < 4; ++m) { bf16_t* rowp = O + (size_t)(row0 + ai * HALF + m * 16) * ldc + col0;
#pragma unroll
                for (int bj = 0; bj < 2; ++bj) { const f32x4 v0 = acc[ai][bj][m][0] * scale, v1 = acc[ai][bj][m][1] * scale;
                    u32x4 w; w.x = cvt_pk_bf16(v0[0], v0[1]); w.y = cvt_pk_bf16(v0[2], v0[3]); w.z = cvt_pk_bf16(v1[0], v1[1]); w.w = cvt_pk_bf16(v1[2], v1[3]);
                    *(u32x4*)(rowp + bj * HALF) = w; } }
    }
};
struct EpiF32 {
    static constexpr bool PERM = false, AFTER_DRAIN = false;
    float* O; int ldc;
    __device__ __forceinline__ void operator()(const f32x4 (&acc)[2][2][4][2], const Unit& u, int wr, int wc, int fr_, int fq_) const {
        int fr = fr_, fq = fq_; asm volatile("" : "+v"(fr), "+v"(fq));
        const int row0 = u.pm * BM + wr * 64 + fr, col0 = u.pn * BM + wc * 32 + 4 * fq;
#pragma unroll
        for (int ai = 0; ai < 2; ++ai)
#pragma unroll
            for (int m = 0; m < 4; ++m) { float* rowp = O + (size_t)(row0 + ai * HALF + m * 16) * ldc + col0;
#pragma unroll
                for (int bj = 0; bj < 2; ++bj)
#pragma unroll
                    for (int n = 0; n < 2; ++n) *(f32x4*)(rowp + bj * HALF + n * 16) = acc[ai][bj][m][n]; }
    }
};
__device__ __forceinline__ float silu_f(float g) { return g * __builtin_amdgcn_rcpf(1.0f + __builtin_amdgcn_exp2f(-1.4426950408889634f * g)); }
struct EpiSwiGLU {
    static constexpr bool PERM = true, AFTER_DRAIN = false;
    bf16_t* O; int ldc; int pn_mod;
    __device__ __forceinline__ void operator()(const f32x4 (&acc)[2][2][4][2], const Unit& u, int wr, int wc, int fr_, int fq_) const {
        int fr = fr_, fq = fq_; asm volatile("" : "+v"(fr), "+v"(fq));
        const int row0 = u.pm * BM + wr * 64 + fr, col0 = (u.pn % pn_mod) * HALF + wc * 32 + 8 * fq;
#pragma unroll
        for (int ai = 0; ai < 2; ++ai)
#pragma unroll
            for (int m = 0; m < 4; ++m) { bf16_t* rowp = O + (size_t)(row0 + ai * HALF + m * 16) * ldc + col0;
                const f32x4 g0 = acc[ai][0][m][0], g1 = acc[ai][0][m][1], u0 = acc[ai][1][m][0], u1 = acc[ai][1][m][1];
                u32x4 w; w.x = cvt_pk_bf16(silu_f(g0[0]) * u0[0], silu_f(g0[1]) * u0[1]); w.y = cvt_pk_bf16(silu_f(g0[2]) * u0[2], silu_f(g0[3]) * u0[3]);
                w.z = cvt_pk_bf16(silu_f(g1[0]) * u1[0], silu_f(g1[1]) * u1[1]); w.w = cvt_pk_bf16(silu_f(g1[2]) * u1[2], silu_f(g1[3]) * u1[3]);
                *(u32x4*)rowp = w; }
    }
};

__device__ __forceinline__ unsigned pk4_fp8(float a, float b, float c, float d) {
    a = fminf(fmaxf(a, -448.f), 448.f); b = fminf(fmaxf(b, -448.f), 448.f); c = fminf(fmaxf(c, -448.f), 448.f); d = fminf(fmaxf(d, -448.f), 448.f);
    unsigned w = 0u; w = __builtin_amdgcn_cvt_pk_fp8_f32(a, b, w, false); w = __builtin_amdgcn_cvt_pk_fp8_f32(c, d, w, true); return w;
}
struct EpiSwiGLU8 {
    static constexpr bool PERM = true, AFTER_DRAIN = false;
    unsigned char* O; int ldc; int pn_mod; float inv, oscale;
    __device__ __forceinline__ void operator()(const f32x4 (&acc)[2][2][4][2], const Unit& u, int wr, int wc, int fr_, int fq_) const {
        int fr = fr_, fq = fq_; asm volatile("" : "+v"(fr), "+v"(fq));
        const int row0 = u.pm * BM + wr * 64 + fr, col0 = (u.pn % pn_mod) * HALF + wc * 32 + 8 * fq;
#pragma unroll
        for (int ai = 0; ai < 2; ++ai)
#pragma unroll
            for (int m = 0; m < 4; ++m) { unsigned char* rowp = O + (size_t)(row0 + ai * HALF + m * 16) * ldc + col0;
                const f32x4 g0 = acc[ai][0][m][0] * inv, g1 = acc[ai][0][m][1] * inv, u0 = acc[ai][1][m][0] * (inv * oscale), u1 = acc[ai][1][m][1] * (inv * oscale);
                u32x2 w; w.x = pk4_fp8(silu_f(g0[0]) * u0[0], silu_f(g0[1]) * u0[1], silu_f(g0[2]) * u0[2], silu_f(g0[3]) * u0[3]);
                w.y = pk4_fp8(silu_f(g1[0]) * u1[0], silu_f(g1[1]) * u1[1], silu_f(g1[2]) * u1[2], silu_f(g1[3]) * u1[3]);
                *(u32x2*)rowp = w; }
    }
};
template <class Epi, class Sched, bool ALIGN_EPI = false, bool SP2 = false, bool FP8 = false>
__device__ __forceinline__ void gemm_phase(PG8_LAS unsigned char* lds, const Gemm g, const Sched& S, const Epi& E) {
    int tid_ = threadIdx.x; asm volatile("" : "+v"(tid_));
    const int tid = tid_, wid = __builtin_amdgcn_readfirstlane(tid >> 6), lane = tid & 63, wr = wid >> 2, wc = wid & 3, fr = lane & 15, fq = lane >> 4;
    const int K = g.K, nt = K / BK;
    unsigned voffA[2], voffB[2];
#pragma unroll
    for (int i = 0; i < 2; ++i) { int R, C; stage_rc(tid * 16 + i * 8192, R, C); const int Rb = Epi::PERM ? ((R & ~31) + perm32(R & 31)) : R;
        voffA[i] = (unsigned)(R * K + C) * 2u; voffB[i] = (unsigned)(Rb * K + C) * 2u; }
    const size_t kstep = (size_t)(BK * 2);
    const size_t hstep = (size_t)HALF * K * 2;
    const size_t tstep = 2 * hstep;
    const unsigned ldsw = (unsigned)wid * 1024u;
    const int aoff = lds_byte(wr * 64 + fr, fq * 8), boff = lds_byte(wc * 32 + fr, fq * 8);
#define PG8_SA(b, h) (((b) * 2 + (h)) * HTB)
#define PG8_SB(b, h) ((4 + (b) * 2 + (h)) * HTB)
#define PG8_STAGE(bufoff, gbase, voff) do { _Pragma("unroll") for (int _i = 0; _i < 2; ++_i) \
        __builtin_amdgcn_global_load_lds((const unsigned*)((const char*)(gbase) + (voff)[_i]), (PG8_LAS unsigned*)(lds + (bufoff) + ldsw + _i * 8192), 16, 0, 0); } while (0)
#define PG8_LDA(dst, b, h) do { if constexpr (FP8) { _Pragma("unroll") for (int m = 0; m < 4; ++m) dst##8[m] = __builtin_shufflevector(*(const PG8_LAS i32x4*)(lds + PG8_SA(b, h) + aoff + m * 2048), *(const PG8_LAS i32x4*)(lds + PG8_SA(b, h) + aoff + m * 2048 + 1024), 0, 1, 2, 3, 4, 5, 6, 7); } \
    else { _Pragma("unroll") for (int m = 0; m < 4; ++m) _Pragma("unroll") for (int k = 0; k < 2; ++k) dst[m][k] = *(const PG8_LAS bf16x8*)(lds + PG8_SA(b, h) + aoff + m * 2048 + k * 1024); } } while (0)
#define PG8_LDB(dst, b, h) do { if constexpr (FP8) { _Pragma("unroll") for (int n = 0; n < 2; ++n) dst##8[n] = __builtin_shufflevector(*(const PG8_LAS i32x4*)(lds + PG8_SB(b, h) + boff + n * 2048), *(const PG8_LAS i32x4*)(lds + PG8_SB(b, h) + boff + n * 2048 + 1024), 0, 1, 2, 3, 4, 5, 6, 7); } \
    else { _Pragma("unroll") for (int n = 0; n < 2; ++n) _Pragma("unroll") for (int k = 0; k < 2; ++k) dst[n][k] = *(const PG8_LAS bf16x8*)(lds + PG8_SB(b, h) + boff + n * 2048 + k * 1024); } } while (0)
#define PG8_MMA(ai, bj, At, Bt) do { __builtin_amdgcn_s_setprio(1); \
    if constexpr (FP8) { _Pragma("unroll") for (int m = 0; m < 4; ++m) _Pragma("unroll") for (int n = 0; n < 2; ++n) \
        asm volatile("v_mfma_scale_f32_16x16x128_f8f6f4 %0, %1, %2, %0, %3, %3 op_sel_hi:[0,0,0]" : "+v"(acc[ai][bj][m][n]) : "v"(Bt##8[n]), "v"(At##8[m]), "v"(fp8_unit_scale)); } \
    else { _Pragma("unroll") for (int m = 0; m < 4; ++m) _Pragma("unroll") for (int n = 0; n < 2; ++n) _Pragma("unroll") for (int k = 0; k < 2; ++k) \
        acc[ai][bj][m][n] = __builtin_amdgcn_mfma_f32_16x16x32_bf16(Bt[n][k], At[m][k], acc[ai][bj][m][n], 0, 0, 0); } \
    __builtin_amdgcn_s_setprio(0); } while (0)
#define PG8_WAIT_V(n) asm volatile("s_waitcnt vmcnt(" #n ")" ::: "memory")
#define PG8_WAIT_L(n) asm volatile("s_waitcnt lgkmcnt(" #n ")" ::: "memory")
#define PG8_BAR __builtin_amdgcn_s_barrier()
#define PG8_SCHED __builtin_amdgcn_sched_barrier(0)
    Unit cur, nxt; int ui = 0;
    if (!S.next(0, cur)) return;
    f32x4 acc[2][2][4][2];
#pragma unroll
    for (int a = 0; a < 2; ++a)
#pragma unroll
        for (int b = 0; b < 2; ++b)
#pragma unroll
            for (int m = 0; m < 4; ++m)
#pragma unroll
                for (int n = 0; n < 2; ++n) acc[a][b][m][n] = (f32x4){0.f, 0.f, 0.f, 0.f};
    const int fp8_unit_scale = 0x7f7f7f7f;
    bf16x8 At[4][2], B0[2][2], B1[2][2]; i32x8 At8[4], B08[2], B18[2];
    const char* cA = (const char*)g.A + (size_t)cur.pm * tstep; const char* cB = (const char*)g.Bt + (size_t)cur.pn * tstep;
    S.a_ready(cur);
    if constexpr (SP2) {
        PG8_STAGE(PG8_SB(0, 0), cB, voffB); PG8_STAGE(PG8_SB(0, 1), cB + hstep, voffB); PG8_STAGE(PG8_SA(0, 0), cA, voffA); PG8_STAGE(PG8_SA(0, 1), cA + hstep, voffA);
        if (wr == 1) PG8_BAR;
        PG8_WAIT_V(2); PG8_BAR;
        PG8_STAGE(PG8_SB(1, 0), cB + kstep, voffB); PG8_STAGE(PG8_SA(1, 0), cA + kstep, voffA); PG8_STAGE(PG8_SB(1, 1), cB + hstep + kstep, voffB);
        PG8_WAIT_V(6); PG8_BAR;
    } else {
        PG8_STAGE(PG8_SB(0, 0), cB, voffB); PG8_STAGE(PG8_SA(0, 0), cA, voffA); PG8_STAGE(PG8_SB(0, 1), cB + hstep, voffB); PG8_STAGE(PG8_SA(0, 1), cA + hstep, voffA);
        if (wr == 1) PG8_BAR;
        PG8_WAIT_V(4); PG8_BAR;
        PG8_STAGE(PG8_SB(1, 0), cB + kstep, voffB); PG8_STAGE(PG8_SA(1, 0), cA + kstep, voffA); PG8_STAGE(PG8_SB(1, 1), cB + hstep + kstep, voffB);
        PG8_WAIT_V(6); PG8_BAR;
    }
    for (;;) {
        const bool has_next = S.next(ui + 1, nxt);
        const char* nA = has_next ? (const char*)g.A + (size_t)nxt.pm * tstep : cA; const char* nB = has_next ? (const char*)g.Bt + (size_t)nxt.pn * tstep : cB;
_Pragma("unroll 1")
        for (int t = 0; t < nt; t += 2) {
            const bool last = (t == nt - 2);
            const char* a1 = cA + (size_t)(t + 1) * kstep;
            const char* a2 = last ? nA : cA + (size_t)(t + 2) * kstep; const char* b2 = last ? nB : cB + (size_t)(t + 2) * kstep;
            const char* a3 = a2 + kstep; const char* b3 = b2 + kstep;
            if (last && has_next) S.a_ready(nxt);
            if constexpr (SP2) {
            PG8_LDB(B0, 0, 0); PG8_LDB(B1, 0, 1); PG8_SCHED; PG8_LDA(At, 0, 0); PG8_STAGE(PG8_SA(1, 1), a1 + hstep, voffA);
            PG8_WAIT_V(8); PG8_WAIT_L(0); PG8_BAR; PG8_MMA(0, 0, At, B0); PG8_MMA(0, 1, At, B1); PG8_BAR; PG8_SCHED;
            PG8_LDA(At, 0, 1); PG8_STAGE(PG8_SB(0, 0), b2, voffB); PG8_STAGE(PG8_SB(0, 1), b2 + hstep, voffB); PG8_STAGE(PG8_SA(0, 0), a2, voffA);
            PG8_WAIT_V(8); PG8_WAIT_L(0); PG8_BAR; PG8_MMA(1, 0, At, B0); PG8_MMA(1, 1, At, B1); PG8_BAR; PG8_SCHED;
            PG8_LDB(B0, 1, 0); PG8_LDB(B1, 1, 1); PG8_SCHED; PG8_LDA(At, 1, 0); PG8_STAGE(PG8_SA(0, 1), a2 + hstep, voffA);
            PG8_WAIT_V(8); PG8_WAIT_L(0); PG8_BAR; PG8_MMA(0, 0, At, B0); PG8_MMA(0, 1, At, B1); PG8_BAR; PG8_SCHED;
            PG8_LDA(At, 1, 1); PG8_STAGE(PG8_SB(1, 0), b3, voffB); PG8_STAGE(PG8_SB(1, 1), b3 + hstep, voffB); PG8_STAGE(PG8_SA(1, 0), a3, voffA);
            PG8_WAIT_V(8); PG8_WAIT_L(0); PG8_BAR; PG8_MMA(1, 0, At, B0); PG8_MMA(1, 1, At, B1); PG8_BAR; PG8_SCHED;
            } else {
            PG8_LDB(B0, 0, 0); PG8_SCHED; PG8_LDA(At, 0, 0); PG8_STAGE(PG8_SA(1, 1), a1 + hstep, voffA);
            PG8_WAIT_L(8); PG8_BAR; PG8_WAIT_L(0); PG8_MMA(0, 0, At, B0); PG8_BAR; PG8_SCHED;
            PG8_LDB(B1, 0, 1); PG8_STAGE(PG8_SB(0, 0), b2, voffB);
            PG8_BAR; PG8_WAIT_L(0); PG8_MMA(0, 1, At, B1); PG8_BAR;
            PG8_LDA(At, 0, 1); PG8_STAGE(PG8_SA(0, 0), a2, voffA);
            PG8_BAR; PG8_WAIT_L(0); PG8_MMA(1, 0, At, B0); PG8_BAR; PG8_SCHED;
            PG8_STAGE(PG8_SB(0, 1), b2 + hstep, voffB);
            PG8_WAIT_V(6); PG8_BAR; PG8_MMA(1, 1, At, B1); PG8_BAR;
            PG8_LDB(B0, 1, 0); PG8_SCHED; PG8_LDA(At, 1, 0); PG8_STAGE(PG8_SA(0, 1), a2 + hstep, voffA);
            PG8_WAIT_L(8); PG8_BAR; PG8_WAIT_L(0); PG8_MMA(0, 0, At, B0); PG8_BAR; PG8_SCHED;
            PG8_LDB(B1, 1, 1); PG8_STAGE(PG8_SB(1, 0), b3, voffB);
            PG8_BAR; PG8_WAIT_L(0); PG8_MMA(0, 1, At, B1); PG8_BAR;
            PG8_LDA(At, 1, 1); PG8_STAGE(PG8_SA(1, 0), a3, voffA);
            PG8_BAR; PG8_WAIT_L(0); PG8_MMA(1, 0, At, B0); PG8_BAR; PG8_SCHED;
            PG8_STAGE(PG8_SB(1, 1), b3 + hstep, voffB);
            PG8_WAIT_V(6); PG8_BAR; PG8_MMA(1, 1, At, B1); PG8_BAR;
            }
        }
        if constexpr (FP8) { asm volatile("s_nop 15\n\ts_nop 15" ::: "memory"); }
        if constexpr (ALIGN_EPI) { if (wr == 0) PG8_BAR; }
        if constexpr (!Epi::AFTER_DRAIN) { E(acc, cur, wr, wc, fr, fq); S.done(cur); }
        if (!has_next) break;
#pragma unroll
        for (int a = 0; a < 2; ++a)
#pragma unroll
            for (int b = 0; b < 2; ++b)
#pragma unroll
                for (int m = 0; m < 4; ++m)
#pragma unroll
                    for (int n = 0; n < 2; ++n) acc[a][b][m][n] = (f32x4){0.f, 0.f, 0.f, 0.f};
        cur = nxt; cA = nA; cB = nB; ++ui;
        if constexpr (ALIGN_EPI) { if (wr == 1) PG8_BAR; }
    }
    PG8_WAIT_V(0);
    if constexpr (!ALIGN_EPI) { if (wr == 0) PG8_BAR; }
    PG8_BAR;
    if constexpr (Epi::AFTER_DRAIN) { E.fused(acc, cur, wr, wc, fr, fq, lds, wid, lane); S.done(cur); }
#undef PG8_SA
#undef PG8_SB
#undef PG8_STAGE
#undef PG8_LDA
#undef PG8_LDB
#undef PG8_MMA
#undef PG8_WAIT_V
#undef PG8_WAIT_L
#undef PG8_BAR
#undef PG8_SCHED
}
}
constexpr int NB = 4, SEQ = 4096, D = 1024, CTXL = 256, DEPTH = 2, GRIDW = 64, NROWS = 64;
constexpr int MX = NB * SEQ, MC = NB * CTXL, MT = MX + MC;
constexpr int NIN = 2560, NE = 16, FH = 2816, CAPX = 512, CAPC = 32, NMOD = 6;
constexpr int EROWS = 2304;
constexpr int ETILES = EROWS / 256, FNT = FH / 128;
constexpr int PQ = 0, PK = 512, PV = 1024, PBG = 1536, PCG = 1792, PU = 2048, PF = 2304;
constexpr float RMS_EPS = 1e-6f;
constexpr float S_ACT = 16.f, S_WGU = 256.f, S_HID = 4.f, S_WDN = 256.f;
constexpr int NWAVES = 8;

constexpr size_t MiB = 1u << 20;
constexpr size_t WS_CTL = 0, CTL_ZERO_BYTES = 1 * MiB;
constexpr size_t WS_MODX = 64 * 1024;
constexpr size_t WS_WINT = 2 * MiB;
constexpr size_t WS_WOUTT = 12 * MiB;
constexpr size_t WS_WGUT = 16 * MiB;
constexpr size_t WS_WDT = 368 * MiB;
constexpr size_t WS_H = 544 * MiB;
constexpr size_t WS_P = 578 * MiB;
constexpr size_t WS_NA = 663 * MiB;
constexpr size_t WS_FO = 680 * MiB;
constexpr size_t WS_TT = 697 * MiB;
constexpr size_t WS_GC = 729 * MiB;
constexpr size_t WS_Y = 731 * MiB;
constexpr size_t WS_MO = 765 * MiB;
constexpr size_t WS_HID = 578 * MiB;
constexpr size_t WS_X1 = 833 * MiB;
constexpr size_t WS_X2 = 901 * MiB;
constexpr size_t WS_H2 = 969 * MiB;
constexpr size_t WS_AFF = 1003 * MiB;
constexpr size_t WS_SLOT = 1005 * MiB;
constexpr size_t WS_XS = 1007 * MiB;
constexpr size_t WS_YE = 1079 * MiB;
constexpr size_t WS_END = 1151 * MiB;
static_assert(WS_HID + (size_t)NE * EROWS * FH * 2 <= WS_X1, "HID overlay");
static_assert(WS_MODX + (size_t)DEPTH * 5 * NMOD * D * 4 <= CTL_ZERO_BYTES, "MODX inside memset region");
constexpr int CW_BAR = 4096;

constexpr int RING_OFF = 0, RING_BYTES = 131072;
constexpr int LDSCTL_OFF = RING_BYTES, MISC_OFF = LDSCTL_OFF + 320;
constexpr int TW64_OFF = LDSCTL_OFF + 512, TW256_OFF = LDSCTL_OFF + 1024, TW4K_OFF = LDSCTL_OFF + 3072;
constexpr int CT_OFF = LDSCTL_OFF + 4096, ST_OFF = LDSCTL_OFF + 12288;
constexpr int RPB_OFF = LDSCTL_OFF + 20480;
constexpr int LDS_BYTES = LDSCTL_OFF + 20480 + 7680;
#define GAS __attribute__((address_space(1)))
#define LAS __attribute__((address_space(3)))
typedef unsigned short bf16;
typedef unsigned v4u __attribute__((ext_vector_type(4)));
typedef float f32x4 __attribute__((ext_vector_type(4)));
typedef short bf16x8 __attribute__((ext_vector_type(8)));
typedef GAS unsigned gu32;
typedef GAS unsigned long long gu64;
#define RLX_AGENT __ATOMIC_RELAXED, __HIP_MEMORY_SCOPE_AGENT
#define LDS_WAIT() asm volatile("s_waitcnt lgkmcnt(0)" ::: "memory")
#define VM_WAIT() asm volatile("s_waitcnt vmcnt(0)" ::: "memory")
__device__ __forceinline__ unsigned long long rt() { return __builtin_amdgcn_s_memrealtime(); }
__device__ __forceinline__ unsigned f2bf(float f) { unsigned u = __builtin_bit_cast(unsigned, f); return (u + 0x7fffu + ((u >> 16) & 1u)) >> 16; }
__device__ __forceinline__ unsigned pk2(float lo, float hi) { return f2bf(lo) | (f2bf(hi) << 16); }

#define XB_TMO      128
#define XB_XCNT(j)  (256  + 64 * (j))
#define XB_XSUB(j)  (1280 + 64 * (j))
#define XB_XGEN(j)  (2304 + 64 * (j))
#define XB_TOP      3328
#define XB_TOPGEN   3392
#define XCD_BAR_WORDS 3456
#define XB_SPIN_CAP (1u << 18)

__device__ __forceinline__ unsigned xb_ld(unsigned* p)              { return __hip_atomic_load(p, __ATOMIC_RELAXED, __HIP_MEMORY_SCOPE_AGENT); }
__device__ __forceinline__ unsigned xb_add(unsigned* p, unsigned v) { return __hip_atomic_fetch_add(p, v, __ATOMIC_RELAXED, __HIP_MEMORY_SCOPE_AGENT); }
__device__ __forceinline__ unsigned xb_xcc_id() { return (unsigned)__builtin_amdgcn_s_getreg((3 << 11) | 20) & 0xFu; }
#define XB_SPIN(cond, bar) do { unsigned _sp = 0; while (cond) { __builtin_amdgcn_s_sleep(1); \
    if ((++_sp & 255u) == 0u) { if (xb_ld(&(bar)[XB_TMO])) break; if (_sp > XB_SPIN_CAP) { atomicAdd(&(bar)[XB_TMO], 1u); break; } } } } while (0)

struct XcdBarrier {
    unsigned* bar; unsigned x;
    volatile LAS unsigned* st;
};

__device__ __forceinline__ XcdBarrier xcd_barrier_post(unsigned* bar, volatile LAS unsigned* st) {
    XcdBarrier b; b.bar = bar; b.x = xb_xcc_id(); b.st = st;
    if (threadIdx.x == 0) (void)xb_add(&bar[XB_XCNT(b.x)], 1u);
    return b;
}
__device__ __forceinline__ void xcd_barrier_complete(unsigned* bar, unsigned x, unsigned& nloc, unsigned& nx) {
    const unsigned G = gridDim.x * gridDim.y * gridDim.z;
    unsigned sum, cnt, mine, sp = 0u;
    for (;;) {
        sum = 0u; cnt = 0u; mine = 0u;
#pragma unroll
        for (unsigned j = 0; j < 16; ++j) { const unsigned c = xb_ld(&bar[XB_XCNT(j)]); sum += c; cnt += (c > 0u) ? 1u : 0u; mine = (j == x) ? c : mine; }
        if (sum == G) break;
        __builtin_amdgcn_s_sleep(1);
        if ((++sp & 255u) == 0u) { if (xb_ld(&bar[XB_TMO])) break; if (sp > XB_SPIN_CAP) { atomicAdd(&bar[XB_TMO], 1u); break; } }
    }
    nloc = mine > 0u ? mine : 1u; nx = cnt > 0u ? cnt : 1u;
}

__device__ __forceinline__ void xcd_barrier(const XcdBarrier& b) {
    asm volatile("s_waitcnt vmcnt(0)" ::: "memory");
    __syncthreads();
    if (threadIdx.x == 0) {
        unsigned* bar = b.bar;
        __builtin_amdgcn_s_waitcnt(0);
        unsigned nloc = b.st[0], nx = b.st[1];
        if (nloc == 0u) { xcd_barrier_complete(bar, b.x, nloc, nx); b.st[0] = nloc; b.st[1] = nx; }
        const unsigned old = xb_add(&bar[XB_XSUB(b.x)], 1u);
        const unsigned gen = old / nloc;
        if (old + 1u == (gen + 1u) * nloc) {
            __builtin_amdgcn_fence(__ATOMIC_RELEASE, "agent");
            asm volatile("s_waitcnt vmcnt(0)" ::: "memory");
            const unsigned og = xb_add(&bar[XB_TOP], 1u);
            const unsigned tg = og / nx;
            if (og + 1u == (tg + 1u) * nx) xb_add(&bar[XB_TOPGEN], 1u);
            else XB_SPIN(xb_ld(&bar[XB_TOPGEN]) == tg, bar);
            __builtin_amdgcn_fence(__ATOMIC_ACQUIRE, "agent");
            xb_add(&bar[XB_XGEN(b.x)], 1u);
            asm volatile("s_waitcnt vmcnt(0)" ::: "memory");
        } else {
            XB_SPIN(xb_ld(&bar[XB_XGEN(b.x)]) == gen, bar);
            __builtin_amdgcn_fence(__ATOMIC_ACQUIRE, "agent");
            asm volatile("s_waitcnt vmcnt(0)" ::: "memory");
        }
    }
    __syncthreads();
}
typedef LAS float lfloat;
typedef float f32x2 __attribute__((ext_vector_type(2)));
typedef unsigned u32x2 __attribute__((ext_vector_type(2)));
__device__ __forceinline__ float bflo(unsigned w) { return __uint_as_float(w << 16); }
__device__ __forceinline__ float bfhi(unsigned w) { return __uint_as_float(w & 0xffff0000u); }
__device__ __forceinline__ float bf2f(bf16 h) { return __uint_as_float((unsigned)h << 16); }
template <int CTRL> __device__ __forceinline__ float dppf(float v) { return __builtin_bit_cast(float, __builtin_amdgcn_update_dpp(0, __builtin_bit_cast(int, v), CTRL, 0xf, 0xf, true)); }
__device__ __forceinline__ float wave_sum(float v) {
    v += dppf<0xB1>(v); v += dppf<0x4E>(v); v += dppf<0x141>(v); v += dppf<0x140>(v);
    const float r0 = __builtin_bit_cast(float, __builtin_amdgcn_readlane(__builtin_bit_cast(int, v), 0)), r1 = __builtin_bit_cast(float, __builtin_amdgcn_readlane(__builtin_bit_cast(int, v), 16));
    const float r2 = __builtin_bit_cast(float, __builtin_amdgcn_readlane(__builtin_bit_cast(int, v), 32)), r3 = __builtin_bit_cast(float, __builtin_amdgcn_readlane(__builtin_bit_cast(int, v), 48));
    return (r0 + r1) + (r2 + r3);
}
__device__ __forceinline__ float wave_max(float v) {
#pragma unroll
    for (int o = 1; o < 64; o <<= 1) v = fmaxf(v, __shfl_xor(v, o));
    return v;
}
__device__ __forceinline__ float silu(float x) { return x / (1.0f + __expf(-x)); }

struct Ctx {
    unsigned char* ws; LAS unsigned char* lds;
    int tid, lane, wave, G, gw, NGW;
};
#define IN_X 0
#define IN_C 1
#define IN_CTX 2
#define IN_CCTX 3
#define IN_WMOD 4
#define IN_BMOD 5
#define IN_GPREMIX 6
#define IN_GPOSTMIX 7
#define IN_GPREFFN 8
#define IN_GPOSTFFN 9
#define IN_WIN 10
#define IN_RPB 11
#define IN_CONVW 12
#define IN_GMIXOUT 13
#define IN_WOUT 14
#define IN_WROUTER 15
#define IN_WGATE 16
#define IN_WUP 17
#define IN_WDOWN 18

__device__ __forceinline__ int mod_row(int row) { return row < MX ? (row >> 12) : 4; }
__device__ __forceinline__ const float* modx(const Ctx& C, int layer, int mr, int which) { return (const float*)(C.ws + WS_MODX) + ((size_t)(layer * 5 + mr) * NMOD + which) * D; }

__device__ __forceinline__ void transpose_item(const float* W, int K, int N, bf16* WT, int item, int mode, lfloat* scr, int lane) {
    const int nblk = N / 32, kb = item / nblk, nb = item % nblk, k0 = 64 * kb, n0 = 32 * nb;
#pragma unroll 8
    for (int i = 0; i < 32; ++i) { const int kk = 2 * i + (lane >> 5); scr[kk * 33 + (lane & 31)] = W[(size_t)(k0 + kk) * N + n0 + (lane & 31)]; }
    LDS_WAIT(); asm volatile("" ::: "memory");
    const int rowbase = mode == 0 ? n0 : ((n0 >> 7) * 256 + (n0 & 127) + (mode == 2 ? 128 : 0));
    const int c = lane & 7;
#pragma unroll
    for (int j = 0; j < 4; ++j) { const int n = (lane >> 3) + 8 * j; const lfloat* s = scr + (8 * c) * 33 + n;
        v4u o; o.x = pk2(s[0 * 33], s[1 * 33]); o.y = pk2(s[2 * 33], s[3 * 33]); o.z = pk2(s[4 * 33], s[5 * 33]); o.w = pk2(s[6 * 33], s[7 * 33]);
        *(GAS v4u*)(WT + (size_t)(rowbase + n) * K + k0 + 8 * c) = o; }
    LDS_WAIT(); asm volatile("" ::: "memory");
}
__device__ __forceinline__ void transpose_item8(const float* W, int K, int N, unsigned char* WT, int item, int mode, float scale, lfloat* scr, int lane) {
    const int nblk = N / 32, kb = item / nblk, nb = item % nblk, k0 = 128 * kb, n0 = 32 * nb;
    const int rowbase = mode == 0 ? n0 : ((n0 >> 7) * 256 + (n0 & 127) + (mode == 2 ? 128 : 0));
    const int c = lane & 3;
    v4u o[2][2];
#pragma unroll
    for (int hf = 0; hf < 2; ++hf) {
#pragma unroll 8
        for (int i = 0; i < 32; ++i) { const int kk = 2 * i + (lane >> 5); scr[kk * 33 + (lane & 31)] = W[(size_t)(k0 + 64 * hf + kk) * N + n0 + (lane & 31)] * scale; }
        LDS_WAIT(); asm volatile("" ::: "memory");
#pragma unroll
        for (int j = 0; j < 2; ++j) { const int n = (lane >> 2) + 16 * j; const lfloat* s = scr + (16 * c) * 33 + n;
            o[hf][j].x = pg8::pk4_fp8(s[0 * 33], s[1 * 33], s[2 * 33], s[3 * 33]); o[hf][j].y = pg8::pk4_fp8(s[4 * 33], s[5 * 33], s[6 * 33], s[7 * 33]);
            o[hf][j].z = pg8::pk4_fp8(s[8 * 33], s[9 * 33], s[10 * 33], s[11 * 33]); o[hf][j].w = pg8::pk4_fp8(s[12 * 33], s[13 * 33], s[14 * 33], s[15 * 33]); }
        LDS_WAIT(); asm volatile("" ::: "memory");
    }
#pragma unroll
    for (int j = 0; j < 2; ++j) { const int n = (lane >> 2) + 16 * j; unsigned char* dst = WT + (size_t)(rowbase + n) * K + k0 + 16 * c;
        *(GAS v4u*)dst = o[0][j]; *(GAS v4u*)(dst + 64) = o[1][j]; }
}
struct ExpItem { const float* src; unsigned char* dst; int N, K, mode; float scale; };
constexpr int IT_EXP = (D / 128) * (FH / 32);
static_assert((FH / 128) * (D / 32) == IT_EXP, "item counts");
constexpr int N_EXP_ITEMS = 3 * DEPTH * NE * IT_EXP;
__device__ __forceinline__ ExpItem exp_item(const float* const (&in)[19], unsigned char* ws, int it) {
    const int mat = it / (DEPTH * NE * IT_EXP), r = it % (DEPTH * NE * IT_EXP), le = r / IT_EXP, item = r % IT_EXP;
    ExpItem e;
    if (mat < 2) { const int nblk = FH / 32, kb = item / nblk, nb = item % nblk, k0 = 128 * kb, n0 = 32 * nb;
        e.N = FH; e.K = D; e.scale = S_WGU; e.src = in[mat == 0 ? IN_WGATE : IN_WUP] + (size_t)le * D * FH + (size_t)k0 * FH + n0;
        const int rowbase = (n0 >> 7) * 256 + (n0 & 127) + (mat == 1 ? 128 : 0);
        e.dst = ws + WS_WGUT + (size_t)le * 2 * FH * D + (size_t)rowbase * D + k0; }
    else { const int nblk = D / 32, kb = item / nblk, nb = item % nblk, k0 = 128 * kb, n0 = 32 * nb;
        e.N = D; e.K = FH; e.scale = S_WDN; e.src = in[IN_WDOWN] + (size_t)le * FH * D + (size_t)k0 * D + n0;
        e.dst = ws + WS_WDT + (size_t)le * D * FH + (size_t)n0 * FH + k0; }
    e.mode = 0;
    return e;
}
__device__ __forceinline__ void exp_issue(f32x4 (&r)[8], const float* src, int N, int lane) {
    const int lofs = (lane >> 3) * N + (lane & 7) * 4;
#pragma unroll
    for (int i = 0; i < 8; ++i) { const float* rowp = src + (size_t)(8 * i) * N; r[i] = *(const f32x4*)(rowp + lofs); }
}
__device__ __forceinline__ void exp_half(const f32x4 (&r)[8], float scale, lfloat* scr, int lane, v4u (&o)[2]) {
#pragma unroll
    for (int i = 0; i < 8; ++i) { lfloat* d = scr + (8 * i + (lane >> 3)) * 33 + (lane & 7) * 4; const f32x4 v = r[i] * scale; d[0] = v.x; d[1] = v.y; d[2] = v.z; d[3] = v.w; }
    LDS_WAIT(); asm volatile("" ::: "memory");
    const int c = lane & 3;
#pragma unroll
    for (int j = 0; j < 2; ++j) { const int n = (lane >> 2) + 16 * j; const lfloat* s = scr + (16 * c) * 33 + n;
        o[j].x = pg8::pk4_fp8(s[0 * 33], s[1 * 33], s[2 * 33], s[3 * 33]); o[j].y = pg8::pk4_fp8(s[4 * 33], s[5 * 33], s[6 * 33], s[7 * 33]);
        o[j].z = pg8::pk4_fp8(s[8 * 33], s[9 * 33], s[10 * 33], s[11 * 33]); o[j].w = pg8::pk4_fp8(s[12 * 33], s[13 * 33], s[14 * 33], s[15 * 33]); }
    LDS_WAIT(); asm volatile("" ::: "memory");
}
__device__ __forceinline__ void p0_expert_stream(const Ctx& C, const float* const (&in)[19], int it0, int it_end, int stride) {
    lfloat* scr = (lfloat*)(C.lds + RING_OFF + C.wave * 16384);
    const int lane = C.lane;
    int it = it0; f32x4 ra[8], rb[8];
    if (it >= it_end) return;
    ExpItem e = exp_item(in, C.ws, it);
    exp_issue(ra, e.src, e.N, lane);
    while (it < it_end) {
        exp_issue(rb, e.src + (size_t)64 * e.N, e.N, lane);
        v4u o0[2], o1[2];
        exp_half(ra, e.scale, scr, lane, o0);
        const int nit = it + stride;
        const ExpItem ne = exp_item(in, C.ws, nit < it_end ? nit : it);
        exp_issue(ra, ne.src, ne.N, lane);
        exp_half(rb, e.scale, scr, lane, o1);
#pragma unroll
        for (int j = 0; j < 2; ++j) { const int n = (lane >> 2) + 16 * j; unsigned char* dst = e.dst + (size_t)n * e.K + 16 * (lane & 3);
            *(GAS v4u*)dst = o0[j]; *(GAS v4u*)(dst + 64) = o1[j]; }
        e = ne; it = nit;
    }
}
constexpr int IT_WIN = (D / 64) * (NIN / 32), IT_WOUT = (D / 64) * (D / 32), IT_GU = (D / 128) * (FH / 32), IT_DN = (FH / 128) * (D / 32);
constexpr int N_T_ITEMS = DEPTH * IT_WIN + DEPTH * IT_WOUT;
__device__ __forceinline__ void p0_prologue(const Ctx& C, const float* const (&in)[19]) {
    {
        lfloat* part = (lfloat*)(C.lds + RING_OFF);
        for (int it = blockIdx.x; it < DEPTH * (NMOD * D / 64); it += C.G) {
            const int l = it / (NMOD * D / 64), cb = it % (NMOD * D / 64), col = cb * 64 + C.lane;
            const float* wm = in[IN_WMOD] + (size_t)l * D * NMOD * D + col;
            float acc[5] = {0.f, 0.f, 0.f, 0.f, 0.f};
#pragma unroll 8
            for (int k = C.wave * 128; k < C.wave * 128 + 128; ++k) {
                const float wv = wm[(size_t)k * (NMOD * D)];
#pragma unroll
                for (int r = 0; r < 4; ++r) acc[r] += silu(in[IN_C][r * D + k]) * wv;
                acc[4] += silu(in[IN_CCTX][k]) * wv;
            }
#pragma unroll
            for (int r = 0; r < 5; ++r) part[(C.wave * 5 + r) * 64 + C.lane] = acc[r];
            __syncthreads();
            if (C.wave < 5) { const int r = C.wave; float sum = in[IN_BMOD][l * NMOD * D + col];
#pragma unroll
                for (int w = 0; w < 8; ++w) sum += part[(w * 5 + r) * 64 + C.lane];
                ((float*)(C.ws + WS_MODX))[(size_t)(l * 5 + r) * NMOD * D + col] = sum; }
            __syncthreads();
        }
    }
    lfloat* scr = (lfloat*)(C.lds + RING_OFF + C.wave * 16384);
    bf16* WINT = (bf16*)(C.ws + WS_WINT); bf16* WOUTT = (bf16*)(C.ws + WS_WOUTT);
    for (int it = C.gw; it < N_T_ITEMS; it += C.NGW) {
        int r = it;
        if (r < DEPTH * IT_WIN) { const int l = r / IT_WIN; transpose_item(in[IN_WIN] + (size_t)l * D * NIN, D, NIN, WINT + (size_t)l * NIN * D, r % IT_WIN, 0, scr, C.lane); continue; } r -= DEPTH * IT_WIN;
        { const int l = r / IT_WOUT; transpose_item(in[IN_WOUT] + (size_t)l * D * D, D, D, WOUTT + (size_t)l * D * D, r % IT_WOUT, 0, scr, C.lane); }
    }
    p0_expert_stream(C, in, C.gw, N_EXP_ITEMS, C.NGW);
}

__device__ __forceinline__ void norm_mod_store(const f32x4 (&v)[4], float ss, const float* g, const float* sh, const float* sc, bf16* orow, int lane) {
    const float rstd = 1.0f / sqrtf(ss * (1.f / D) + RMS_EPS);
#pragma unroll
    for (int j = 0; j < 4; ++j) {
        const f32x4 gg = ((const f32x4*)g)[lane + 64 * j], hh = ((const f32x4*)sh)[lane + 64 * j], cc = ((const f32x4*)sc)[lane + 64 * j];
        const f32x4 o = (v[j] * rstd * gg) * (cc + 1.0f) + hh;
        u32x2 w; w.x = pk2(o.x, o.y); w.y = pk2(o.z, o.w);
        ((u32x2*)orow)[lane + 64 * j] = w;
    }
}
__device__ __forceinline__ void stage_vec4(LAS float* dst, const float* src, int n4, int tid) { for (int i = tid; i < n4; i += NWAVES * 64) ((LAS f32x4*)dst)[i] = ((const f32x4*)src)[i]; }
__device__ __forceinline__ float sumsq4(const f32x4 (&v)[4]) { float ss = 0.f;
#pragma unroll
    for (int j = 0; j < 4; ++j) ss += (v[j].x * v[j].x + v[j].y * v[j].y) + (v[j].z * v[j].z + v[j].w * v[j].w);
    return ss; }
__device__ __forceinline__ void norm_mod_store_lds(const f32x4 (&v)[4], float ss, const LAS float* g, const LAS float* sh, const LAS float* sc, bf16* orow, int lane) {
    const float rstd = 1.0f / sqrtf(ss * (1.f / D) + RMS_EPS);
#pragma unroll
    for (int j = 0; j < 4; ++j) {
        const f32x4 gg = ((const LAS f32x4*)g)[lane + 64 * j], hh = ((const LAS f32x4*)sh)[lane + 64 * j], cc = ((const LAS f32x4*)sc)[lane + 64 * j];
        const f32x4 o = (v[j] * rstd * gg) * (cc + 1.0f) + hh;
        u32x2 w; w.x = pk2(o.x, o.y); w.y = pk2(o.z, o.w);
        ((u32x2*)orow)[lane + 64 * j] = w;
    }
}
__device__ __forceinline__ void p1_h0(const Ctx& C, const float* const (&in)[19]) {
    bf16* H = (bf16*)(C.ws + WS_H);
    LAS float* LG = (LAS float*)(C.lds + RING_OFF); LAS float* LM = LG + D;
    stage_vec4(LG, in[IN_GPREMIX], D / 4, C.tid);
    for (int r = 0; r < 5; ++r) stage_vec4(LM + r * 2 * D, modx(C, 0, r, 0), 2 * D / 4, C.tid);
    __syncthreads();
    const int lane = C.lane;
    int row = C.gw; f32x4 v[4], nv[4];
    if (row < MT) { const float* xr = row < MX ? in[IN_X] + (size_t)row * D : in[IN_CTX] + (size_t)(row - MX) * D;
#pragma unroll
        for (int j = 0; j < 4; ++j) v[j] = ((const f32x4*)xr)[lane + 64 * j]; }
    while (row < MT) {
        const int nrow = row + C.NGW;
        { const int prow = nrow < MT ? nrow : MT - 1;
          const float* xr = prow < MX ? in[IN_X] + (size_t)prow * D : in[IN_CTX] + (size_t)(prow - MX) * D;
#pragma unroll
          for (int j = 0; j < 4; ++j) nv[j] = ((const f32x4*)xr)[lane + 64 * j]; }
        const float ss = wave_sum(sumsq4(v)); const int mr = mod_row(row);
        norm_mod_store_lds(v, ss, LG, LM + mr * 2 * D, LM + mr * 2 * D + D, H + (size_t)row * D, lane);
#pragma unroll
        for (int j = 0; j < 4; ++j) v[j] = nv[j];
        row = nrow;
    }
}
__device__ __forceinline__ float dot64(const float (&q)[64], const bf16* krow) {
    const v4u* p = (const v4u*)krow; float a = 0.f;
#pragma unroll
    for (int t = 0; t < 8; ++t) { const v4u w = p[t];
        a += q[8 * t + 0] * bflo(w.x) + q[8 * t + 1] * bfhi(w.x) + q[8 * t + 2] * bflo(w.y) + q[8 * t + 3] * bfhi(w.y)
           + q[8 * t + 4] * bflo(w.z) + q[8 * t + 5] * bfhi(w.z) + q[8 * t + 6] * bflo(w.w) + q[8 * t + 7] * bfhi(w.w); }
    return a;
}
__device__ __forceinline__ void axpy64(float (&o)[64], float p, const bf16* vrow) {
    const v4u* pp = (const v4u*)vrow;
#pragma unroll
    for (int t = 0; t < 8; ++t) { const v4u w = pp[t];
        o[8 * t + 0] += p * bflo(w.x); o[8 * t + 1] += p * bfhi(w.x); o[8 * t + 2] += p * bflo(w.y); o[8 * t + 3] += p * bfhi(w.y);
        o[8 * t + 4] += p * bflo(w.z); o[8 * t + 5] += p * bfhi(w.z); o[8 * t + 6] += p * bflo(w.w); o[8 * t + 7] += p * bfhi(w.w); }
}
__device__ __forceinline__ void attn_key(const float (&q)[64], float (&o)[64], float& m, float& l, float bias, const bf16* P, int key, int head) {
    const float s = dot64(q, P + (size_t)key * NIN + PK + head * 64) + bias;
    if (s > m) { const float alpha = __expf(m - s); l *= alpha;
#pragma unroll
        for (int d = 0; d < 64; ++d) o[d] *= alpha;
        m = s; }
    const float p = __expf(s - m); l += p;
    axpy64(o, p, P + (size_t)key * NIN + PV + head * 64);
}
__device__ __forceinline__ void p_attn_naive(const Ctx& C, const float* const (&in)[19], int layer) {
    const bf16* P = (const bf16*)(C.ws + WS_P); bf16* NA = (bf16*)(C.ws + WS_NA);
    const float* rpb = in[IN_RPB] + (size_t)layer * 8 * 15 * 31;
    const int nitems = layer == 0 ? 2048 + 128 : 2048;
    for (int id = C.gw; id < nitems; id += C.NGW) {
        const bool isctx = id >= 2048;
        int b, h, r = 0, c = 0, qrow;
        if (!isctx) { b = id >> 9; r = (id >> 3) & 63; h = id & 7; c = C.lane; qrow = b * SEQ + r * 64 + c; }
        else { const int j = id - 2048; b = j >> 5; h = (j >> 2) & 7; qrow = MX + b * CTXL + (j & 3) * 64 + C.lane; }
        float q[64], o[64];
        { const v4u* p = (const v4u*)(P + (size_t)qrow * NIN + PQ + h * 64);
#pragma unroll
          for (int t = 0; t < 8; ++t) { const v4u w = p[t];
              q[8 * t + 0] = 0.125f * bflo(w.x); q[8 * t + 1] = 0.125f * bfhi(w.x); q[8 * t + 2] = 0.125f * bflo(w.y); q[8 * t + 3] = 0.125f * bfhi(w.y);
              q[8 * t + 4] = 0.125f * bflo(w.z); q[8 * t + 5] = 0.125f * bfhi(w.z); q[8 * t + 6] = 0.125f * bflo(w.w); q[8 * t + 7] = 0.125f * bfhi(w.w); } }
#pragma unroll
        for (int d = 0; d < 64; ++d) o[d] = 0.f;
        float m = -1e30f, l = 0.f;
        if (!isctx) {
            const int rs = min(max(r - 4, 0), NROWS - 8), cs = min(max(c - 8, 0), GRIDW - 16);
            for (int kr = 0; kr < 8; ++kr) {
                const float* bp = rpb + (size_t)h * 465 + (rs + kr - r + 7) * 31 + 15;
#pragma unroll 1
                for (int i = 0; i < 16; ++i) { const int dc = min(max(cs + i - c, -15), 15); attn_key(q, o, m, l, bp[dc], P, b * SEQ + (rs + kr) * 64 + cs + i, h); }
            }
        }
#pragma unroll 1
        for (int j = 0; j < CTXL; ++j) attn_key(q, o, m, l, 0.f, P, MX + b * CTXL + j, h);
        const float inv = 1.0f / l;
        v4u* op = (v4u*)(NA + (size_t)qrow * 512 + h * 64);
#pragma unroll
        for (int t = 0; t < 8; ++t) { v4u w; w.x = pk2(o[8 * t] * inv, o[8 * t + 1] * inv); w.y = pk2(o[8 * t + 2] * inv, o[8 * t + 3] * inv);
            w.z = pk2(o[8 * t + 4] * inv, o[8 * t + 5] * inv); w.w = pk2(o[8 * t + 6] * inv, o[8 * t + 7] * inv); op[t] = w; }
    }
}

typedef short v4i16_t __attribute__((ext_vector_type(4)));
__device__ __forceinline__ bf16x8 pack8(const f32x4& a, const f32x4& b) {
    v4u w; w.x = pk2(a[0], a[1]); w.y = pk2(a[2], a[3]); w.z = pk2(b[0], b[1]); w.w = pk2(b[2], b[3]); return __builtin_bit_cast(bf16x8, w);
}
__device__ __forceinline__ bf16x8 neg8(const bf16x8& a) { v4u w = __builtin_bit_cast(v4u, a); w.x ^= 0x80008000u; w.y ^= 0x80008000u; w.z ^= 0x80008000u; w.w ^= 0x80008000u; return __builtin_bit_cast(bf16x8, w); }
#define MFMA16(a, b, c) __builtin_amdgcn_mfma_f32_16x16x32_bf16((a), (b), (c), 0, 0, 0)
constexpr float LOG2E = 1.4426950408889634f;
struct AttnStage { v4u k[5], v[5]; };
__device__ __forceinline__ void attn_issue(AttnStage& R, const bf16* src, unsigned lofs) {
#pragma unroll
    for (int i = 0; i < 5; ++i) { const char* bi = (const char*)src + (size_t)i * (8 * NIN * 2);
        R.k[i] = *(const v4u*)(bi + lofs); R.v[i] = *(const v4u*)(bi + (PV - PK) * 2 + lofs); }
}
__device__ __forceinline__ void attn_commit(const AttnStage& R, LAS unsigned char* kdst) {
#pragma unroll
    for (int i = 0; i < 5; ++i) { *(LAS v4u*)(kdst + i * 1024) = R.k[i]; *(LAS v4u*)(kdst + 8192 + i * 1024) = R.v[i]; }
}
struct AttnAddr { const LAS unsigned char* k[2]; const LAS unsigned char* v[4]; };
__device__ __forceinline__ AttnAddr attn_addr(const LAS unsigned char* KL, const LAS unsigned char* VL, int lr, int lq) {
    AttnAddr A;
#pragma unroll
    for (int ks = 0; ks < 2; ++ks) A.k[ks] = KL + lr * 128 + (((4 * ks + lq) ^ (lr & 7)) << 4);
    const int qq = lr >> 2, p = lr & 3, row = 4 * lq + qq;
#pragma unroll
    for (int dt = 0; dt < 4; ++dt) A.v[dt] = VL + row * 128 + (((2 * dt + (p >> 1)) ^ (row & 7)) << 4) + 8 * (p & 1);
    return A;
}
__device__ __forceinline__ bf16x8 attn_v_op(const LAS unsigned char* va, int kb0, int kb1) {
    const v4i16_t lo = __builtin_amdgcn_ds_read_tr16_b64_v4i16((LAS v4i16_t*)(va + kb0 * 128));
    const v4i16_t hi = __builtin_amdgcn_ds_read_tr16_b64_v4i16((LAS v4i16_t*)(va + kb1 * 128));
    return (bf16x8){lo[0], lo[1], lo[2], lo[3], hi[0], hi[1], hi[2], hi[3]};
}
__device__ __forceinline__ float xmax4(float v) { v = fmaxf(v, __shfl_xor(v, 16)); v = fmaxf(v, __shfl_xor(v, 32)); return v; }
template <int NT, bool WIN, int KB>
__device__ __forceinline__ void attn_block(const AttnAddr& A, const bf16x8 (&QB)[2], f32x4 (&O)[4], float& m, float& l, bool first, int lo, const LAS bf16* bias, int lq) {
    const f32x4 z4 = (f32x4){0.f, 0.f, 0.f, 0.f};
    constexpr float SC = 0.125f * LOG2E;
    float s[NT][4];
#pragma unroll
    for (int t = 0; t < NT; ++t) {
        f32x4 a = MFMA16(*(const LAS bf16x8*)(A.k[0] + (KB + 16 * t) * 128), QB[0], z4);
        a = MFMA16(*(const LAS bf16x8*)(A.k[1] + (KB + 16 * t) * 128), QB[1], a);
#pragma unroll
        for (int r = 0; r < 4; ++r) { const int kk = 16 * t + 4 * lq + r; float v = a[r] * SC;
            if (WIN) { v += bf2f(bias[kk]); v = ((unsigned)(kk - lo) < 16u) ? v : -1e30f; }
            s[t][r] = v; }
        asm volatile("" ::: "memory");
    }
    if (first) { float mc = -1e30f;
#pragma unroll
        for (int t = 0; t < NT; ++t)
#pragma unroll
            for (int r = 0; r < 4; ++r) mc = fmaxf(mc, s[t][r]);
        m = xmax4(mc); }
    float ps = 0.f;
#pragma unroll
    for (int t = 0; t < NT; ++t)
#pragma unroll
        for (int r = 0; r < 4; ++r) { s[t][r] = __builtin_amdgcn_exp2f(fminf(s[t][r] - m, 100.f)); ps += s[t][r]; }
    l += ps;
#pragma unroll
    for (int kp = 0; kp < NT / 2; ++kp) {
        const bf16x8 bp = pack8((f32x4){s[2 * kp][0], s[2 * kp][1], s[2 * kp][2], s[2 * kp][3]}, (f32x4){s[2 * kp + 1][0], s[2 * kp + 1][1], s[2 * kp + 1][2], s[2 * kp + 1][3]});
#pragma unroll
        for (int dt = 0; dt < 4; ++dt) { O[dt] = MFMA16(attn_v_op(A.v[dt], KB + 32 * kp, KB + 32 * kp + 16), bp, O[dt]); if (dt & 1) asm volatile("" ::: "memory"); }
    }
}
__device__ __forceinline__ void p_attn(const Ctx& C, const float* const (&in)[19], int layer) {
    const bf16* P = (const bf16*)(C.ws + WS_P); bf16* NA = (bf16*)(C.ws + WS_NA);
    LAS unsigned char* KL = C.lds + RING_OFF + C.wave * 16384; LAS unsigned char* VL = KL + 8192;
    LAS bf16* RPB = (LAS bf16*)(C.lds + RPB_OFF) + 32;
    { const float* rpb = in[IN_RPB] + (size_t)layer * 8 * 465;
      for (int u = C.tid; u < 8 * 465; u += NWAVES * 64) RPB[u] = (bf16)f2bf(rpb[u] * LOG2E);
      __syncthreads(); }
    const int lane = C.lane, lr = lane & 15, lq = lane >> 4;
    const AttnAddr AD = attn_addr(KL, VL, lr, lq);
    const unsigned lofs = (unsigned)(((lane >> 3) * NIN + (lane & 7) * 8) * 2);
    LAS unsigned char* kdst = KL + (lane >> 3) * 128 + (((lane & 7) ^ ((lane >> 3) & 7)) << 4); LAS unsigned char* vdst = kdst + 8192;
    const int nitems = layer == 0 ? 4096 + 256 : 4096;
    for (int id = C.gw; id < nitems; id += C.NGW) {
        const bool isctx = id >= 4096;
        int b, h, r = 0, half = 0, qtok0;
        if (!isctx) { b = id >> 10; r = (id >> 4) & 63; h = (id >> 1) & 7; half = id & 1; qtok0 = b * SEQ + r * 64 + 32 * half; }
        else { const int j = id - 4096; b = j >> 6; h = (j >> 3) & 7; qtok0 = MX + b * CTXL + (j & 7) * 32; }
        bf16x8 QB[2][2];
#pragma unroll
        for (int qb = 0; qb < 2; ++qb) { const bf16* qp = P + (size_t)(qtok0 + 16 * qb + lr) * NIN + PQ + h * 64 + 8 * lq; QB[qb][0] = *(const bf16x8*)qp; QB[qb][1] = *(const bf16x8*)(qp + 32); }
        f32x4 O[2][4]; float m[2], l[2];
#pragma unroll
        for (int qb = 0; qb < 2; ++qb) { m[qb] = -1e30f; l[qb] = 0.f;
#pragma unroll
            for (int dt = 0; dt < 4; ++dt) O[qb][dt] = (f32x4){0.f, 0.f, 0.f, 0.f}; }
        const int rs = min(max(r - 4, 0), NROWS - 8), kc0 = 24 * half;
        const bf16* wsrc = P + (size_t)(b * SEQ + rs * 64 + kc0) * NIN + h * 64 + PK;
        const bf16* csrc = P + (size_t)(MX + b * CTXL) * NIN + h * 64 + PK;
        const int c0 = isctx ? 8 : 0; int c = c0;
        AttnStage R;
        attn_issue(R, c < 8 ? wsrc + (size_t)c * 64 * NIN : csrc + (size_t)(c - 8) * 32 * NIN, lofs);
#pragma unroll 1
        for (; c < 16; ++c) {
            attn_commit(R, kdst);
            { const int cn = c + 1 < 16 ? c + 1 : 15;
              attn_issue(R, cn < 8 ? wsrc + (size_t)cn * 64 * NIN : csrc + (size_t)(cn - 8) * 32 * NIN, lofs); }
            LDS_WAIT(); asm volatile("" ::: "memory");
            if (c < 8) {
                const LAS bf16* brow = RPB + h * 465 + (rs + c - r + 7) * 31;
#define ATTN_WIN(qb, ks0) { const int col = 32 * half + 16 * (qb) + lr, cs = min(max(col - 8, 0), GRIDW - 16); attn_block<2, true, ks0>(AD, QB[qb], O[qb], m[qb], l[qb], c == c0, cs - (kc0 + (ks0)), brow + ((kc0 + (ks0)) - col + 15), lq); __builtin_amdgcn_sched_barrier(0); }
                ATTN_WIN(0, 0) ATTN_WIN(1, 8)
#undef ATTN_WIN
            } else {
#pragma unroll
                for (int qb = 0; qb < 2; ++qb) { attn_block<2, false, 0>(AD, QB[qb], O[qb], m[qb], l[qb], c == c0, 0, RPB, lq); __builtin_amdgcn_sched_barrier(0); }
            }
            asm volatile("" ::: "memory");
        }
#pragma unroll
        for (int qb = 0; qb < 2; ++qb) {
            float lt = l[qb]; lt += __shfl_xor(lt, 16); lt += __shfl_xor(lt, 32);
            const float inv = 1.0f / lt;
            bf16* op = NA + (size_t)(qtok0 + 16 * qb + lr) * 512 + h * 64 + 4 * lq;
#pragma unroll
            for (int dt = 0; dt < 4; ++dt) { u32x2 w; w.x = pk2(O[qb][dt][0] * inv, O[qb][dt][1] * inv); w.y = pk2(O[qb][dt][2] * inv, O[qb][dt][3] * inv); *(u32x2*)(op + 16 * dt) = w; }
        }
    }
}

__device__ __forceinline__ void p_fft_a(const Ctx& C) {
    const bf16* P = (const bf16*)(C.ws + WS_P); bf16* TT = (bf16*)(C.ws + WS_TT);
    const LAS unsigned char* CT = C.lds + CT_OFF; const LAS unsigned char* ST = C.lds + ST_OFF;
    const LAS f32x2* tw64 = (const LAS f32x2*)(C.lds + TW64_OFF); const LAS f32x2* tw4k = (const LAS f32x2*)(C.lds + TW4K_OFF);
    const int lane = C.lane, lr = lane & 15, lq = lane >> 4;
    const f32x4 z4 = (f32x4){0.f, 0.f, 0.f, 0.f};
    for (int id = C.wave * C.G + (int)blockIdx.x; id < NB * 4 * 64; id += C.NGW)     {
        const int b = id >> 8, g = (id >> 6) & 3, n2 = id & 63;
        bf16x8 FA[4][2];
#pragma unroll
        for (int mt = 0; mt < 4; ++mt) { const int n1 = 32 * (mt >> 1) + 8 * (lr >> 2) + 4 * (mt & 1) + (lr & 3);
            const bf16* fr = P + (size_t)(b * SEQ + 64 * n1 + n2) * NIN + PF + g * 64 + 8 * lq;
            FA[mt][0] = *(const bf16x8*)fr; FA[mt][1] = *(const bf16x8*)(fr + 32); }
        float tcs[4][4], tsn[4][4];
#pragma unroll
        for (int kt = 0; kt < 4; ++kt)
#pragma unroll
            for (int r = 0; r < 4; ++r) { const int kn = (16 * kt + 4 * lq + r) * n2; const f32x2 wa = tw64[(kn >> 6) & 63], wb = tw4k[kn & 63];
                tcs[kt][r] = wa.x * wb.x - wa.y * wb.y; tsn[kt][r] = wa.y * wb.x + wa.x * wb.y; }
#pragma unroll 1
        for (int jt = 0; jt < 4; ++jt) {
            bf16x8 cb[2], sb[2];
#pragma unroll
            for (int ks = 0; ks < 2; ++ks) { cb[ks] = *(const LAS bf16x8*)(CT + (16 * jt + lr) * 128 + (32 * ks + 8 * lq) * 2); sb[ks] = *(const LAS bf16x8*)(ST + (16 * jt + lr) * 128 + (32 * ks + 8 * lq) * 2); }
            f32x4 gr[4], gi[4];
#pragma unroll
            for (int mt = 0; mt < 4; ++mt) { gr[mt] = MFMA16(FA[mt][0], cb[0], z4); gr[mt] = MFMA16(FA[mt][1], cb[1], gr[mt]); gi[mt] = MFMA16(FA[mt][0], sb[0], z4); gi[mt] = MFMA16(FA[mt][1], sb[1], gi[mt]); }
            bf16x8 BGr[2], BGi[2], BnGi[2];
#pragma unroll
            for (int p = 0; p < 2; ++p) { BGr[p] = pack8(gr[2 * p], gr[2 * p + 1]); BGi[p] = pack8(gi[2 * p], gi[2 * p + 1]); BnGi[p] = neg8(BGi[p]); }
#pragma unroll
            for (int kt = 0; kt < 4; ++kt) {
                f32x4 tr = z4, nti = z4;
#pragma unroll
                for (int p = 0; p < 2; ++p) { const bf16x8 ca = *(const LAS bf16x8*)(CT + (16 * kt + lr) * 128 + (32 * p + 8 * lq) * 2), sa = *(const LAS bf16x8*)(ST + (16 * kt + lr) * 128 + (32 * p + 8 * lq) * 2);
                    tr = MFMA16(ca, BGr[p], tr); tr = MFMA16(sa, BnGi[p], tr); nti = MFMA16(ca, BGi[p], nti); nti = MFMA16(sa, BGr[p], nti); }
#pragma unroll
                for (int r = 0; r < 4; ++r) { const int k1 = 16 * kt + 4 * lq + r; const float cs = tcs[kt][r], sn = tsn[kt][r];
                    const float tpr = cs * tr[r] - sn * nti[r], tpi = -cs * nti[r] - sn * tr[r];
                    bf16* dst = TT + ((size_t)(((b * 4 + g) * 64 + k1) * 2) * 64 + n2) * 64 + 16 * jt + lr;
                    dst[0] = (bf16)f2bf(tpr); dst[64 * 64] = (bf16)f2bf(tpi); }
            }
        }
    }
}
__device__ __forceinline__ void p_fft_b(const Ctx& C) {
    const bf16* TT = (const bf16*)(C.ws + WS_TT); float* FO = (float*)(C.ws + WS_FO);
    const LAS unsigned char* CT = C.lds + CT_OFF; const LAS unsigned char* ST = C.lds + ST_OFF;
    LAS unsigned char* scr = C.lds + RING_OFF + C.wave * 16384;
    const int lane = C.lane, lr = lane & 15, lq = lane >> 4;
    const f32x4 z4 = (f32x4){0.f, 0.f, 0.f, 0.f};
    for (int id = C.wave * C.G + (int)blockIdx.x; id < NB * 4 * 64; id += C.NGW)     {
        const int b = id >> 8, g = (id >> 6) & 3, k1 = id & 63;
        const v4u* src = (const v4u*)(TT + (size_t)(((b * 4 + g) * 64 + k1) * 2) * 64 * 64);
#pragma unroll
        for (int i = 0; i < 16; ++i) { const v4u w = src[i * 64 + lane]; *(LAS v4u*)(scr + (i * 64 + lane) * 16) = w; }
        LDS_WAIT(); asm volatile("" ::: "memory");
        f32x4 acc[4][4];
#pragma unroll
        for (int kt = 0; kt < 4; ++kt)
#pragma unroll
            for (int jt = 0; jt < 4; ++jt) acc[kt][jt] = z4;
#pragma unroll
        for (int ri = 0; ri < 2; ++ri)
#pragma unroll
            for (int ks = 0; ks < 2; ++ks) {
                bf16x8 Bop[4];
#pragma unroll
                for (int jt = 0; jt < 4; ++jt) {
                    const int r0 = 32 * ks + 8 * lq; const LAS unsigned char* pa = scr + ri * 8192 + (r0 + (lr >> 2)) * 128 + (16 * jt + 4 * (lr & 3)) * 2;
                    const v4i16_t lo = __builtin_amdgcn_ds_read_tr16_b64_v4i16((LAS v4i16_t*)pa), hi = __builtin_amdgcn_ds_read_tr16_b64_v4i16((LAS v4i16_t*)(pa + 4 * 128));
                    Bop[jt] = (bf16x8){lo[0], lo[1], lo[2], lo[3], hi[0], hi[1], hi[2], hi[3]}; }
#pragma unroll
                for (int kt = 0; kt < 4; ++kt) { const bf16x8 aop = *(const LAS bf16x8*)((ri == 0 ? CT : ST) + (16 * kt + lr) * 128 + (32 * ks + 8 * lq) * 2);
#pragma unroll
                    for (int jt = 0; jt < 4; ++jt) acc[kt][jt] = MFMA16(aop, Bop[jt], acc[kt][jt]); }
            }
#pragma unroll
        for (int kt = 0; kt < 4; ++kt)
#pragma unroll
            for (int r = 0; r < 4; ++r) { const int k2 = 16 * kt + 4 * lq + r; float* dst = FO + (size_t)(b * SEQ + k1 + 64 * k2) * 256 + g * 64 + lr;
#pragma unroll
                for (int jt = 0; jt < 4; ++jt) dst[16 * jt] = acc[kt][jt][r] * (1.0f / 512.0f); }
        LDS_WAIT(); asm volatile("" ::: "memory");
    }
}
__device__ __forceinline__ void p_fft_ctx1(const Ctx& C) {
    const bf16* P = (const bf16*)(C.ws + WS_P); f32x2* GC = (f32x2*)(C.ws + WS_GC);
    const LAS f32x2* tw64 = (const LAS f32x2*)(C.lds + TW64_OFF);
    const int lane = C.lane;
    for (int id = C.gw; id < NB * 4 * CTXL; id += C.NGW) {
        const int b = id >> 10, g = (id >> 8) & 3, n = id & 255;
        const float fv = bf2f(P[(size_t)(MX + b * CTXL + n) * NIN + PF + g * 64 + lane]);
        float gr = 0.f, gi = 0.f;
#pragma unroll
        for (int c = 0; c < 64; ++c) { const float f = __builtin_bit_cast(float, __builtin_amdgcn_readlane(__builtin_bit_cast(int, fv), c)); const f32x2 t = tw64[(lane * c) & 63]; gr += f * t.x; gi -= f * t.y; }
        GC[(size_t)((b * 4 + g) * CTXL + n) * 64 + lane] = (f32x2){gr, gi};
    }
}
__device__ __forceinline__ void p_fft_ctx2(const Ctx& C) {
    const f32x2* GC = (const f32x2*)(C.ws + WS_GC); float* FO = (float*)(C.ws + WS_FO);
    const LAS f32x2* tw256 = (const LAS f32x2*)(C.lds + TW256_OFF);
    const int lane = C.lane;
    for (int id = ((C.wave + 4) & 7) * C.G + (int)blockIdx.x; id < NB * 4 * 64; id += C.NGW) {
        const int b = id >> 8, g = (id >> 6) & 3, kc = id & 63;
        float acc[4] = {0.f, 0.f, 0.f, 0.f};
        const f32x2* gp = GC + (size_t)((b * 4 + g) * CTXL) * 64 + lane;
#pragma unroll 1
        for (int n0 = 0; n0 < CTXL; n0 += 64) {
            f32x2 gv[64];
#pragma unroll
            for (int i = 0; i < 64; ++i) gv[i] = gp[(size_t)(n0 + i) * 64];
#pragma unroll
            for (int i = 0; i < 64; ++i)
#pragma unroll
                for (int kk = 0; kk < 4; ++kk) { const f32x2 t = tw256[((kc * 4 + kk) * (n0 + i)) & 255]; acc[kk] += t.x * gv[i].x + t.y * gv[i].y; }
        }
#pragma unroll
        for (int kk = 0; kk < 4; ++kk) FO[(size_t)(MX + b * CTXL + kc * 4 + kk) * 256 + g * 64 + lane] = acc[kk] * (1.0f / 128.0f);
    }
}

struct MergeIn { v4u na; u32x2 cg[3], uu[3], bg; f32x4 fo; unsigned okm[3]; };
__device__ __forceinline__ void merge_load(MergeIn& m, const bf16* P, const bf16* NA, const float* FO, int row, int lane) {
    const bool isctx = row >= MX; const int slen = isctx ? CTXL : SEQ, pos = isctx ? ((row - MX) & (CTXL - 1)) : (row & (SEQ - 1));
    m.na = *(const v4u*)(NA + (size_t)row * 512 + 8 * lane);
    const bf16* pr = P + (size_t)row * NIN;
#pragma unroll
    for (int dk = 0; dk < 3; ++dk) { const int pp = pos + dk - 1; const bool ok = pp >= 0 && pp < slen; const bf16* pq = pr + (ptrdiff_t)(dk - 1) * NIN;
        const bf16* pz = ok ? pq : pr;
        const u32x2 cgv = *(const u32x2*)(pz + PCG + 4 * lane), uuv = *(const u32x2*)(pz + PU + 4 * lane);
        m.cg[dk] = cgv; m.uu[dk] = uuv; m.okm[dk] = ok ? 0xffffffffu : 0u; }
    m.bg = *(const u32x2*)(pr + PBG + 4 * lane);
    m.fo = *(const f32x4*)(FO + (size_t)row * 256 + 4 * lane);
}
__device__ __forceinline__ void p_merge(const Ctx& C, const float* const (&in)[19], int layer) {
    const bf16* P = (const bf16*)(C.ws + WS_P); const bf16* NA = (const bf16*)(C.ws + WS_NA); const float* FO = (const float*)(C.ws + WS_FO); bf16* Y = (bf16*)(C.ws + WS_Y);
    LAS float* cw = (LAS float*)(C.lds + RING_OFF); LAS float* gm = cw + 768;
    stage_vec4(cw, in[IN_CONVW] + (size_t)layer * 3 * 256, 768 / 4, C.tid); stage_vec4(gm, in[IN_GMIXOUT] + (size_t)layer * D, D / 4, C.tid);
    __syncthreads();
    const int nrows = layer == 0 ? MT : MX, lane = C.lane;
    int row = C.gw; MergeIn m, nm;
    if (row < nrows) merge_load(m, P, NA, FO, row, lane);
    while (row < nrows) {
        const int nrow = row + C.NGW;
        merge_load(nm, P, NA, FO, nrow < nrows ? nrow : nrows - 1, lane);
        float na[8]; { const v4u w = m.na;
            na[0] = bflo(w.x); na[1] = bfhi(w.x); na[2] = bflo(w.y); na[3] = bfhi(w.y); na[4] = bflo(w.z); na[5] = bfhi(w.z); na[6] = bflo(w.w); na[7] = bfhi(w.w); }
        float s_na = 0.f;
#pragma unroll
        for (int i = 0; i < 8; ++i) s_na += na[i] * na[i];
        float z[3][4];
#pragma unroll
        for (int dk = 0; dk < 3; ++dk) { u32x2 cg = m.cg[dk]; const u32x2 uu = m.uu[dk]; cg.x &= m.okm[dk]; cg.y &= m.okm[dk];
            z[dk][0] = bflo(cg.x) * bflo(uu.x); z[dk][1] = bfhi(cg.x) * bfhi(uu.x); z[dk][2] = bflo(cg.y) * bflo(uu.y); z[dk][3] = bfhi(cg.y) * bfhi(uu.y); }
        const u32x2 bgw = m.bg;
        const f32x4 w0 = *(const LAS f32x4*)(cw + 4 * lane), w1 = *(const LAS f32x4*)(cw + 256 + 4 * lane), w2 = *(const LAS f32x4*)(cw + 512 + 4 * lane);
        float cv[4];
        cv[0] = bflo(bgw.x) * (w0.x * z[0][0] + w1.x * z[1][0] + w2.x * z[2][0]); cv[1] = bfhi(bgw.x) * (w0.y * z[0][1] + w1.y * z[1][1] + w2.y * z[2][1]);
        cv[2] = bflo(bgw.y) * (w0.z * z[0][2] + w1.z * z[1][2] + w2.z * z[2][2]); cv[3] = bfhi(bgw.y) * (w0.w * z[0][3] + w1.w * z[1][3] + w2.w * z[2][3]);
        float s_cv = cv[0] * cv[0] + cv[1] * cv[1] + cv[2] * cv[2] + cv[3] * cv[3];
        const f32x4 fo = m.fo;
        float s_fo = fo.x * fo.x + fo.y * fo.y + fo.z * fo.z + fo.w * fo.w;
        s_na = wave_sum(s_na); s_cv = wave_sum(s_cv); s_fo = wave_sum(s_fo);
        const float r_na = 1.0f / sqrtf(s_na * (1.f / 512.f) + RMS_EPS), r_cv = 1.0f / sqrtf(s_cv * (1.f / 256.f) + RMS_EPS), r_fo = 1.0f / sqrtf(s_fo * (1.f / 256.f) + RMS_EPS);
        bf16* yr = Y + (size_t)row * D;
        { const f32x4 g0 = *(const LAS f32x4*)(gm + 8 * lane), g1 = *(const LAS f32x4*)(gm + 8 * lane + 4);
          v4u w; w.x = pk2(na[0] * r_na * g0.x, na[1] * r_na * g0.y); w.y = pk2(na[2] * r_na * g0.z, na[3] * r_na * g0.w);
          w.z = pk2(na[4] * r_na * g1.x, na[5] * r_na * g1.y); w.w = pk2(na[6] * r_na * g1.z, na[7] * r_na * g1.w); *(v4u*)(yr + 8 * lane) = w; }
        { const f32x4 g0 = *(const LAS f32x4*)(gm + 512 + 4 * lane); u32x2 w; w.x = pk2(cv[0] * r_cv * g0.x, cv[1] * r_cv * g0.y); w.y = pk2(cv[2] * r_cv * g0.z, cv[3] * r_cv * g0.w); *(u32x2*)(yr + 512 + 4 * lane) = w; }
        { const f32x4 g0 = *(const LAS f32x4*)(gm + 768 + 4 * lane); u32x2 w; w.x = pk2(fo.x * r_fo * g0.x, fo.y * r_fo * g0.y); w.y = pk2(fo.z * r_fo * g0.z, fo.w * r_fo * g0.w); *(u32x2*)(yr + 768 + 4 * lane) = w; }
        m = nm; row = nrow;
    }
}
__device__ __forceinline__ const float* xin_row0(const float* const (&in)[19], int row) { return row < MX ? in[IN_X] + (size_t)row * D : in[IN_CTX] + (size_t)(row - MX) * D; }
__device__ __forceinline__ f32x4 bf4(u32x2 w) { return (f32x4){bflo(w.x), bfhi(w.x), bflo(w.y), bfhi(w.y)}; }
__device__ __forceinline__ u32x2 pk4bf(f32x4 a) { u32x2 w; w.x = pk2(a.x, a.y); w.y = pk2(a.z, a.w); return w; }
template <bool L0>
__device__ __forceinline__ void postmix_rows(const Ctx& C, const float* const (&in)[19], int layer, int row0, int rstride, int rend, const LAS float* WR, const LAS float* GPOST, const LAS float* GPRE, const LAS float* G1, const LAS float* SH2, const LAS float* SC2) {
    const bf16* MO = (const bf16*)(C.ws + WS_MO); bf16* X1 = (bf16*)(C.ws + WS_X1); const bf16* X2 = (const bf16*)(C.ws + WS_X2); unsigned char* H2 = C.ws + WS_H2; float* AFF = (float*)(C.ws + WS_AFF);
    const int lane = C.lane;
    int row = row0; f32x4 v[4], xx[4]; u32x2 nm[4], nxb[4]; f32x4 nxf[4];
    if (row >= rend) return;
#pragma unroll
    for (int j = 0; j < 4; ++j) { nm[j] = ((const u32x2*)(MO + (size_t)row * D))[lane + 64 * j];
        if (L0) nxf[j] = ((const f32x4*)xin_row0(in, row))[lane + 64 * j]; else nxb[j] = ((const u32x2*)(X2 + (size_t)row * D))[lane + 64 * j]; }
    while (row < rend) {
#pragma unroll
        for (int j = 0; j < 4; ++j) { v[j] = bf4(nm[j]); xx[j] = L0 ? nxf[j] : bf4(nxb[j]); }
        const int nrow = row + rstride, prow = nrow < rend ? nrow : rend - 1;
#pragma unroll
        for (int j = 0; j < 4; ++j) { nm[j] = ((const u32x2*)(MO + (size_t)prow * D))[lane + 64 * j];
            if (L0) nxf[j] = ((const f32x4*)xin_row0(in, prow))[lane + 64 * j]; else nxb[j] = ((const u32x2*)(X2 + (size_t)prow * D))[lane + 64 * j]; }
        const float r1 = 1.0f / sqrtf(wave_sum(sumsq4(v)) * (1.f / D) + RMS_EPS);
#pragma unroll
        for (int j = 0; j < 4; ++j) { const f32x4 gg = ((const LAS f32x4*)GPOST)[lane + 64 * j], g1v = ((const LAS f32x4*)G1)[lane + 64 * j];
            v[j] = xx[j] + g1v * (v[j] * r1 * gg); ((u32x2*)(X1 + (size_t)row * D))[lane + 64 * j] = pk4bf(v[j]); }
        const float r2 = 1.0f / sqrtf(wave_sum(sumsq4(v)) * (1.f / D) + RMS_EPS);
        f32x2 acc2[NE];
#pragma unroll
        for (int e = 0; e < NE; ++e) acc2[e] = (f32x2){0.f, 0.f};
#pragma unroll
        for (int j = 0; j < 4; ++j) {
            const f32x4 gg = ((const LAS f32x4*)GPRE)[lane + 64 * j], hh = ((const LAS f32x4*)SH2)[lane + 64 * j], cc = ((const LAS f32x4*)SC2)[lane + 64 * j];
            const f32x4 h = (v[j] * r2 * gg) * (cc + 1.0f) + hh;
            ((unsigned*)(H2 + (size_t)row * D))[lane + 64 * j] = pg8::pk4_fp8(h.x * S_ACT, h.y * S_ACT, h.z * S_ACT, h.w * S_ACT);
            const f32x2 hlo = (f32x2){h.x, h.y}, hhi = (f32x2){h.z, h.w};
#pragma unroll
            for (int e = 0; e < NE; ++e) { const f32x4 ww = ((const LAS f32x4*)(WR + e * D))[lane + 64 * j];
                acc2[e] += hlo * (f32x2){ww.x, ww.y}; acc2[e] += hhi * (f32x2){ww.z, ww.w};
                if ((e & 7) == 7) asm volatile("" ::: "memory"); }
        }
        float f;
        { const bool b0 = lane & 1, b1 = lane & 2, b2 = lane & 4, b3 = lane & 8;
          float s8[8], s4[4], s2[2];
#pragma unroll
          for (int k = 0; k < 8; ++k) { const float lo = acc2[k].x + acc2[k].y, hi = acc2[k + 8].x + acc2[k + 8].y; s8[k] = (b0 ? hi : lo) + dppf<0xB1>(b0 ? lo : hi); }
#pragma unroll
          for (int k = 0; k < 4; ++k) s4[k] = (b1 ? s8[k + 4] : s8[k]) + dppf<0x4E>(b1 ? s8[k] : s8[k + 4]);
#pragma unroll
          for (int k = 0; k < 2; ++k) s2[k] = (b2 ? s4[k + 2] : s4[k]) + __shfl_xor(b2 ? s4[k] : s4[k + 2], 4);
          f = (b3 ? s2[1] : s2[0]) + __shfl_xor(b3 ? s2[0] : s2[1], 8);
          f += __shfl_xor(f, 16); f += __shfl_xor(f, 32); }
        float mx = f; mx = fmaxf(mx, dppf<0xB1>(mx)); mx = fmaxf(mx, dppf<0x4E>(mx)); mx = fmaxf(mx, dppf<0x141>(mx)); mx = fmaxf(mx, dppf<0x140>(mx));
        const float pe = expf(f - mx);
        float sum = pe; sum += dppf<0xB1>(sum); sum += dppf<0x4E>(sum); sum += dppf<0x141>(sum); sum += dppf<0x140>(sum);
        if (lane < 16) AFF[(size_t)row * NE + (((lane & 1) << 3) | ((lane & 2) << 1) | ((lane & 4) >> 1) | ((lane & 8) >> 3))] = pe / sum;
        row = nrow;
    }
}
__device__ __forceinline__ void p_postmix(const Ctx& C, const float* const (&in)[19], int layer) {
    LAS float* WR = (LAS float*)(C.lds + RING_OFF); LAS float* GPOST = WR + D * NE; LAS float* GPRE = GPOST + D; LAS float* G1 = GPRE + D; LAS float* SH2 = G1 + D; LAS float* SC2 = SH2 + D;
    { const float* wr = in[IN_WROUTER] + (size_t)layer * D * NE;
      for (int u = C.tid; u < D * NE / 4; u += NWAVES * 64) { const f32x4 w = ((const f32x4*)wr)[u]; const int d = u >> 2, e0 = (u & 3) * 4;
          WR[(e0 + 0) * D + d] = w.x; WR[(e0 + 1) * D + d] = w.y; WR[(e0 + 2) * D + d] = w.z; WR[(e0 + 3) * D + d] = w.w; } }
    stage_vec4(GPOST, in[IN_GPOSTMIX] + (size_t)layer * D, D / 4, C.tid); stage_vec4(GPRE, in[IN_GPREFFN] + (size_t)layer * D, D / 4, C.tid);
    const bool by_sample = (C.G & 3) == 0;
    const int npass = by_sample ? 1 : 4;
    for (int ps = 0; ps < npass; ++ps) {
        const int b = by_sample ? ((int)blockIdx.x & 3) : ps;
        if (ps > 0) __syncthreads();
        stage_vec4(G1, modx(C, layer, b, 2), 3 * D / 4, C.tid);
        __syncthreads();
        const int wgs = by_sample ? C.G / 4 : C.G, wgi = by_sample ? ((int)blockIdx.x >> 2) : (int)blockIdx.x;
        if (layer == 0) postmix_rows<true>(C, in, layer, b * SEQ + wgi * NWAVES + C.wave, wgs * NWAVES, (b + 1) * SEQ, WR, GPOST, GPRE, G1, SH2, SC2);
        else postmix_rows<false>(C, in, layer, b * SEQ + wgi * NWAVES + C.wave, wgs * NWAVES, (b + 1) * SEQ, WR, GPOST, GPRE, G1, SH2, SC2);
    }
    if (layer == 0) {
        __syncthreads();
        stage_vec4(G1, modx(C, layer, 4, 2), 3 * D / 4, C.tid);
        __syncthreads();
        postmix_rows<true>(C, in, layer, MX + C.gw, C.NGW, MT, WR, GPOST, GPRE, G1, SH2, SC2);
    }
}

__device__ __forceinline__ int wave_isum(int v) {
#pragma unroll
    for (int o = 1; o < 64; o <<= 1) v += __shfl_xor(v, o);
    return v;
}
__device__ __forceinline__ void p_route(const Ctx& C, int layer) {
    const float* AFF = (const float*)(C.ws + WS_AFF); int* SLOT = (int*)(C.ws + WS_SLOT); const unsigned char* H2 = C.ws + WS_H2; unsigned char* XS = C.ws + WS_XS;
    LAS int* red = (LAS int*)(C.lds + RING_OFF);
    LAS int* list = (LAS int*)(C.lds + RING_OFF + 1024); LAS int* cnt = (LAS int*)(C.lds + RING_OFF + 512);
    const int nitems = layer == 0 ? 256 + 64 : 256;
    for (int item = blockIdx.x; item < nitems; item += C.G) {
        int b, e, NT, rowbase, cap, tok0, ntok, xsbase;
        if (item < 256) { b = item >> 6; e = (item >> 2) & 15; NT = SEQ; rowbase = b * SEQ; cap = CAPX; tok0 = (item & 3) * 1024; ntok = 1024; xsbase = e * EROWS + b * CAPX; }
        else { const int j = item - 256; b = j >> 4; e = j & 15; NT = CTXL; rowbase = MX + b * CTXL; cap = CAPC; tok0 = 0; ntok = CTXL; xsbase = e * EROWS + NB * CAPX + b * CAPC; }
        unsigned v[8];
#pragma unroll
        for (int j = 0; j < 8; ++j) { const int t = C.tid * 8 + j; v[j] = t < NT ? __float_as_uint(AFF[(size_t)(rowbase + t) * NE + e]) : 0u; }
        if (C.tid == 0) *cnt = 0;
        unsigned T = 0u;
        for (int bit = 30; bit >= 0; --bit) {
            const unsigned cand = T | (1u << bit); int c = 0;
#pragma unroll
            for (int j = 0; j < 8; ++j) c += __builtin_popcountll(__builtin_amdgcn_ballot_w64(v[j] >= cand));
            LAS int* r = red + (bit & 1) * 8;
            if (C.lane == 0) r[C.wave] = c;
            __syncthreads();
            int tot = 0;
#pragma unroll
            for (int w = 0; w < 8; ++w) tot += r[w];
            if (tot >= cap) T = cand;
        }
        int cg = 0, ce = 0;
#pragma unroll
        for (int j = 0; j < 8; ++j) { cg += (v[j] > T) ? 1 : 0; ce += (v[j] == T && (C.tid * 8 + j) < NT) ? 1 : 0; }
        int sg = cg, se = ce;
#pragma unroll
        for (int o = 1; o < 64; o <<= 1) { const int ag = __shfl_up(sg, o), ae = __shfl_up(se, o); if (C.lane >= o) { sg += ag; se += ae; } }
        LAS int* sc = red + 64;
        __syncthreads();
        if (C.lane == 63) { sc[C.wave] = sg; sc[8 + C.wave] = se; }
        __syncthreads();
        int bg = 0, be = 0, totg = 0;
#pragma unroll
        for (int w = 0; w < 8; ++w) { const int xg = sc[w], xe = sc[8 + w]; if (w < C.wave) { bg += xg; be += xe; } totg += xg; }
        int pg = bg + sg - cg, pe = be + se - ce;
        const int need_eq = cap - totg;
#pragma unroll
        for (int j = 0; j < 8; ++j) {
            const int t = C.tid * 8 + j; const bool gt = v[j] > T, eq = (v[j] == T) && t < NT;
            const bool sel = gt || (eq && pe < need_eq);
            const int slot = pg + min(pe, need_eq);
            if (t >= tok0 && t < tok0 + ntok) {
                SLOT[(size_t)(rowbase + t) * NE + e] = sel ? slot : -1;
                if (sel) { const int pos = atomicAdd((int*)cnt, 1); list[2 * pos] = t; list[2 * pos + 1] = slot; }
            }
            pg += gt ? 1 : 0; pe += eq ? 1 : 0;
        }
        __syncthreads();
        const int n = *cnt;
        for (int idx = C.wave * 8; idx < n; idx += NWAVES * 8) {
            v4u w[8]; int sl8[8];
#pragma unroll
            for (int q = 0; q < 8; ++q) { const int ii = min(idx + q, n - 1); sl8[q] = list[2 * ii + 1]; w[q] = ((const v4u*)(H2 + (size_t)(rowbase + list[2 * ii]) * D))[C.lane]; }
#pragma unroll
            for (int q = 0; q < 8; ++q) ((v4u*)(XS + (size_t)(xsbase + sl8[q]) * D))[C.lane] = w[q];
        }
        __syncthreads();
    }
}

__device__ __forceinline__ void combine_rows(const Ctx& C, float* XO, int layer, int row0, int rstride, int rend, int ebase_, const LAS float* GPF, const LAS float* G2, const LAS float* GP1, const LAS float* SH1, const LAS float* SC1) {
    const float* AFF = (const float*)(C.ws + WS_AFF); const int* SLOT = (const int*)(C.ws + WS_SLOT); const bf16* YE = (const bf16*)(C.ws + WS_YE); const bf16* X1 = (const bf16*)(C.ws + WS_X1); bf16* H = (bf16*)(C.ws + WS_H);
    const int lane = C.lane, le = lane & 15;
    int row = row0; u32x2 xx[4], nx[4]; int sl = -1, nsl = -1; float gt = 0.f, ngt = 0.f;
    if (row < rend) { sl = SLOT[(size_t)row * NE + le]; gt = AFF[(size_t)row * NE + le];
#pragma unroll
        for (int j = 0; j < 4; ++j) xx[j] = ((const u32x2*)(X1 + (size_t)row * D))[lane + 64 * j]; }
    while (row < rend) {
        const int nrow = row + rstride;
        { const int prow = nrow < rend ? nrow : rend - 1;
          nsl = SLOT[(size_t)prow * NE + le]; ngt = AFF[(size_t)prow * NE + le];
#pragma unroll
          for (int j = 0; j < 4; ++j) nx[j] = ((const u32x2*)(X1 + (size_t)prow * D))[lane + 64 * j]; }
        f32x4 a[4];
#pragma unroll
        for (int j = 0; j < 4; ++j) a[j] = (f32x4){0.f, 0.f, 0.f, 0.f};
        const int ebase = ebase_ >= 0 ? ebase_ : NB * CAPX + ((row - MX) >> 8) * CAPC;
        unsigned mask = (unsigned)(__builtin_amdgcn_ballot_w64(sl >= 0) & 0xffffull);
        while (mask) {
            const int e0 = __builtin_ctz(mask); mask &= mask - 1u;
            const int s0 = __builtin_amdgcn_readlane(sl, e0); const float g0 = __builtin_bit_cast(float, __builtin_amdgcn_readlane(__builtin_bit_cast(int, gt), e0));
            const u32x2* y0 = (const u32x2*)(YE + (size_t)(e0 * EROWS + ebase + s0) * D);
            if (mask) {
                const int e1 = __builtin_ctz(mask); mask &= mask - 1u;
                const int s1 = __builtin_amdgcn_readlane(sl, e1); const float g1 = __builtin_bit_cast(float, __builtin_amdgcn_readlane(__builtin_bit_cast(int, gt), e1));
                const u32x2* y1 = (const u32x2*)(YE + (size_t)(e1 * EROWS + ebase + s1) * D);
                u32x2 w0[4], w1[4];
#pragma unroll
                for (int j = 0; j < 4; ++j) { w0[j] = y0[lane + 64 * j]; w1[j] = y1[lane + 64 * j]; }
#pragma unroll
                for (int j = 0; j < 4; ++j) { a[j].x += g0 * bflo(w0[j].x); a[j].y += g0 * bfhi(w0[j].x); a[j].z += g0 * bflo(w0[j].y); a[j].w += g0 * bfhi(w0[j].y); }
#pragma unroll
                for (int j = 0; j < 4; ++j) { a[j].x += g1 * bflo(w1[j].x); a[j].y += g1 * bfhi(w1[j].x); a[j].z += g1 * bflo(w1[j].y); a[j].w += g1 * bfhi(w1[j].y); }
            } else {
#pragma unroll
                for (int j = 0; j < 4; ++j) { const u32x2 w = y0[lane + 64 * j]; a[j].x += g0 * bflo(w.x); a[j].y += g0 * bfhi(w.x); a[j].z += g0 * bflo(w.y); a[j].w += g0 * bfhi(w.y); }
            }
        }
        const float r = 1.0f / sqrtf(wave_sum(sumsq4(a)) * (1.f / D) + RMS_EPS);
#pragma unroll
        for (int j = 0; j < 4; ++j) { const f32x4 gg = ((const LAS f32x4*)GPF)[lane + 64 * j], g2v = ((const LAS f32x4*)G2)[lane + 64 * j];
            a[j] = bf4(xx[j]) + g2v * (a[j] * r * gg);
            if (layer == 0) ((u32x2*)((bf16*)XO + (size_t)row * D))[lane + 64 * j] = pk4bf(a[j]); else ((f32x4*)(XO + (size_t)row * D))[lane + 64 * j] = a[j]; }
        if (layer == 0) norm_mod_store_lds(a, wave_sum(sumsq4(a)), GP1, SH1, SC1, H + (size_t)row * D, lane);
#pragma unroll
        for (int j = 0; j < 4; ++j) xx[j] = nx[j];
        sl = nsl; gt = ngt; row = nrow;
    }
}
__device__ __forceinline__ void p_combine(const Ctx& C, const float* const (&in)[19], float* out, int layer) {
    float* XO = layer == 0 ? (float*)(C.ws + WS_X2) : out;
    LAS float* GPF = (LAS float*)(C.lds + RING_OFF); LAS float* GP1 = GPF + D; LAS float* G2 = GP1 + D; LAS float* SH1 = G2 + D; LAS float* SC1 = SH1 + D;
    stage_vec4(GPF, in[IN_GPOSTFFN] + (size_t)layer * D, D / 4, C.tid);
    if (layer == 0) stage_vec4(GP1, in[IN_GPREMIX] + D, D / 4, C.tid);
    const bool by_sample = (C.G & 3) == 0; const int npass = by_sample ? 1 : 4;
    for (int ps = 0; ps < npass; ++ps) {
        const int b = by_sample ? ((int)blockIdx.x & 3) : ps;
        if (ps > 0) __syncthreads();
        stage_vec4(G2, modx(C, layer, b, 5), D / 4, C.tid);
        if (layer == 0) stage_vec4(SH1, modx(C, 1, b, 0), 2 * D / 4, C.tid);
        __syncthreads();
        const int wgs = by_sample ? C.G / 4 : C.G, wgi = by_sample ? ((int)blockIdx.x >> 2) : (int)blockIdx.x;
        combine_rows(C, XO, layer, b * SEQ + wgi * NWAVES + C.wave, wgs * NWAVES, (b + 1) * SEQ, b * CAPX, GPF, G2, GP1, SH1, SC1);
    }
    if (layer == 0) {
        __syncthreads();
        stage_vec4(G2, modx(C, layer, 4, 5), D / 4, C.tid); stage_vec4(SH1, modx(C, 1, 4, 0), 2 * D / 4, C.tid);
        __syncthreads();
        combine_rows(C, XO, layer, MX + C.gw, C.NGW, MT, -1, GPF, G2, GP1, SH1, SC1);
    }
}
constexpr int NPH = 22;
#ifndef MK_PER_PHASE
#define MK_PER_PHASE 0
#endif
struct Args { const float* in[19]; float* out; unsigned char* ws; int ph_lo, ph_hi; };
__global__ void __launch_bounds__(NWAVES * 64, 2) mk_fwd(Args args) {
    extern __shared__ __attribute__((aligned(16))) unsigned char lds_raw[];
    Ctx C;
    C.ws = args.ws; C.lds = (LAS unsigned char*)lds_raw;
    C.tid = threadIdx.x; C.lane = C.tid & 63; C.wave = __builtin_amdgcn_readfirstlane(C.tid >> 6); C.G = gridDim.x;
    C.gw = blockIdx.x * NWAVES + C.wave; C.NGW = C.G * NWAVES;
    volatile LAS unsigned* MISC = (volatile LAS unsigned*)(C.lds + MISC_OFF);
    for (int u = C.tid; u < (512 - 0) / 4; u += NWAVES * 64) ((LAS unsigned*)(C.lds + LDSCTL_OFF))[u] = 0u;
    if (C.tid < 64) { float s, c; sincospif((float)C.tid * (1.0f / 32.0f), &s, &c); ((LAS f32x2*)(C.lds + TW64_OFF))[C.tid] = (f32x2){c, s}; }
    if (C.tid < 256) { float s, c; sincospif((float)C.tid * (1.0f / 128.0f), &s, &c); ((LAS f32x2*)(C.lds + TW256_OFF))[C.tid] = (f32x2){c, s}; }
    if (C.tid >= 256 && C.tid < 320) { float s, c; sincospif((float)(C.tid - 256) * (1.0f / 2048.0f), &s, &c); ((LAS f32x2*)(C.lds + TW4K_OFF))[C.tid - 256] = (f32x2){c, s}; }
    for (int u = C.tid; u < 4096; u += NWAVES * 64) { float s, c; sincospif((float)(((u >> 6) * (u & 63)) & 63) * (1.0f / 32.0f), &s, &c); ((LAS bf16*)(C.lds + CT_OFF))[u] = (bf16)f2bf(c); ((LAS bf16*)(C.lds + ST_OFF))[u] = (bf16)f2bf(s); }
    __syncthreads();
    gu32* ctl = (gu32*)(C.ws + WS_CTL);
    XcdBarrier bar = xcd_barrier_post((unsigned*)(ctl + CW_BAR), MISC + 8);
    const int lo = args.ph_lo, hi = args.ph_hi;
#ifndef DBG_MASK
#define DBG_MASK 0xffffffffu
#endif
#define PH_ON(k) (((DBG_MASK) >> (k)) & 1u)
#ifndef DBG_REP
#define DBG_REP 0u
#endif
#define REP(k) _Pragma("unroll") for (int rep_ = 0; rep_ < 1 + (int)(((DBG_REP) >> (k)) & 1u); ++rep_)
#define IN(k) (lo <= (k) && (k) < hi)
#ifdef DBG_TPHASE
    unsigned long long tp0_ = 0, tp1_ = 0;
#define TPROBE(k) do { if ((k) == DBG_TPHASE) tp0_ = __builtin_amdgcn_s_memrealtime(); if ((k) == DBG_TPHASE + 1) tp1_ = __builtin_amdgcn_s_memrealtime(); } while (0)
#else
#define TPROBE(k) do { } while (0)
#endif
#define SEAM(k) do { if (IN(k) && IN((k) + 1)) xcd_barrier(bar); TPROBE((k) + 1); } while (0)

    TPROBE(0);
    if (PH_ON(0) && IN(0)) REP(0) p0_prologue(C, args.in);
    SEAM(0);
    if (PH_ON(1) && IN(1)) REP(1) p1_h0(C, args.in);
    SEAM(1);
    for (int layer = 0; layer < DEPTH; ++layer) {
        const int pb = 2 + 10 * layer;
        Ctx L = C; asm volatile("" : "+v"(L.tid), "+v"(L.lane)); asm volatile("" : "+s"(L.wave), "+s"(L.gw));
        if (PH_ON(2) && IN(pb + 0)) REP(2) {
            pg8::Gemm g{(const pg8::bf16_t*)(L.ws + WS_H), (const pg8::bf16_t*)(L.ws + WS_WINT) + (size_t)layer * NIN * D, MT, NIN, D};
            pg8::TileOrder S; S.init(MT / 256, NIN / 256, L.G, (int)blockIdx.x);
            pg8::EpiBf16Map E{(pg8::bf16_t*)(L.ws + WS_P), NIN, 1 << 30, 1.0f};
            pg8::gemm_phase<pg8::EpiBf16Map, pg8::TileOrder, true, true>(L.lds + RING_OFF, g, S, E);
        }
        SEAM(pb + 0);
        if (IN(pb + 1)) { if (PH_ON(3)) REP(3) p_attn(L, args.in, layer); if (PH_ON(4)) REP(4) p_fft_a(L); if (PH_ON(5) && layer == 0) REP(5) p_fft_ctx1(L); }
        SEAM(pb + 1);
        if (IN(pb + 2)) { if (PH_ON(6)) REP(6) p_fft_b(L); if (PH_ON(5) && layer == 0) REP(5) p_fft_ctx2(L); }
        SEAM(pb + 2);
        if (PH_ON(7) && IN(pb + 3)) REP(7) p_merge(L, args.in, layer);
        SEAM(pb + 3);
        if (PH_ON(8) && IN(pb + 4)) REP(8) {
            pg8::Gemm g{(const pg8::bf16_t*)(L.ws + WS_Y), (const pg8::bf16_t*)(L.ws + WS_WOUTT) + (size_t)layer * D * D, MT, D, D};
            pg8::TileOrder S; S.init((layer == 0 ? MT : MX) / 256, D / 256, L.G, (int)blockIdx.x);
            pg8::EpiBf16Map E{(pg8::bf16_t*)(L.ws + WS_MO), D, 1 << 30, 1.0f};
            pg8::gemm_phase<pg8::EpiBf16Map, pg8::TileOrder, true, true>(L.lds + RING_OFF, g, S, E);
        }
        SEAM(pb + 4);
        if (PH_ON(9) && IN(pb + 5)) REP(9) p_postmix(L, args.in, layer);
        SEAM(pb + 5);
        if (PH_ON(10) && IN(pb + 6)) REP(10) p_route(L, layer);
        SEAM(pb + 6);
        if (PH_ON(11) && IN(pb + 7)) REP(11) {
            pg8::Gemm g{(const pg8::bf16_t*)(L.ws + WS_XS), (const pg8::bf16_t*)(L.ws + WS_WGUT + (size_t)layer * NE * 2 * FH * D), NE * EROWS, NE * 2 * FH, D / 2};
            pg8::GroupOrder S; S.init(NE, layer == 0 ? ETILES : ETILES - 1, ETILES, FNT, L.G, (int)blockIdx.x);
            pg8::EpiSwiGLU8 E{L.ws + WS_HID, FH, FNT, 1.0f / (S_ACT * S_WGU), S_HID};
            pg8::gemm_phase<pg8::EpiSwiGLU8, pg8::GroupOrder, true, true, true>(L.lds + RING_OFF, g, S, E);
        }
        SEAM(pb + 7);
        if (PH_ON(12) && IN(pb + 8)) REP(12) {
            pg8::Gemm g{(const pg8::bf16_t*)(L.ws + WS_HID), (const pg8::bf16_t*)(L.ws + WS_WDT + (size_t)layer * NE * D * FH), NE * EROWS, NE * D, FH / 2};
            pg8::GroupOrder S; S.init(NE, layer == 0 ? ETILES : ETILES - 1, ETILES, D / 256, L.G, (int)blockIdx.x);
            pg8::EpiBf16Map E{(pg8::bf16_t*)(L.ws + WS_YE), D, D / 256, 1.0f / (S_HID * S_WDN)};
            pg8::gemm_phase<pg8::EpiBf16Map, pg8::GroupOrder, true, true, true>(L.lds + RING_OFF, g, S, E);
        }
        SEAM(pb + 8);
        if (PH_ON(13) && IN(pb + 9)) REP(13) p_combine(L, args.in, args.out, layer);
        SEAM(pb + 9);
#ifdef DBG_XBAR
        for (int xb = 0; xb < DBG_XBAR; ++xb) xcd_barrier(bar);
#endif
    }
#ifdef DBG_TPHASE
    if (DBG_TPHASE == NPH - 1) tp1_ = __builtin_amdgcn_s_memrealtime();
    { const unsigned long long t0 = __builtin_amdgcn_s_memrealtime(), dt = (tp1_ - tp0_) * DBG_SPINMUL; if (blockIdx.x == 0) while (__builtin_amdgcn_s_memrealtime() - t0 < dt) __builtin_amdgcn_s_sleep(8); }
#endif
#undef IN
#undef SEAM
}

extern "C" void kernel_launch(void* const* d_in, const int* in_sizes, int n_in, void* d_out, int out_size, void* d_ws, size_t ws_size, hipStream_t stream) {
    static int grid = 0;
    if (grid == 0) {
        if (n_in != 19 || in_sizes[0] != MX * D || out_size != MX * D || ws_size < WS_END) { fprintf(stderr, "kernel_launch: unexpected shapes (n_in %d, in0 %d, out %d, ws %zu < %zu); nothing launched\n", n_in, n_in > 0 ? in_sizes[0] : -1, out_size, ws_size, (size_t)WS_END); grid = -1; return; }
        int dev = 0, cus = 0, per_cu = 0;
        if (hipGetDevice(&dev) != hipSuccess || hipDeviceGetAttribute(&cus, hipDeviceAttributeMultiprocessorCount, dev) != hipSuccess) { fprintf(stderr, "kernel_launch: device query failed\n"); grid = -1; return; }
        if (hipFuncSetAttribute((const void*)mk_fwd, hipFuncAttributeMaxDynamicSharedMemorySize, LDS_BYTES) != hipSuccess) { fprintf(stderr, "kernel_launch: hipFuncSetAttribute failed\n"); grid = -1; return; }
        if (hipOccupancyMaxActiveBlocksPerMultiprocessor(&per_cu, (const void*)mk_fwd, NWAVES * 64, LDS_BYTES) != hipSuccess || per_cu < 1)
            fprintf(stderr, "kernel_launch: note: occupancy query reports %d workgroups per CU\n", per_cu);
        (void)hipGetLastError();
        grid = cus;
    }
    if (grid < 0) return;
    if (hipMemsetAsync((char*)d_ws + WS_CTL, 0, CTL_ZERO_BYTES, stream) != hipSuccess) { fprintf(stderr, "kernel_launch: memset failed\n"); return; }
    Args a{};
    for (int i = 0; i < 19; ++i) a.in[i] = (const float*)d_in[i];
    a.out = (float*)d_out; a.ws = (unsigned char*)d_ws;
#if MK_PER_PHASE
    for (int ph = 0; ph < NPH; ++ph) { a.ph_lo = ph; a.ph_hi = ph + 1; hipLaunchKernelGGL(mk_fwd, dim3(grid), dim3(NWAVES * 64), LDS_BYTES, stream, a); }
#else
    a.ph_lo = 0; a.ph_hi = NPH;
    hipLaunchKernelGGL(mk_fwd, dim3(grid), dim3(NWAVES * 64), LDS_BYTES, stream, a);
#endif
    const hipError_t le = hipPeekAtLastError();
    if (le != hipSuccess) fprintf(stderr, "kernel_launch: launch failed: %s\n", hipGetErrorName(le));
}
```

```cpp
#include <hip/hip_runtime.h>
#include <cstdio>
#include <cstdint>
#define WOUT_FP8 1
#define CFG_NI 4, 3, 2, 3
namespace pg8 {
#define PG8_LAS __attribute__((address_space(3)))
typedef unsigned short bf16_t;
typedef short bf16x8 __attribute__((ext_vector_type(8)));
typedef float f32x4 __attribute__((ext_vector_type(4)));
typedef unsigned u32x4 __attribute__((ext_vector_type(4)));
typedef int i32x4 __attribute__((ext_vector_type(4)));
typedef int i32x8 __attribute__((ext_vector_type(8)));
typedef unsigned u32x2 __attribute__((ext_vector_type(2)));
constexpr int BM = 256, BK = 64, HALF = 128, HTB = HALF * BK * 2  , STAGE_BYTES = 8 * HTB, NXCD = 8, WGM = 8;

__host__ __device__ __forceinline__ int lds_byte(int r, int c) { const int st = (r >> 4) * 2 + (c >> 5), rr = r & 15, cc = c & 31, ob = rr * 64 + cc * 2; return st * 1024 + (ob ^ (((ob >> 9) & 1) << 5)); }
__host__ __device__ __forceinline__ void stage_rc(int b, int& R, int& C) { const int st = b / 1024, sb = b % 1024, swz = sb ^ (((sb >> 9) & 1) << 5); R = (st >> 1) * 16 + swz / 64; C = (st & 1) * 32 + (swz % 64) / 2; }
__host__ __device__ __forceinline__ int perm32(int rho) { const int n = rho >> 4, i = rho & 15; return 8 * (i >> 2) + 4 * n + (i & 3); }

struct Unit { int pm, pn; int half; };
struct Gemm { const bf16_t* A; const bf16_t* Bt; int M, N, K; };

struct StaticOrder {
    int nM, nN, nwg, G, c;
    __host__ __device__ void init(int M, int N, int G_, int c_) { nM = M / BM; nN = N / BM; nwg = nM * nN; G = G_; c = c_; }
    __host__ __device__ bool next(int i, Unit& u) const {
        const long L = (long)i * G + c; if (L >= nwg) return false;
        int wgid = (int)L; { const int q = nwg / NXCD, r = nwg % NXCD, xcd = wgid % NXCD, off = wgid / NXCD; wgid = (xcd < r ? xcd * (q + 1) : r * (q + 1) + (xcd - r) * q) + off; }
        const int nig = WGM * nN, gid = wgid / nig, fm = gid * WGM, gsz = (nM - fm) < WGM ? (nM - fm) : WGM;
        u.pm = fm + ((wgid % nig) % gsz); u.pn = (wgid % nig) / gsz; u.half = 0; return true;
    }
    __device__ __forceinline__ void a_ready(const Unit&) const {}
    __device__ __forceinline__ void done(const Unit&) const {}
};

__device__ __forceinline__ unsigned cvt_pk_bf16(float lo, float hi) { unsigned r; asm volatile("v_cvt_pk_bf16_f32 %0, %1, %2" : "=v"(r) : "v"(lo), "v"(hi)); return r; }
struct TileOrder {
    int nM, nN, nwg, G, c;
    __device__ void init(int nM_, int nN_, int G_, int c_) { nM = nM_; nN = nN_; nwg = nM * nN; G = G_; c = c_; }
    __device__ bool next(int i, Unit& u) const {
        int wgid;
        if ((G & 7) == 0) { const int per = G >> 3; wgid = (i * 8 + (c & 7)) * per + (c >> 3); } else wgid = i * G + c;
        if (wgid >= nwg) return false;
        const int nig = WGM * nN, gid = wgid / nig, fm = gid * WGM, gsz = (nM - fm) < WGM ? (nM - fm) : WGM;
        u.pm = fm + ((wgid % nig) % gsz); u.pn = (wgid % nig) / gsz; u.half = 0; return true;
    }
    __device__ __forceinline__ void a_ready(const Unit&) const {}
    __device__ __forceinline__ void done(const Unit&) const {}
};
struct GroupOrder {
    int nE, nMt, strideM, nNt, nwg, G, c, half_im;
    __device__ void init(int nE_, int nMt_, int strideM_, int nNt_, int G_, int c_, int half_im_) { nE = nE_; nMt = nMt_; strideM = strideM_; nNt = nNt_; nwg = nE * nMt * nNt; G = G_; c = c_; half_im = half_im_; }
    __device__ bool next(int i, Unit& u) const {
        int wgid;
        if ((G & 7) == 0) { const int per = G >> 3; wgid = (i * 8 + (c & 7)) * per + (c >> 3); } else wgid = i * G + c;
        if (wgid >= nwg) return false;
        const int per_e = nMt * nNt, e = wgid / per_e, r = wgid % per_e, jn = r / nMt, im = r % nMt;
        u.pm = e * strideM + im; u.pn = e * nNt + jn; u.half = (im == half_im) ? 1 : 0; return true;
    }
    __device__ __forceinline__ void a_ready(const Unit&) const {}
    __device__ __forceinline__ void done(const Unit&) const {}
};
struct EpiBf16Map {
    static constexpr bool PERM = true, AFTER_DRAIN = false;
    bf16_t* O; int ldc; int pn_mod; float scale;
    __device__ __forceinline__ void operator()(const f32x4 (&acc)[2][2][4][2], const Unit& u, int wr, int wc, int fr_, int fq_) const {
        int fr = fr_, fq = fq_; asm volatile("" : "+v"(fr), "+v"(fq));
        const int row0 = u.pm * BM + wr * 64 + fr, col0 = (u.pn % pn_mod) * BM + wc * 32 + 8 * fq;
#pragma unroll
        for (int ai = 0; ai < 2; ++ai)
#pragma unroll
            for (int m = 0; m < 4; ++m) { if (ai == 1 && u.half) continue; bf16_t* rowp = O + (size_t)(row0 + ai * HALF + m * 16) * ldc + col0;
#pragma unroll
                for (int bj = 0; bj < 2; ++bj) { const f32x4 v0 = acc[ai][bj][m][0] * scale, v1 = acc[ai][bj][m][1] * scale;
                    u32x4 w; w.x = cvt_pk_bf16(v0[0], v0[1]); w.y = cvt_pk_bf16(v0[2], v0[3]); w.z = cvt_pk_bf16(v1[0], v1[1]); w.w = cvt_pk_bf16(v1[2], v1[3]);
                    *(u32x4*)(rowp + bj * HALF) = w; } }
    }
};
struct EpiF32 {
    static constexpr bool PERM = false, AFTER_DRAIN = false;
    float* O; int ldc;
    __device__ __forceinline__ void operator()(const f32x4 (&acc)[2][2][4][2], const Unit& u, int wr, int wc, int fr_, int fq_) const {
        int fr = fr_, fq = fq_; asm volatile("" : "+v"(fr), "+v"(fq));
        const int row0 = u.pm * BM + wr * 64 + fr, col0 = u.pn * BM + wc * 32 + 4 * fq;
#pragma unroll
        for (int ai = 0; ai < 2; ++ai)
#pragma unroll
            for (int m = 0; m < 4; ++m) { if (ai == 1 && u.half) continue; float* rowp = O + (size_t)(row0 + ai * HALF + m * 16) * ldc + col0;
#pragma unroll
                for (int bj = 0; bj < 2; ++bj)
#pragma unroll
                    for (int n = 0; n < 2; ++n) *(f32x4*)(rowp + bj * HALF + n * 16) = acc[ai][bj][m][n]; }
    }
};
__device__ __forceinline__ float silu_f(float g) { return g * __builtin_amdgcn_rcpf(1.0f + __builtin_amdgcn_exp2f(-1.4426950408889634f * g)); }
struct EpiSwiGLU {
    static constexpr bool PERM = true, AFTER_DRAIN = false;
    bf16_t* O; int ldc; int pn_mod;
    __device__ __forceinline__ void operator()(const f32x4 (&acc)[2][2][4][2], const Unit& u, int wr, int wc, int fr_, int fq_) const {
        int fr = fr_, fq = fq_; asm volatile("" : "+v"(fr), "+v"(fq));
        const int row0 = u.pm * BM + wr * 64 + fr, col0 = (u.pn % pn_mod) * HALF + wc * 32 + 8 * fq;
#pragma unroll
        for (int ai = 0; ai < 2; ++ai)
#pragma unroll
            for (int m = 0; m < 4; ++m) { if (ai == 1 && u.half) continue; bf16_t* rowp = O + (size_t)(row0 + ai * HALF + m * 16) * ldc + col0;
                const f32x4 g0 = acc[ai][0][m][0], g1 = acc[ai][0][m][1], u0 = acc[ai][1][m][0], u1 = acc[ai][1][m][1];
                u32x4 w; w.x = cvt_pk_bf16(silu_f(g0[0]) * u0[0], silu_f(g0[1]) * u0[1]); w.y = cvt_pk_bf16(silu_f(g0[2]) * u0[2], silu_f(g0[3]) * u0[3]);
                w.z = cvt_pk_bf16(silu_f(g1[0]) * u1[0], silu_f(g1[1]) * u1[1]); w.w = cvt_pk_bf16(silu_f(g1[2]) * u1[2], silu_f(g1[3]) * u1[3]);
                *(u32x4*)rowp = w; }
    }
};

__device__ __forceinline__ unsigned pk4_fp8(float a, float b, float c, float d) {
    a = fminf(fmaxf(a, -448.f), 448.f); b = fminf(fmaxf(b, -448.f), 448.f); c = fminf(fmaxf(c, -448.f), 448.f); d = fminf(fmaxf(d, -448.f), 448.f);
    unsigned w = 0u; w = __builtin_amdgcn_cvt_pk_fp8_f32(a, b, w, false); w = __builtin_amdgcn_cvt_pk_fp8_f32(c, d, w, true); return w;
}
struct EpiSwiGLU8 {
    static constexpr bool PERM = true, AFTER_DRAIN = false;
    unsigned char* O; int ldc; int pn_mod; float inv, oscale;
    __device__ __forceinline__ void operator()(const f32x4 (&acc)[2][2][4][2], const Unit& u, int wr, int wc, int fr_, int fq_) const {
        int fr = fr_, fq = fq_; asm volatile("" : "+v"(fr), "+v"(fq));
        const int row0 = u.pm * BM + wr * 64 + fr, col0 = (u.pn % pn_mod) * HALF + wc * 32 + 8 * fq;
#pragma unroll
        for (int ai = 0; ai < 2; ++ai)
#pragma unroll
            for (int m = 0; m < 4; ++m) { if (ai == 1 && u.half) continue; unsigned char* rowp = O + (size_t)(row0 + ai * HALF + m * 16) * ldc + col0;
                const f32x4 g0 = acc[ai][0][m][0] * inv, g1 = acc[ai][0][m][1] * inv, u0 = acc[ai][1][m][0] * (inv * oscale), u1 = acc[ai][1][m][1] * (inv * oscale);
                u32x2 w; w.x = pk4_fp8(silu_f(g0[0]) * u0[0], silu_f(g0[1]) * u0[1], silu_f(g0[2]) * u0[2], silu_f(g0[3]) * u0[3]);
                w.y = pk4_fp8(silu_f(g1[0]) * u1[0], silu_f(g1[1]) * u1[1], silu_f(g1[2]) * u1[2], silu_f(g1[3]) * u1[3]);
                *(u32x2*)rowp = w; }
    }
};
template <class Epi, class Sched, bool ALIGN_EPI = false, bool SP2 = false, bool FP8 = false>
__device__ __forceinline__ void gemm_phase(PG8_LAS unsigned char* lds, const Gemm g, const Sched& S, const Epi& E) {
    int tid_ = threadIdx.x; asm volatile("" : "+v"(tid_));
    const int tid = tid_, wid = __builtin_amdgcn_readfirstlane(tid >> 6), lane = tid & 63, wr = wid >> 2, wc = wid & 3, fr = lane & 15, fq = lane >> 4;
    const int K = g.K, nt = K / BK;
    unsigned voffA[2], voffB[2];
#pragma unroll
    for (int i = 0; i < 2; ++i) { int R, C; stage_rc(tid * 16 + i * 8192, R, C); const int Rb = Epi::PERM ? ((R & ~31) + perm32(R & 31)) : R;
        voffA[i] = (unsigned)(R * K + C) * 2u; voffB[i] = (unsigned)(Rb * K + C) * 2u; }
    const size_t kstep = (size_t)(BK * 2);
    const size_t hstep = (size_t)HALF * K * 2;
    const size_t tstep = 2 * hstep;
    const unsigned ldsw = (unsigned)wid * 1024u;
    const int aoff = lds_byte(wr * 64 + fr, fq * 8), boff = lds_byte(wc * 32 + fr, fq * 8);
#define PG8_SA(b, h) (((b) * 2 + (h)) * HTB)
#define PG8_SB(b, h) ((4 + (b) * 2 + (h)) * HTB)
#define PG8_STAGE(bufoff, gbase, voff) do { _Pragma("unroll") for (int _i = 0; _i < 2; ++_i) \
        __builtin_amdgcn_global_load_lds((const unsigned*)((const char*)(gbase) + (voff)[_i]), (PG8_LAS unsigned*)(lds + (bufoff) + ldsw + _i * 8192), 16, 0, 0); } while (0)
#define PG8_LDA(dst, b, h) do { if constexpr (FP8) { _Pragma("unroll") for (int m = 0; m < 4; ++m) dst##8[m] = __builtin_shufflevector(*(const PG8_LAS i32x4*)(lds + PG8_SA(b, h) + aoff + m * 2048), *(const PG8_LAS i32x4*)(lds + PG8_SA(b, h) + aoff + m * 2048 + 1024), 0, 1, 2, 3, 4, 5, 6, 7); } \
    else { _Pragma("unroll") for (int m = 0; m < 4; ++m) _Pragma("unroll") for (int k = 0; k < 2; ++k) dst[m][k] = *(const PG8_LAS bf16x8*)(lds + PG8_SA(b, h) + aoff + m * 2048 + k * 1024); } } while (0)
#define PG8_LDB(dst, b, h) do { if constexpr (FP8) { _Pragma("unroll") for (int n = 0; n < 2; ++n) dst##8[n] = __builtin_shufflevector(*(const PG8_LAS i32x4*)(lds + PG8_SB(b, h) + boff + n * 2048), *(const PG8_LAS i32x4*)(lds + PG8_SB(b, h) + boff + n * 2048 + 1024), 0, 1, 2, 3, 4, 5, 6, 7); } \
    else { _Pragma("unroll") for (int n = 0; n < 2; ++n) _Pragma("unroll") for (int k = 0; k < 2; ++k) dst[n][k] = *(const PG8_LAS bf16x8*)(lds + PG8_SB(b, h) + boff + n * 2048 + k * 1024); } } while (0)
#define PG8_MMA(ai, bj, At, Bt) do { __builtin_amdgcn_s_setprio(1); \
    if constexpr (FP8) { _Pragma("unroll") for (int m = 0; m < 4; ++m) _Pragma("unroll") for (int n = 0; n < 2; ++n) \
        asm volatile("v_mfma_scale_f32_16x16x128_f8f6f4 %0, %1, %2, %0, %3, %3 op_sel_hi:[0,0,0]" : "+v"(acc[ai][bj][m][n]) : "v"(Bt##8[n]), "v"(At##8[m]), "v"(fp8_unit_scale)); } \
    else { _Pragma("unroll") for (int m = 0; m < 4; ++m) _Pragma("unroll") for (int n = 0; n < 2; ++n) _Pragma("unroll") for (int k = 0; k < 2; ++k) \
        acc[ai][bj][m][n] = __builtin_amdgcn_mfma_f32_16x16x32_bf16(Bt[n][k], At[m][k], acc[ai][bj][m][n], 0, 0, 0); } \
    __builtin_amdgcn_s_setprio(0); } while (0)
#define PG8_WAIT_V(n) asm volatile("s_waitcnt vmcnt(" #n ")" ::: "memory")
#define PG8_WAIT_L(n) asm volatile("s_waitcnt lgkmcnt(" #n ")" ::: "memory")
#define PG8_BAR __builtin_amdgcn_s_barrier()
#define PG8_SCHED __builtin_amdgcn_sched_barrier(0)
    Unit cur, nxt; int ui = 0;
    if (!S.next(0, cur)) return;
    f32x4 acc[2][2][4][2];
#pragma unroll
    for (int a = 0; a < 2; ++a)
#pragma unroll
        for (int b = 0; b < 2; ++b)
#pragma unroll
            for (int m = 0; m < 4; ++m)
#pragma unroll
                for (int n = 0; n < 2; ++n) acc[a][b][m][n] = (f32x4){0.f, 0.f, 0.f, 0.f};
    const int fp8_unit_scale = 0x7f7f7f7f;
    bf16x8 At[4][2], B0[2][2], B1[2][2]; i32x8 At8[4], B08[2], B18[2];
    const char* cA = (const char*)g.A + (size_t)cur.pm * tstep; const char* cB = (const char*)g.Bt + (size_t)cur.pn * tstep;
    S.a_ready(cur);
    if constexpr (SP2) {
        PG8_STAGE(PG8_SB(0, 0), cB, voffB); PG8_STAGE(PG8_SB(0, 1), cB + hstep, voffB); PG8_STAGE(PG8_SA(0, 0), cA, voffA); PG8_STAGE(PG8_SA(0, 1), cA + hstep, voffA);
        if (wr == 1) PG8_BAR;
        PG8_WAIT_V(2); PG8_BAR;
        PG8_STAGE(PG8_SB(1, 0), cB + kstep, voffB); PG8_STAGE(PG8_SA(1, 0), cA + kstep, voffA); PG8_STAGE(PG8_SB(1, 1), cB + hstep + kstep, voffB);
        PG8_WAIT_V(6); PG8_BAR;
    } else {
        PG8_STAGE(PG8_SB(0, 0), cB, voffB); PG8_STAGE(PG8_SA(0, 0), cA, voffA); PG8_STAGE(PG8_SB(0, 1), cB + hstep, voffB); PG8_STAGE(PG8_SA(0, 1), cA + hstep, voffA);
        if (wr == 1) PG8_BAR;
        PG8_WAIT_V(4); PG8_BAR;
        PG8_STAGE(PG8_SB(1, 0), cB + kstep, voffB); PG8_STAGE(PG8_SA(1, 0), cA + kstep, voffA); PG8_STAGE(PG8_SB(1, 1), cB + hstep + kstep, voffB);
        PG8_WAIT_V(6); PG8_BAR;
    }
    for (;;) {
        const bool has_next = S.next(ui + 1, nxt);
        const char* nA = has_next ? (const char*)g.A + (size_t)nxt.pm * tstep : cA; const char* nB = has_next ? (const char*)g.Bt + (size_t)nxt.pn * tstep : cB;
_Pragma("unroll 1")
        for (int t = 0; t < nt; t += 2) {
            const bool last = (t == nt - 2);
            const char* a1 = cA + (size_t)(t + 1) * kstep;
            const char* a2 = last ? nA : cA + (size_t)(t + 2) * kstep; const char* b2 = last ? nB : cB + (size_t)(t + 2) * kstep;
            const char* a3 = a2 + kstep; const char* b3 = b2 + kstep;
            if (last && has_next) S.a_ready(nxt);
            if constexpr (SP2) {
            PG8_LDB(B0, 0, 0); PG8_LDB(B1, 0, 1); PG8_SCHED; PG8_LDA(At, 0, 0); PG8_STAGE(PG8_SA(1, 1), a1 + hstep, voffA);
            PG8_WAIT_V(8); PG8_WAIT_L(0); PG8_BAR; PG8_MMA(0, 0, At, B0); PG8_MMA(0, 1, At, B1); PG8_BAR; PG8_SCHED;
            PG8_LDA(At, 0, 1); PG8_STAGE(PG8_SB(0, 0), b2, voffB); PG8_STAGE(PG8_SB(0, 1), b2 + hstep, voffB); PG8_STAGE(PG8_SA(0, 0), a2, voffA);
            PG8_WAIT_V(8); PG8_WAIT_L(0); PG8_BAR; if (!cur.half) { PG8_MMA(1, 0, At, B0); PG8_MMA(1, 1, At, B1); } PG8_BAR; PG8_SCHED;
            PG8_LDB(B0, 1, 0); PG8_LDB(B1, 1, 1); PG8_SCHED; PG8_LDA(At, 1, 0); PG8_STAGE(PG8_SA(0, 1), a2 + hstep, voffA);
            PG8_WAIT_V(8); PG8_WAIT_L(0); PG8_BAR; PG8_MMA(0, 0, At, B0); PG8_MMA(0, 1, At, B1); PG8_BAR; PG8_SCHED;
            PG8_LDA(At, 1, 1); PG8_STAGE(PG8_SB(1, 0), b3, voffB); PG8_STAGE(PG8_SB(1, 1), b3 + hstep, voffB); PG8_STAGE(PG8_SA(1, 0), a3, voffA);
            PG8_WAIT_V(8); PG8_WAIT_L(0); PG8_BAR; if (!cur.half) { PG8_MMA(1, 0, At, B0); PG8_MMA(1, 1, At, B1); } PG8_BAR; PG8_SCHED;
            } else {
            PG8_LDB(B0, 0, 0); PG8_SCHED; PG8_LDA(At, 0, 0); PG8_STAGE(PG8_SA(1, 1), a1 + hstep, voffA);
            PG8_WAIT_L(8); PG8_BAR; PG8_WAIT_L(0); PG8_MMA(0, 0, At, B0); PG8_BAR; PG8_SCHED;
            PG8_LDB(B1, 0, 1); PG8_STAGE(PG8_SB(0, 0), b2, voffB);
            PG8_BAR; PG8_WAIT_L(0); PG8_MMA(0, 1, At, B1); PG8_BAR;
            PG8_LDA(At, 0, 1); PG8_STAGE(PG8_SA(0, 0), a2, voffA);
            PG8_BAR; PG8_WAIT_L(0); PG8_MMA(1, 0, At, B0); PG8_BAR; PG8_SCHED;
            PG8_STAGE(PG8_SB(0, 1), b2 + hstep, voffB);
            PG8_WAIT_V(6); PG8_BAR; PG8_MMA(1, 1, At, B1); PG8_BAR;
            PG8_LDB(B0, 1, 0); PG8_SCHED; PG8_LDA(At, 1, 0); PG8_STAGE(PG8_SA(0, 1), a2 + hstep, voffA);
            PG8_WAIT_L(8); PG8_BAR; PG8_WAIT_L(0); PG8_MMA(0, 0, At, B0); PG8_BAR; PG8_SCHED;
            PG8_LDB(B1, 1, 1); PG8_STAGE(PG8_SB(1, 0), b3, voffB);
            PG8_BAR; PG8_WAIT_L(0); PG8_MMA(0, 1, At, B1); PG8_BAR;
            PG8_LDA(At, 1, 1); PG8_STAGE(PG8_SA(1, 0), a3, voffA);
            PG8_BAR; PG8_WAIT_L(0); PG8_MMA(1, 0, At, B0); PG8_BAR; PG8_SCHED;
            PG8_STAGE(PG8_SB(1, 1), b3 + hstep, voffB);
            PG8_WAIT_V(6); PG8_BAR; PG8_MMA(1, 1, At, B1); PG8_BAR;
            }
        }
        if constexpr (FP8) { asm volatile("s_nop 15\n\ts_nop 15" ::: "memory"); }
        if constexpr (ALIGN_EPI) { if (wr == 0) PG8_BAR; }
        if constexpr (!Epi::AFTER_DRAIN) { E(acc, cur, wr, wc, fr, fq); S.done(cur); }
        if (!has_next) break;
#pragma unroll
        for (int a = 0; a < 2; ++a)
#pragma unroll
            for (int b = 0; b < 2; ++b)
#pragma unroll
                for (int m = 0; m < 4; ++m)
#pragma unroll
                    for (int n = 0; n < 2; ++n) acc[a][b][m][n] = (f32x4){0.f, 0.f, 0.f, 0.f};
        cur = nxt; cA = nA; cB = nB; ++ui;
        if constexpr (ALIGN_EPI) { if (wr == 1) PG8_BAR; }
    }
    PG8_WAIT_V(0);
    if constexpr (!ALIGN_EPI) { if (wr == 0) PG8_BAR; }
    PG8_BAR;
    if constexpr (Epi::AFTER_DRAIN) { E.fused(acc, cur, wr, wc, fr, fq, lds, wid, lane); S.done(cur); }
#undef PG8_SA
#undef PG8_SB
#undef PG8_STAGE
#undef PG8_LDA
#undef PG8_LDB
#undef PG8_MMA
#undef PG8_WAIT_V
#undef PG8_WAIT_L
#undef PG8_BAR
#undef PG8_SCHED
}
}
constexpr int NB = 4, SEQ = 4096, D = 1024, CTXL = 256, DEPTH = 2, GRIDW = 64, NROWS = 64;
constexpr int MX = NB * SEQ, MC = NB * CTXL, MT = MX + MC;
constexpr int NIN = 2560, NE = 16, FH = 2816, CAPX = 512, CAPC = 32, NMOD = 6;
constexpr int EROWS = 2304;
constexpr int ETILES = EROWS / 256, FNT = FH / 128;
constexpr int PQ = 0, PK = 512, PV = 1024, PBG = 1536, PCG = 1792, PU = 2048, PF = 2304;
constexpr float RMS_EPS = 1e-6f;
constexpr float S_ACT = 16.f, S_WGU = 256.f, S_HID = 4.f, S_WDN = 256.f, S_Y = 16.f, S_WOUT = 256.f;
#ifndef WOUT_FP8
#define WOUT_FP8 0
#endif
constexpr int NWAVES = 8;

constexpr size_t MiB = 1u << 20;
constexpr size_t WS_CTL = 0, CTL_ZERO_BYTES = 1 * MiB;
constexpr size_t WS_MODX = 64 * 1024;
constexpr size_t WS_WINT = 2 * MiB;
constexpr size_t WS_WOUTT = 12 * MiB;
constexpr size_t WS_WGUT = 16 * MiB;
constexpr size_t WS_WDT = 368 * MiB;
constexpr size_t WS_H = 544 * MiB;
constexpr size_t WS_P = 578 * MiB;
constexpr size_t WS_NA = 663 * MiB;
constexpr size_t WS_FO = 680 * MiB;
constexpr size_t WS_TT = 697 * MiB;
constexpr size_t WS_GC = 729 * MiB;
constexpr size_t WS_Y = 731 * MiB;
constexpr size_t WS_MO = 765 * MiB;
constexpr size_t WS_HID = 578 * MiB;
constexpr size_t WS_X1 = 833 * MiB;
constexpr size_t WS_X2 = 901 * MiB;
constexpr size_t WS_H2 = 969 * MiB;
constexpr size_t WS_AFF = 1003 * MiB;
constexpr size_t WS_SLOT = 1005 * MiB;
constexpr size_t WS_XS = 1007 * MiB;
constexpr size_t WS_YE = 1079 * MiB;
constexpr size_t WS_END = 1151 * MiB;
static_assert(WS_HID + (size_t)NE * EROWS * FH * 2 <= WS_X1, "HID overlay");
static_assert(WS_MODX + (size_t)DEPTH * 5 * NMOD * D * 4 <= CTL_ZERO_BYTES, "MODX inside memset region");
constexpr int CW_BAR = 4096;

constexpr int RING_OFF = 0, RING_BYTES = 131072;
constexpr int LDSCTL_OFF = RING_BYTES, MISC_OFF = LDSCTL_OFF + 320;
constexpr int TW64_OFF = LDSCTL_OFF + 512, TW256_OFF = LDSCTL_OFF + 1024, TW4K_OFF = LDSCTL_OFF + 3072;
constexpr int CT_OFF = LDSCTL_OFF + 4096, ST_OFF = LDSCTL_OFF + 12288;
constexpr int RPB_OFF = LDSCTL_OFF + 20480;
constexpr int LDS_BYTES = LDSCTL_OFF + 20480 + 7680;
#define GAS __attribute__((address_space(1)))
#define LAS __attribute__((address_space(3)))
typedef unsigned short bf16;
typedef unsigned v4u __attribute__((ext_vector_type(4)));
typedef float f32x4 __attribute__((ext_vector_type(4)));
typedef short bf16x8 __attribute__((ext_vector_type(8)));
typedef GAS unsigned gu32;
typedef GAS unsigned long long gu64;
#define RLX_AGENT __ATOMIC_RELAXED, __HIP_MEMORY_SCOPE_AGENT
#define LDS_WAIT() asm volatile("s_waitcnt lgkmcnt(0)" ::: "memory")
#define VM_WAIT() asm volatile("s_waitcnt vmcnt(0)" ::: "memory")
__device__ __forceinline__ unsigned long long rt() { return __builtin_amdgcn_s_memrealtime(); }
__device__ __forceinline__ unsigned f2bf(float f) { unsigned u = __builtin_bit_cast(unsigned, f); return (u + 0x7fffu + ((u >> 16) & 1u)) >> 16; }
__device__ __forceinline__ unsigned pk2(float lo, float hi) { return f2bf(lo) | (f2bf(hi) << 16); }

#define XB_TMO      128
#define XB_XCNT(j)  (256  + 64 * (j))
#define XB_XSUB(j)  (1280 + 64 * (j))
#define XB_XGEN(j)  (2304 + 64 * (j))
#define XB_TOP      3328
#define XB_TOPGEN   3392
#define XCD_BAR_WORDS 3456
#define XB_SPIN_CAP (1u << 18)

__device__ __forceinline__ unsigned xb_ld(unsigned* p)              { return __hip_atomic_load(p, __ATOMIC_RELAXED, __HIP_MEMORY_SCOPE_AGENT); }
__device__ __forceinline__ unsigned xb_add(unsigned* p, unsigned v) { return __hip_atomic_fetch_add(p, v, __ATOMIC_RELAXED, __HIP_MEMORY_SCOPE_AGENT); }
__device__ __forceinline__ unsigned xb_xcc_id() { return (unsigned)__builtin_amdgcn_s_getreg((3 << 11) | 20) & 0xFu; }
#define XB_SPIN(cond, bar) do { unsigned _sp = 0; while (cond) { __builtin_amdgcn_s_sleep(1); \
    if ((++_sp & 255u) == 0u) { if (xb_ld(&(bar)[XB_TMO])) break; if (_sp > XB_SPIN_CAP) { atomicAdd(&(bar)[XB_TMO], 1u); break; } } } } while (0)

struct XcdBarrier {
    unsigned* bar; unsigned x;
    volatile LAS unsigned* st;
};

__device__ __forceinline__ XcdBarrier xcd_barrier_post(unsigned* bar, volatile LAS unsigned* st) {
    XcdBarrier b; b.bar = bar; b.x = xb_xcc_id(); b.st = st;
    if (threadIdx.x == 0) (void)xb_add(&bar[XB_XCNT(b.x)], 1u);
    return b;
}
__device__ __forceinline__ void xcd_barrier_complete(unsigned* bar, unsigned x, unsigned& nloc, unsigned& nx) {
    const unsigned G = gridDim.x * gridDim.y * gridDim.z;
    unsigned sum, cnt, mine, sp = 0u;
    for (;;) {
        sum = 0u; cnt = 0u; mine = 0u;
#pragma unroll
        for (unsigned j = 0; j < 16; ++j) { const unsigned c = xb_ld(&bar[XB_XCNT(j)]); sum += c; cnt += (c > 0u) ? 1u : 0u; mine = (j == x) ? c : mine; }
        if (sum == G) break;
        __builtin_amdgcn_s_sleep(1);
        if ((++sp & 255u) == 0u) { if (xb_ld(&bar[XB_TMO])) break; if (sp > XB_SPIN_CAP) { atomicAdd(&bar[XB_TMO], 1u); break; } }
    }
    nloc = mine > 0u ? mine : 1u; nx = cnt > 0u ? cnt : 1u;
}

__device__ __forceinline__ void xcd_barrier(const XcdBarrier& b) {
    asm volatile("s_waitcnt vmcnt(0)" ::: "memory");
    __syncthreads();
    if (threadIdx.x == 0) {
        unsigned* bar = b.bar;
        __builtin_amdgcn_s_waitcnt(0);
        unsigned nloc = b.st[0], nx = b.st[1];
        if (nloc == 0u) { xcd_barrier_complete(bar, b.x, nloc, nx); b.st[0] = nloc; b.st[1] = nx; }
        const unsigned old = xb_add(&bar[XB_XSUB(b.x)], 1u);
        const unsigned gen = old / nloc;
        if (old + 1u == (gen + 1u) * nloc) {
            __builtin_amdgcn_fence(__ATOMIC_RELEASE, "agent");
            asm volatile("s_waitcnt vmcnt(0)" ::: "memory");
            const unsigned og = xb_add(&bar[XB_TOP], 1u);
            const unsigned tg = og / nx;
            if (og + 1u == (tg + 1u) * nx) xb_add(&bar[XB_TOPGEN], 1u);
            else XB_SPIN(xb_ld(&bar[XB_TOPGEN]) == tg, bar);
            __builtin_amdgcn_fence(__ATOMIC_ACQUIRE, "agent");
            xb_add(&bar[XB_XGEN(b.x)], 1u);
            asm volatile("s_waitcnt vmcnt(0)" ::: "memory");
        } else {
            XB_SPIN(xb_ld(&bar[XB_XGEN(b.x)]) == gen, bar);
            __builtin_amdgcn_fence(__ATOMIC_ACQUIRE, "agent");
            asm volatile("s_waitcnt vmcnt(0)" ::: "memory");
        }
    }
    __syncthreads();
}
typedef LAS float lfloat;
typedef float f32x2 __attribute__((ext_vector_type(2)));
typedef unsigned u32x2 __attribute__((ext_vector_type(2)));
__device__ __forceinline__ float bflo(unsigned w) { return __uint_as_float(w << 16); }
__device__ __forceinline__ float bfhi(unsigned w) { return __uint_as_float(w & 0xffff0000u); }
__device__ __forceinline__ float bf2f(bf16 h) { return __uint_as_float((unsigned)h << 16); }
template <int CTRL> __device__ __forceinline__ float dppf(float v) { return __builtin_bit_cast(float, __builtin_amdgcn_update_dpp(0, __builtin_bit_cast(int, v), CTRL, 0xf, 0xf, true)); }
__device__ __forceinline__ float wave_sum(float v) {
    v += dppf<0xB1>(v); v += dppf<0x4E>(v); v += dppf<0x141>(v); v += dppf<0x140>(v);
    const float r0 = __builtin_bit_cast(float, __builtin_amdgcn_readlane(__builtin_bit_cast(int, v), 0)), r1 = __builtin_bit_cast(float, __builtin_amdgcn_readlane(__builtin_bit_cast(int, v), 16));
    const float r2 = __builtin_bit_cast(float, __builtin_amdgcn_readlane(__builtin_bit_cast(int, v), 32)), r3 = __builtin_bit_cast(float, __builtin_amdgcn_readlane(__builtin_bit_cast(int, v), 48));
    return (r0 + r1) + (r2 + r3);
}
__device__ __forceinline__ float wave_max(float v) {
#pragma unroll
    for (int o = 1; o < 64; o <<= 1) v = fmaxf(v, __shfl_xor(v, o));
    return v;
}
__device__ __forceinline__ float silu(float x) { return x / (1.0f + __expf(-x)); }

struct Ctx {
    unsigned char* ws; LAS unsigned char* lds;
    int tid, lane, wave, G, gw, NGW;
};
#define IN_X 0
#define IN_C 1
#define IN_CTX 2
#define IN_CCTX 3
#define IN_WMOD 4
#define IN_BMOD 5
#define IN_GPREMIX 6
#define IN_GPOSTMIX 7
#define IN_GPREFFN 8
#define IN_GPOSTFFN 9
#define IN_WIN 10
#define IN_RPB 11
#define IN_CONVW 12
#define IN_GMIXOUT 13
#define IN_WOUT 14
#define IN_WROUTER 15
#define IN_WGATE 16
#define IN_WUP 17
#define IN_WDOWN 18

__device__ __forceinline__ int mod_row(int row) { return row < MX ? (row >> 12) : 4; }
__device__ __forceinline__ const float* modx(const Ctx& C, int layer, int mr, int which) { return (const float*)(C.ws + WS_MODX) + ((size_t)(layer * 5 + mr) * NMOD + which) * D; }

__device__ __forceinline__ void transpose_item(const float* W, int K, int N, bf16* WT, int item, int mode, lfloat* scr, int lane) {
    const int nblk = N / 32, kb = item / nblk, nb = item % nblk, k0 = 64 * kb, n0 = 32 * nb;
#pragma unroll 8
    for (int i = 0; i < 32; ++i) { const int kk = 2 * i + (lane >> 5); scr[kk * 33 + (lane & 31)] = W[(size_t)(k0 + kk) * N + n0 + (lane & 31)]; }
    LDS_WAIT(); asm volatile("" ::: "memory");
    const int rowbase = mode == 0 ? n0 : ((n0 >> 7) * 256 + (n0 & 127) + (mode == 2 ? 128 : 0));
    const int c = lane & 7;
#pragma unroll
    for (int j = 0; j < 4; ++j) { const int n = (lane >> 3) + 8 * j; const lfloat* s = scr + (8 * c) * 33 + n;
        v4u o; o.x = pk2(s[0 * 33], s[1 * 33]); o.y = pk2(s[2 * 33], s[3 * 33]); o.z = pk2(s[4 * 33], s[5 * 33]); o.w = pk2(s[6 * 33], s[7 * 33]);
        *(GAS v4u*)(WT + (size_t)(rowbase + n) * K + k0 + 8 * c) = o; }
    LDS_WAIT(); asm volatile("" ::: "memory");
}
__device__ __forceinline__ void transpose_item8(const float* W, int K, int N, unsigned char* WT, int item, int mode, float scale, lfloat* scr, int lane) {
    const int nblk = N / 32, kb = item / nblk, nb = item % nblk, k0 = 128 * kb, n0 = 32 * nb;
    const int rowbase = mode == 0 ? n0 : ((n0 >> 7) * 256 + (n0 & 127) + (mode == 2 ? 128 : 0));
    const int c = lane & 3;
    v4u o[2][2];
#pragma unroll
    for (int hf = 0; hf < 2; ++hf) {
#pragma unroll 8
        for (int i = 0; i < 32; ++i) { const int kk = 2 * i + (lane >> 5); scr[kk * 33 + (lane & 31)] = W[(size_t)(k0 + 64 * hf + kk) * N + n0 + (lane & 31)] * scale; }
        LDS_WAIT(); asm volatile("" ::: "memory");
#pragma unroll
        for (int j = 0; j < 2; ++j) { const int n = (lane >> 2) + 16 * j; const lfloat* s = scr + (16 * c) * 33 + n;
            o[hf][j].x = pg8::pk4_fp8(s[0 * 33], s[1 * 33], s[2 * 33], s[3 * 33]); o[hf][j].y = pg8::pk4_fp8(s[4 * 33], s[5 * 33], s[6 * 33], s[7 * 33]);
            o[hf][j].z = pg8::pk4_fp8(s[8 * 33], s[9 * 33], s[10 * 33], s[11 * 33]); o[hf][j].w = pg8::pk4_fp8(s[12 * 33], s[13 * 33], s[14 * 33], s[15 * 33]); }
        LDS_WAIT(); asm volatile("" ::: "memory");
    }
#pragma unroll
    for (int j = 0; j < 2; ++j) { const int n = (lane >> 2) + 16 * j; unsigned char* dst = WT + (size_t)(rowbase + n) * K + k0 + 16 * c;
        *(GAS v4u*)dst = o[0][j]; *(GAS v4u*)(dst + 64) = o[1][j]; }
}
struct ExpItem { const float* src; unsigned char* dst; int N, K, mode; float scale; };
constexpr int IT_EXP = (D / 128) * (FH / 32);
static_assert((FH / 128) * (D / 32) == IT_EXP, "item counts");
constexpr int N_EXP_L = 3 * NE * IT_EXP;
__device__ __forceinline__ ExpItem exp_item(const float* const (&in)[19], unsigned char* ws, int it) {
    const int l = it / N_EXP_L, r = it % N_EXP_L, mat = r / (NE * IT_EXP), le = l * NE + (r / IT_EXP) % NE, item = r % IT_EXP;
    ExpItem e;
    if (mat < 2) { const int nblk = FH / 32, kb = item / nblk, nb = item % nblk, k0 = 128 * kb, n0 = 32 * nb;
        e.N = FH; e.K = D; e.scale = S_WGU; e.src = in[mat == 0 ? IN_WGATE : IN_WUP] + (size_t)le * D * FH + (size_t)k0 * FH + n0;
        const int rowbase = (n0 >> 7) * 256 + (n0 & 127) + (mat == 1 ? 128 : 0);
        e.dst = ws + WS_WGUT + (size_t)le * 2 * FH * D + (size_t)rowbase * D + k0; }
    else { const int nblk = D / 32, kb = item / nblk, nb = item % nblk, k0 = 128 * kb, n0 = 32 * nb;
        e.N = D; e.K = FH; e.scale = S_WDN; e.src = in[IN_WDOWN] + (size_t)le * FH * D + (size_t)k0 * D + n0;
        e.dst = ws + WS_WDT + (size_t)le * D * FH + (size_t)n0 * FH + k0; }
    e.mode = 0;
    return e;
}
#ifndef CFG_NI
#define CFG_NI 4, 4, 2, 3
#endif
constexpr int NI_CFG[4] = {CFG_NI};
constexpr int NI_INPROJ = NI_CFG[0], NI_WOUT0 = NI_CFG[1], NI_GU0 = NI_CFG[2], NI_DN0 = NI_CFG[3];
__device__ __forceinline__ int tail_idle(int nwg, int G) { const int rem = nwg % G; return rem == 0 ? 0 : G - rem; }
#ifndef CFG_NATT
#define CFG_NATT 2
#endif
constexpr int NI_ATT = CFG_NATT;
struct Defer { int inproj, wout0, gu0, dn0, att; };
__device__ __forceinline__ Defer defer_counts(int G) {
    Defer d; d.att = (G > 32 ? G - 32 : 0) * NWAVES * NI_ATT; if (G & 7) { d.inproj = d.wout0 = d.gu0 = d.dn0 = 0; return d; }
    d.inproj = tail_idle((MT / 256) * (NIN / 256), G) * NWAVES * NI_INPROJ; d.wout0 = tail_idle((MT / 256) * (D / 256), G) * NWAVES * NI_WOUT0;
    d.gu0 = tail_idle(NE * ETILES * FNT, G) * NWAVES * NI_GU0; d.dn0 = tail_idle(NE * ETILES * (D / 256), G) * NWAVES * NI_DN0; return d;
}
__device__ __forceinline__ void exp_issue(f32x4 (&r)[8], const float* src, int N, int lane) {
    const int lofs = (lane >> 3) * N + (lane & 7) * 4;
#pragma unroll
    for (int i = 0; i < 8; ++i) { const float* rowp = src + (size_t)(8 * i) * N; r[i] = __builtin_nontemporal_load((const f32x4*)(rowp + lofs)); }
}
__device__ __forceinline__ void exp_half(const f32x4 (&r)[8], float scale, lfloat* scr, int lane, v4u (&o)[2]) {
#pragma unroll
    for (int i = 0; i < 8; ++i) { lfloat* d = scr + (8 * i + (lane >> 3)) * 33 + (lane & 7) * 4; const f32x4 v = r[i] * scale; d[0] = v.x; d[1] = v.y; d[2] = v.z; d[3] = v.w; }
    LDS_WAIT(); asm volatile("" ::: "memory");
    const int c = lane & 3;
#pragma unroll
    for (int j = 0; j < 2; ++j) { const int n = (lane >> 2) + 16 * j; const lfloat* s = scr + (16 * c) * 33 + n;
        o[j].x = pg8::pk4_fp8(s[0 * 33], s[1 * 33], s[2 * 33], s[3 * 33]); o[j].y = pg8::pk4_fp8(s[4 * 33], s[5 * 33], s[6 * 33], s[7 * 33]);
        o[j].z = pg8::pk4_fp8(s[8 * 33], s[9 * 33], s[10 * 33], s[11 * 33]); o[j].w = pg8::pk4_fp8(s[12 * 33], s[13 * 33], s[14 * 33], s[15 * 33]); }
    LDS_WAIT(); asm volatile("" ::: "memory");
}
__device__ __forceinline__ void p0_expert_stream(const Ctx& C, const float* const (&in)[19], int it0, int it_end, int stride) {
    lfloat* scr = (lfloat*)(C.lds + RING_OFF + C.wave * 16384);
    const int lane = C.lane;
    int it = it0; f32x4 ra[8], rb[8];
    if (it >= it_end) return;
    ExpItem e = exp_item(in, C.ws, it);
    exp_issue(ra, e.src, e.N, lane);
    while (it < it_end) {
        exp_issue(rb, e.src + (size_t)64 * e.N, e.N, lane);
        v4u o0[2], o1[2];
        exp_half(ra, e.scale, scr, lane, o0);
        const int nit = it + stride;
        const ExpItem ne = exp_item(in, C.ws, nit < it_end ? nit : it);
        exp_issue(ra, ne.src, ne.N, lane);
        exp_half(rb, e.scale, scr, lane, o1);
#pragma unroll
        for (int j = 0; j < 2; ++j) { const int n = (lane >> 2) + 16 * j; unsigned char* dst = e.dst + (size_t)n * e.K + 16 * (lane & 3);
            *(GAS v4u*)dst = o0[j]; *(GAS v4u*)(dst + 64) = o1[j]; }
        e = ne; it = nit;
    }
}
constexpr int IT_WIN = (D / 64) * (NIN / 32), IT_WOUT = (D / 64) * (D / 32), IT_GU = (D / 128) * (FH / 32), IT_DN = (FH / 128) * (D / 32);
constexpr int N_T_ITEMS = DEPTH * IT_WIN + DEPTH * IT_WOUT;
__device__ __forceinline__ void p0_prologue(const Ctx& C, const float* const (&in)[19]) {
    {
        lfloat* part = (lfloat*)(C.lds + RING_OFF);
        lfloat* sil = (lfloat*)(C.lds + RING_OFF + 16384);
        if ((int)blockIdx.x < DEPTH * (NMOD * D / 64)) {
            for (int u = C.tid; u < 5 * D; u += NWAVES * 64) sil[u] = silu(u < 4 * D ? in[IN_C][u] : in[IN_CCTX][u - 4 * D]);
        }
        __syncthreads();
        for (int it = blockIdx.x; it < DEPTH * (NMOD * D / 64); it += C.G) {
            const int l = it / (NMOD * D / 64), cb = it % (NMOD * D / 64), col = cb * 64 + C.lane;
            const float* wm = in[IN_WMOD] + (size_t)l * D * NMOD * D + col;
            float acc[5] = {0.f, 0.f, 0.f, 0.f, 0.f};
#pragma unroll 16
            for (int k = C.wave * 128; k < C.wave * 128 + 128; ++k) {
                const float wv = __builtin_nontemporal_load(wm + (size_t)k * (NMOD * D));
#pragma unroll
                for (int r = 0; r < 5; ++r) acc[r] += sil[r * D + k] * wv;
            }
#pragma unroll
            for (int r = 0; r < 5; ++r) part[(C.wave * 5 + r) * 64 + C.lane] = acc[r];
            __syncthreads();
            if (C.wave < 5) { const int r = C.wave; float sum = in[IN_BMOD][l * NMOD * D + col];
#pragma unroll
                for (int w = 0; w < 8; ++w) sum += part[(w * 5 + r) * 64 + C.lane];
                ((float*)(C.ws + WS_MODX))[(size_t)(l * 5 + r) * NMOD * D + col] = sum; }
            __syncthreads();
        }
    }
    lfloat* scr = (lfloat*)(C.lds + RING_OFF + C.wave * 16384);
    bf16* WINT = (bf16*)(C.ws + WS_WINT); bf16* WOUTT = (bf16*)(C.ws + WS_WOUTT);
    for (int it = C.gw; it < N_T_ITEMS; it += C.NGW) {
        int r = it;
        if (r < DEPTH * IT_WIN) { const int l = r / IT_WIN; transpose_item(in[IN_WIN] + (size_t)l * D * NIN, D, NIN, WINT + (size_t)l * NIN * D, r % IT_WIN, 0, scr, C.lane); continue; } r -= DEPTH * IT_WIN;
#if WOUT_FP8
        { if (r < DEPTH * (D / 128) * (D / 32)) { const int l = r / ((D / 128) * (D / 32)), item = r % ((D / 128) * (D / 32)), kb = item / (D / 32), nb = item % (D / 32);
              const float* src = in[IN_WOUT] + (size_t)l * D * D + (size_t)(128 * kb) * D + 32 * nb; unsigned char* dst = C.ws + WS_WOUTT + (size_t)l * D * D + (size_t)(32 * nb) * D + 128 * kb;
              f32x4 ra[8]; v4u o0[2], o1[2];
              exp_issue(ra, src, D, C.lane); exp_half(ra, S_WOUT, scr, C.lane, o0); exp_issue(ra, src + (size_t)64 * D, D, C.lane); exp_half(ra, S_WOUT, scr, C.lane, o1);
#pragma unroll
              for (int j = 0; j < 2; ++j) { const int n = (C.lane >> 2) + 16 * j; unsigned char* dp = dst + (size_t)n * D + 16 * (C.lane & 3); *(GAS v4u*)dp = o0[j]; *(GAS v4u*)(dp + 64) = o1[j]; } } }
#else
        { const int l = r / IT_WOUT; transpose_item(in[IN_WOUT] + (size_t)l * D * D, D, D, WOUTT + (size_t)l * D * D, r % IT_WOUT, 0, scr, C.lane); }
#endif
    }
    { const Defer d = defer_counts(C.G);
      p0_expert_stream(C, in, C.gw, N_EXP_L - (d.inproj + d.wout0 + d.att), C.NGW);
      p0_expert_stream(C, in, N_EXP_L + C.gw, 2 * N_EXP_L - (d.gu0 + d.dn0 + d.inproj), C.NGW); }
}

__device__ __forceinline__ void norm_mod_store(const f32x4 (&v)[4], float ss, const float* g, const float* sh, const float* sc, bf16* orow, int lane) {
    const float rstd = 1.0f / sqrtf(ss * (1.f / D) + RMS_EPS);
#pragma unroll
    for (int j = 0; j < 4; ++j) {
        const f32x4 gg = ((const f32x4*)g)[lane + 64 * j], hh = ((const f32x4*)sh)[lane + 64 * j], cc = ((const f32x4*)sc)[lane + 64 * j];
        const f32x4 o = (v[j] * rstd * gg) * (cc + 1.0f) + hh;
        u32x2 w; w.x = pk2(o.x, o.y); w.y = pk2(o.z, o.w);
        ((u32x2*)orow)[lane + 64 * j] = w;
    }
}
__device__ __forceinline__ void stage_vec4(LAS float* dst, const float* src, int n4, int tid) { for (int i = tid; i < n4; i += NWAVES * 64) ((LAS f32x4*)dst)[i] = ((const f32x4*)src)[i]; }
__device__ __forceinline__ float sumsq4(const f32x4 (&v)[4]) { float ss = 0.f;
#pragma unroll
    for (int j = 0; j < 4; ++j) ss += (v[j].x * v[j].x + v[j].y * v[j].y) + (v[j].z * v[j].z + v[j].w * v[j].w);
    return ss; }
__device__ __forceinline__ void norm_mod_store_lds(const f32x4 (&v)[4], float ss, const LAS float* g, const LAS float* sh, const LAS float* sc, bf16* orow, int lane) {
    const float rstd = 1.0f / sqrtf(ss * (1.f / D) + RMS_EPS);
#pragma unroll
    for (int j = 0; j < 4; ++j) {
        const f32x4 gg = ((const LAS f32x4*)g)[lane + 64 * j], hh = ((const LAS f32x4*)sh)[lane + 64 * j], cc = ((const LAS f32x4*)sc)[lane + 64 * j];
        const f32x4 o = (v[j] * rstd * gg) * (cc + 1.0f) + hh;
        u32x2 w; w.x = pk2(o.x, o.y); w.y = pk2(o.z, o.w);
        ((u32x2*)orow)[lane + 64 * j] = w;
    }
}
__device__ __forceinline__ void p1_h0(const Ctx& C, const float* const (&in)[19]) {
    bf16* H = (bf16*)(C.ws + WS_H);
    LAS float* LG = (LAS float*)(C.lds + RING_OFF); LAS float* LM = LG + D;
    stage_vec4(LG, in[IN_GPREMIX], D / 4, C.tid);
    for (int r = 0; r < 5; ++r) stage_vec4(LM + r * 2 * D, modx(C, 0, r, 0), 2 * D / 4, C.tid);
    __syncthreads();
    const int lane = C.lane;
    int row = C.gw; f32x4 v[4], nv[4];
    if (row < MT) { const float* xr = row < MX ? in[IN_X] + (size_t)row * D : in[IN_CTX] + (size_t)(row - MX) * D;
#pragma unroll
        for (int j = 0; j < 4; ++j) v[j] = __builtin_nontemporal_load((const f32x4*)xr + lane + 64 * j); }
    while (row < MT) {
        const int nrow = row + C.NGW;
        { const int prow = nrow < MT ? nrow : MT - 1;
          const float* xr = prow < MX ? in[IN_X] + (size_t)prow * D : in[IN_CTX] + (size_t)(prow - MX) * D;
#pragma unroll
          for (int j = 0; j < 4; ++j) nv[j] = __builtin_nontemporal_load((const f32x4*)xr + lane + 64 * j); }
        const float ss = wave_sum(sumsq4(v)); const int mr = mod_row(row);
        norm_mod_store_lds(v, ss, LG, LM + mr * 2 * D, LM + mr * 2 * D + D, H + (size_t)row * D, lane);
#pragma unroll
        for (int j = 0; j < 4; ++j) v[j] = nv[j];
        row = nrow;
    }
}

__device__ __forceinline__ void tail_convert(const Ctx& C, const float* const (&in)[19], int nwg, int base, int ni) {
    const int G = C.G, rem = nwg % G; if (rem == 0 || (G & 7)) return;
    const int c = (int)blockIdx.x, v = (c & 7) * (G >> 3) + (c >> 3);
    if (v < rem) return;
    const int nidle = G - rem, widx = (v - rem) * NWAVES + C.wave;
    p0_expert_stream(C, in, base + widx, base + nidle * NWAVES * ni, nidle * NWAVES);
}
__device__ __forceinline__ float dot64(const float (&q)[64], const bf16* krow) {
    const v4u* p = (const v4u*)krow; float a = 0.f;
#pragma unroll
    for (int t = 0; t < 8; ++t) { const v4u w = p[t];
        a += q[8 * t + 0] * bflo(w.x) + q[8 * t + 1] * bfhi(w.x) + q[8 * t + 2] * bflo(w.y) + q[8 * t + 3] * bfhi(w.y)
           + q[8 * t + 4] * bflo(w.z) + q[8 * t + 5] * bfhi(w.z) + q[8 * t + 6] * bflo(w.w) + q[8 * t + 7] * bfhi(w.w); }
    return a;
}
__device__ __forceinline__ void axpy64(float (&o)[64], float p, const bf16* vrow) {
    const v4u* pp = (const v4u*)vrow;
#pragma unroll
    for (int t = 0; t < 8; ++t) { const v4u w = pp[t];
        o[8 * t + 0] += p * bflo(w.x); o[8 * t + 1] += p * bfhi(w.x); o[8 * t + 2] += p * bflo(w.y); o[8 * t + 3] += p * bfhi(w.y);
        o[8 * t + 4] += p * bflo(w.z); o[8 * t + 5] += p * bfhi(w.z); o[8 * t + 6] += p * bflo(w.w); o[8 * t + 7] += p * bfhi(w.w); }
}
__device__ __forceinline__ void attn_key(const float (&q)[64], float (&o)[64], float& m, float& l, float bias, const bf16* P, int key, int head) {
    const float s = dot64(q, P + (size_t)key * NIN + PK + head * 64) + bias;
    if (s > m) { const float alpha = __expf(m - s); l *= alpha;
#pragma unroll
        for (int d = 0; d < 64; ++d) o[d] *= alpha;
        m = s; }
    const float p = __expf(s - m); l += p;
    axpy64(o, p, P + (size_t)key * NIN + PV + head * 64);
}
__device__ __forceinline__ void p_attn_naive(const Ctx& C, const float* const (&in)[19], int layer) {
    const bf16* P = (const bf16*)(C.ws + WS_P); bf16* NA = (bf16*)(C.ws + WS_NA);
    const float* rpb = in[IN_RPB] + (size_t)layer * 8 * 15 * 31;
    const int nitems = layer == 0 ? 2048 + 128 : 2048;
    for (int id = C.gw; id < nitems; id += C.NGW) {
        const bool isctx = id >= 2048;
        int b, h, r = 0, c = 0, qrow;
        if (!isctx) { b = id >> 9; r = (id >> 3) & 63; h = id & 7; c = C.lane; qrow = b * SEQ + r * 64 + c; }
        else { const int j = id - 2048; b = j >> 5; h = (j >> 2) & 7; qrow = MX + b * CTXL + (j & 3) * 64 + C.lane; }
        float q[64], o[64];
        { const v4u* p = (const v4u*)(P + (size_t)qrow * NIN + PQ + h * 64);
#pragma unroll
          for (int t = 0; t < 8; ++t) { const v4u w = p[t];
              q[8 * t + 0] = 0.125f * bflo(w.x); q[8 * t + 1] = 0.125f * bfhi(w.x); q[8 * t + 2] = 0.125f * bflo(w.y); q[8 * t + 3] = 0.125f * bfhi(w.y);
              q[8 * t + 4] = 0.125f * bflo(w.z); q[8 * t + 5] = 0.125f * bfhi(w.z); q[8 * t + 6] = 0.125f * bflo(w.w); q[8 * t + 7] = 0.125f * bfhi(w.w); } }
#pragma unroll
        for (int d = 0; d < 64; ++d) o[d] = 0.f;
        float m = -1e30f, l = 0.f;
        if (!isctx) {
            const int rs = min(max(r - 4, 0), NROWS - 8), cs = min(max(c - 8, 0), GRIDW - 16);
            for (int kr = 0; kr < 8; ++kr) {
                const float* bp = rpb + (size_t)h * 465 + (rs + kr - r + 7) * 31 + 15;
#pragma unroll 1
                for (int i = 0; i < 16; ++i) { const int dc = min(max(cs + i - c, -15), 15); attn_key(q, o, m, l, bp[dc], P, b * SEQ + (rs + kr) * 64 + cs + i, h); }
            }
        }
#pragma unroll 1
        for (int j = 0; j < CTXL; ++j) attn_key(q, o, m, l, 0.f, P, MX + b * CTXL + j, h);
        const float inv = 1.0f / l;
        v4u* op = (v4u*)(NA + (size_t)qrow * 512 + h * 64);
#pragma unroll
        for (int t = 0; t < 8; ++t) { v4u w; w.x = pk2(o[8 * t] * inv, o[8 * t + 1] * inv); w.y = pk2(o[8 * t + 2] * inv, o[8 * t + 3] * inv);
            w.z = pk2(o[8 * t + 4] * inv, o[8 * t + 5] * inv); w.w = pk2(o[8 * t + 6] * inv, o[8 * t + 7] * inv); op[t] = w; }
    }
}

typedef short v4i16_t __attribute__((ext_vector_type(4)));
__device__ __forceinline__ bf16x8 pack8(const f32x4& a, const f32x4& b) {
    v4u w; w.x = pk2(a[0], a[1]); w.y = pk2(a[2], a[3]); w.z = pk2(b[0], b[1]); w.w = pk2(b[2], b[3]); return __builtin_bit_cast(bf16x8, w);
}
__device__ __forceinline__ bf16x8 neg8(const bf16x8& a) { v4u w = __builtin_bit_cast(v4u, a); w.x ^= 0x80008000u; w.y ^= 0x80008000u; w.z ^= 0x80008000u; w.w ^= 0x80008000u; return __builtin_bit_cast(bf16x8, w); }
#define MFMA16(a, b, c) __builtin_amdgcn_mfma_f32_16x16x32_bf16((a), (b), (c), 0, 0, 0)
constexpr float LOG2E = 1.4426950408889634f;
struct AttnStage { v4u k[5], v[5]; };
__device__ __forceinline__ void attn_issue(AttnStage& R, const bf16* src, unsigned lofs) {
#pragma unroll
    for (int i = 0; i < 5; ++i) { const char* bi = (const char*)src + (size_t)i * (8 * NIN * 2);
        R.k[i] = *(const v4u*)(bi + lofs); R.v[i] = *(const v4u*)(bi + (PV - PK) * 2 + lofs); }
}
__device__ __forceinline__ void attn_commit(const AttnStage& R, LAS unsigned char* kdst) {
#pragma unroll
    for (int i = 0; i < 5; ++i) { *(LAS v4u*)(kdst + i * 1024) = R.k[i]; *(LAS v4u*)(kdst + 8192 + i * 1024) = R.v[i]; }
}
struct AttnAddr { const LAS unsigned char* k[2]; const LAS unsigned char* v[4]; };
__device__ __forceinline__ AttnAddr attn_addr(const LAS unsigned char* KL, const LAS unsigned char* VL, int lr, int lq) {
    AttnAddr A;
#pragma unroll
    for (int ks = 0; ks < 2; ++ks) A.k[ks] = KL + lr * 128 + (((4 * ks + lq) ^ (lr & 7)) << 4);
    const int qq = lr >> 2, p = lr & 3, row = 4 * lq + qq;
#pragma unroll
    for (int dt = 0; dt < 4; ++dt) A.v[dt] = VL + row * 128 + (((2 * dt + (p >> 1)) ^ (row & 7)) << 4) + 8 * (p & 1);
    return A;
}
__device__ __forceinline__ bf16x8 attn_v_op(const LAS unsigned char* va, int kb0, int kb1) {
    const v4i16_t lo = __builtin_amdgcn_ds_read_tr16_b64_v4i16((LAS v4i16_t*)(va + kb0 * 128));
    const v4i16_t hi = __builtin_amdgcn_ds_read_tr16_b64_v4i16((LAS v4i16_t*)(va + kb1 * 128));
    return (bf16x8){lo[0], lo[1], lo[2], lo[3], hi[0], hi[1], hi[2], hi[3]};
}
__device__ __forceinline__ float xmax4(float v) { v = fmaxf(v, __shfl_xor(v, 16)); v = fmaxf(v, __shfl_xor(v, 32)); return v; }
template <int NT, bool WIN, int KB>
__device__ __forceinline__ void attn_block(const AttnAddr& A, const bf16x8 (&QB)[2], f32x4 (&O)[4], float& m, float& l, bool first, int lo, const LAS bf16* bias, int lq) {
    const f32x4 z4 = (f32x4){0.f, 0.f, 0.f, 0.f};
    constexpr float SC = 0.125f * LOG2E;
    float s[NT][4];
    bf16x8 kop[NT][2];
#pragma unroll
    for (int t = 0; t < NT; ++t) { kop[t][0] = *(const LAS bf16x8*)(A.k[0] + (KB + 16 * t) * 128); kop[t][1] = *(const LAS bf16x8*)(A.k[1] + (KB + 16 * t) * 128); }
#pragma unroll
    for (int t = 0; t < NT; ++t) {
        f32x4 a = MFMA16(kop[t][0], QB[0], z4);
        a = MFMA16(kop[t][1], QB[1], a);
#pragma unroll
        for (int r = 0; r < 4; ++r) { const int kk = 16 * t + 4 * lq + r; float v = a[r] * SC;
            if (WIN) { v += bf2f(bias[kk]); v = ((unsigned)(kk - lo) < 16u) ? v : -1e30f; }
            s[t][r] = v; }
    }
    if (first) { float mc = -1e30f;
#pragma unroll
        for (int t = 0; t < NT; ++t)
#pragma unroll
            for (int r = 0; r < 4; ++r) mc = fmaxf(mc, s[t][r]);
        m = xmax4(mc); }
    float ps = 0.f;
#pragma unroll
    for (int t = 0; t < NT; ++t)
#pragma unroll
        for (int r = 0; r < 4; ++r) { s[t][r] = __builtin_amdgcn_exp2f(fminf(s[t][r] - m, 100.f)); ps += s[t][r]; }
    l += ps;
#pragma unroll
    for (int kp = 0; kp < NT / 2; ++kp) {
        const bf16x8 bp = pack8((f32x4){s[2 * kp][0], s[2 * kp][1], s[2 * kp][2], s[2 * kp][3]}, (f32x4){s[2 * kp + 1][0], s[2 * kp + 1][1], s[2 * kp + 1][2], s[2 * kp + 1][3]});
        bf16x8 vop[4];
#pragma unroll
        for (int dt = 0; dt < 4; ++dt) vop[dt] = attn_v_op(A.v[dt], KB + 32 * kp, KB + 32 * kp + 16);
#pragma unroll
        for (int dt = 0; dt < 4; ++dt) O[dt] = MFMA16(vop[dt], bp, O[dt]);
    }
}
template <bool WIN>
__device__ __forceinline__ bf16x8 attn_soft(const f32x4 (&a)[2], float& m, float& l, bool first, int lo, const LAS bf16* bias, int lq) {
    constexpr float SC = 0.125f * LOG2E;
    float s[2][4];
#pragma unroll
    for (int t = 0; t < 2; ++t)
#pragma unroll
        for (int r = 0; r < 4; ++r) { const int kk = 16 * t + 4 * lq + r; float v = a[t][r] * SC;
            if (WIN) { v += bf2f(bias[kk]); v = ((unsigned)(kk - lo) < 16u) ? v : -1e30f; }
            s[t][r] = v; }
    if (first) { float mc = -1e30f;
#pragma unroll
        for (int t = 0; t < 2; ++t)
#pragma unroll
            for (int r = 0; r < 4; ++r) mc = fmaxf(mc, s[t][r]);
        m = xmax4(mc); }
    float ps = 0.f;
#pragma unroll
    for (int t = 0; t < 2; ++t)
#pragma unroll
        for (int r = 0; r < 4; ++r) { s[t][r] = __builtin_amdgcn_exp2f(fminf(s[t][r] - m, 100.f)); ps += s[t][r]; }
    l += ps;
    return pack8((f32x4){s[0][0], s[0][1], s[0][2], s[0][3]}, (f32x4){s[1][0], s[1][1], s[1][2], s[1][3]});
}
template <bool WIN, int KB0, int KB1>
__device__ __forceinline__ void attn_pair(const AttnAddr& A, const bf16x8 (&QB0)[2], const bf16x8 (&QB1)[2], f32x4 (&O0)[4], f32x4 (&O1)[4], float& m0, float& m1, float& l0, float& l1, bool first,
                                          int lo0, int lo1, const LAS bf16* bias0, const LAS bf16* bias1, int lq) {
    constexpr bool SAMEKV = (KB0 == KB1);
    const f32x4 z4 = (f32x4){0.f, 0.f, 0.f, 0.f};
    bf16x8 k0[2][2], k1[2][2];
#pragma unroll
    for (int t = 0; t < 2; ++t)
#pragma unroll
        for (int ks = 0; ks < 2; ++ks) { k0[t][ks] = *(const LAS bf16x8*)(A.k[ks] + (KB0 + 16 * t) * 128); k1[t][ks] = SAMEKV ? k0[t][ks] : *(const LAS bf16x8*)(A.k[ks] + (KB1 + 16 * t) * 128); }
    f32x4 a0[2], a1[2];
#pragma unroll
    for (int t = 0; t < 2; ++t) { a0[t] = MFMA16(k0[t][0], QB0[0], z4); a0[t] = MFMA16(k0[t][1], QB0[1], a0[t]); }
#pragma unroll
    for (int t = 0; t < 2; ++t) { a1[t] = MFMA16(k1[t][0], QB1[0], z4); a1[t] = MFMA16(k1[t][1], QB1[1], a1[t]); }
    __builtin_amdgcn_sched_barrier(0);
    bf16x8 v0[4], v1[4];
#pragma unroll
    for (int dt = 0; dt < 4; ++dt) v0[dt] = attn_v_op(A.v[dt], KB0, KB0 + 16);
    const bf16x8 bp0 = attn_soft<WIN>(a0, m0, l0, first, lo0, bias0, lq);
#pragma unroll
    for (int dt = 0; dt < 4; ++dt) O0[dt] = MFMA16(v0[dt], bp0, O0[dt]);
    __builtin_amdgcn_sched_barrier(0);
#pragma unroll
    for (int dt = 0; dt < 4; ++dt) v1[dt] = SAMEKV ? v0[dt] : attn_v_op(A.v[dt], KB1, KB1 + 16);
    const bf16x8 bp1 = attn_soft<WIN>(a1, m1, l1, first, lo1, bias1, lq);
#pragma unroll
    for (int dt = 0; dt < 4; ++dt) O1[dt] = MFMA16(v1[dt], bp1, O1[dt]);
}
__device__ __forceinline__ void p_attn(const Ctx& C, const float* const (&in)[19], int layer) {
    const bf16* P = (const bf16*)(C.ws + WS_P); bf16* NA = (bf16*)(C.ws + WS_NA);
    LAS unsigned char* KL = C.lds + RING_OFF + C.wave * 16384; LAS unsigned char* VL = KL + 8192;
    LAS bf16* RPB = (LAS bf16*)(C.lds + RPB_OFF) + 32;
    { const float* rpb = in[IN_RPB] + (size_t)layer * 8 * 465;
      for (int u = C.tid; u < 8 * 465; u += NWAVES * 64) RPB[u] = (bf16)f2bf(rpb[u] * LOG2E);
      __syncthreads(); }
    const int lane = C.lane, lr = lane & 15, lq = lane >> 4;
    const AttnAddr AD = attn_addr(KL, VL, lr, lq);
    const unsigned lofs = (unsigned)(((lane >> 3) * NIN + (lane & 7) * 8) * 2);
    LAS unsigned char* kdst = KL + (lane >> 3) * 128 + (((lane & 7) ^ ((lane >> 3) & 7)) << 4); LAS unsigned char* vdst = kdst + 8192;
    const int nitems = layer == 0 ? 4096 + 256 : 4096;
    const bool xl = C.G == 256; const int xs = (int)blockIdx.x >> 3;
    for (int it = C.gw; it < nitems; it += C.NGW) {
        int id = it;
        if (xl && it < 4096) { const int B = (it >> 11) * 8 + ((int)blockIdx.x & 7); id = ((((B >> 2) * 64 + (B & 3) * 16 + (xs >> 1)) << 4) | ((4 * (xs & 1) + (C.wave >> 1)) << 1) | (C.wave & 1)); }
        const bool isctx = id >= 4096;
        int b, h, r = 0, half = 0, qtok0;
        if (!isctx) { b = id >> 10; r = (id >> 4) & 63; h = (id >> 1) & 7; half = id & 1; qtok0 = b * SEQ + r * 64 + 32 * half; }
        else { const int j = id - 4096; b = j >> 6; h = (j >> 3) & 7; qtok0 = MX + b * CTXL + (j & 7) * 32; }
        bf16x8 QB[2][2];
#pragma unroll
        for (int qb = 0; qb < 2; ++qb) { const bf16* qp = P + (size_t)(qtok0 + 16 * qb + lr) * NIN + PQ + h * 64 + 8 * lq; QB[qb][0] = *(const bf16x8*)qp; QB[qb][1] = *(const bf16x8*)(qp + 32); }
        f32x4 O[2][4]; float m[2], l[2];
#pragma unroll
        for (int qb = 0; qb < 2; ++qb) { m[qb] = -1e30f; l[qb] = 0.f;
#pragma unroll
            for (int dt = 0; dt < 4; ++dt) O[qb][dt] = (f32x4){0.f, 0.f, 0.f, 0.f}; }
        const int rs = min(max(r - 4, 0), NROWS - 8), kc0 = 24 * half;
        const bf16* wsrc = P + (size_t)(b * SEQ + rs * 64 + kc0) * NIN + h * 64 + PK;
        const bf16* csrc = P + (size_t)(MX + b * CTXL) * NIN + h * 64 + PK;
        const int c0 = isctx ? 8 : 0; int c = c0;
        AttnStage R;
        attn_issue(R, c < 8 ? wsrc + (size_t)c * 64 * NIN : csrc + (size_t)(c - 8) * 32 * NIN, lofs);
#pragma unroll 1
        for (; c < 16; ++c) {
            attn_commit(R, kdst);
            { const int cn = c + 1 < 16 ? c + 1 : 15;
              attn_issue(R, cn < 8 ? wsrc + (size_t)cn * 64 * NIN : csrc + (size_t)(cn - 8) * 32 * NIN, lofs); }
            LDS_WAIT(); asm volatile("" ::: "memory");
            if (c < 8) {
                const LAS bf16* brow = RPB + h * 465 + (rs + c - r + 7) * 31;
{ const int col0 = 32 * half + lr, cs0 = min(max(col0 - 8, 0), GRIDW - 16), col1 = col0 + 16, cs1 = min(max(col1 - 8, 0), GRIDW - 16);
                  attn_pair<true, 0, 8>(AD, QB[0], QB[1], O[0], O[1], m[0], m[1], l[0], l[1], c == c0, cs0 - kc0, cs1 - (kc0 + 8), brow + (kc0 - col0 + 15), brow + ((kc0 + 8) - col1 + 15), lq); }
            } else {
                attn_pair<false, 0, 0>(AD, QB[0], QB[1], O[0], O[1], m[0], m[1], l[0], l[1], c == c0, 0, 0, RPB, RPB, lq);
            }
            asm volatile("" ::: "memory");
        }
#pragma unroll
        for (int qb = 0; qb < 2; ++qb) {
            float lt = l[qb]; lt += __shfl_xor(lt, 16); lt += __shfl_xor(lt, 32);
            const float inv = 1.0f / lt;
            bf16* op = NA + (size_t)(qtok0 + 16 * qb + lr) * 512 + h * 64 + 4 * lq;
#pragma unroll
            for (int dt = 0; dt < 4; ++dt) { u32x2 w; w.x = pk2(O[qb][dt][0] * inv, O[qb][dt][1] * inv); w.y = pk2(O[qb][dt][2] * inv, O[qb][dt][3] * inv); *(u32x2*)(op + 16 * dt) = w; }
        }
    }
}

__device__ __forceinline__ void p_fft_a(const Ctx& C) {
    const bf16* P = (const bf16*)(C.ws + WS_P); bf16* TT = (bf16*)(C.ws + WS_TT);
    const LAS unsigned char* CT = C.lds + CT_OFF; const LAS unsigned char* ST = C.lds + ST_OFF;
    const LAS f32x2* tw64 = (const LAS f32x2*)(C.lds + TW64_OFF); const LAS f32x2* tw4k = (const LAS f32x2*)(C.lds + TW4K_OFF);
    const int lane = C.lane, lr = lane & 15, lq = lane >> 4;
    const f32x4 z4 = (f32x4){0.f, 0.f, 0.f, 0.f};
    for (int id2 = C.wave * C.G + (int)blockIdx.x; id2 < 2 * NB * 4 * 64; id2 += C.NGW)     {
        const int id = id2 >> 1, jh = id2 & 1, b = id >> 8, g = (id >> 6) & 3, n2 = id & 63;
        bf16x8 FA[4][2];
#pragma unroll
        for (int mt = 0; mt < 4; ++mt) { const int n1 = 32 * (mt >> 1) + 8 * (lr >> 2) + 4 * (mt & 1) + (lr & 3);
            const bf16* fr = P + (size_t)(b * SEQ + 64 * n1 + n2) * NIN + PF + g * 64 + 8 * lq;
            FA[mt][0] = *(const bf16x8*)fr; FA[mt][1] = *(const bf16x8*)(fr + 32); }
        float tcs[4][4], tsn[4][4];
#pragma unroll
        for (int kt = 0; kt < 4; ++kt)
#pragma unroll
            for (int r = 0; r < 4; ++r) { const int kn = (16 * kt + 4 * lq + r) * n2; const f32x2 wa = tw64[(kn >> 6) & 63], wb = tw4k[kn & 63];
                tcs[kt][r] = wa.x * wb.x - wa.y * wb.y; tsn[kt][r] = wa.y * wb.x + wa.x * wb.y; }
#pragma unroll 1
        for (int jt = 2 * jh; jt < 2 * jh + 2; ++jt) {
            bf16x8 cb[2], sb[2];
#pragma unroll
            for (int ks = 0; ks < 2; ++ks) { cb[ks] = *(const LAS bf16x8*)(CT + (16 * jt + lr) * 128 + (32 * ks + 8 * lq) * 2); sb[ks] = *(const LAS bf16x8*)(ST + (16 * jt + lr) * 128 + (32 * ks + 8 * lq) * 2); }
            f32x4 gr[4], gi[4];
#pragma unroll
            for (int mt = 0; mt < 4; ++mt) { gr[mt] = MFMA16(FA[mt][0], cb[0], z4); gr[mt] = MFMA16(FA[mt][1], cb[1], gr[mt]); gi[mt] = MFMA16(FA[mt][0], sb[0], z4); gi[mt] = MFMA16(FA[mt][1], sb[1], gi[mt]); }
            bf16x8 BGr[2], BGi[2], BnGi[2];
#pragma unroll
            for (int p = 0; p < 2; ++p) { BGr[p] = pack8(gr[2 * p], gr[2 * p + 1]); BGi[p] = pack8(gi[2 * p], gi[2 * p + 1]); BnGi[p] = neg8(BGi[p]); }
#pragma unroll
            for (int kt = 0; kt < 4; ++kt) {
                f32x4 tr = z4, nti = z4;
#pragma unroll
                for (int p = 0; p < 2; ++p) { const bf16x8 ca = *(const LAS bf16x8*)(CT + (16 * kt + lr) * 128 + (32 * p + 8 * lq) * 2), sa = *(const LAS bf16x8*)(ST + (16 * kt + lr) * 128 + (32 * p + 8 * lq) * 2);
                    tr = MFMA16(ca, BGr[p], tr); tr = MFMA16(sa, BnGi[p], tr); nti = MFMA16(ca, BGi[p], nti); nti = MFMA16(sa, BGr[p], nti); }
#pragma unroll
                for (int r = 0; r < 4; ++r) { const int k1 = 16 * kt + 4 * lq + r; const float cs = tcs[kt][r], sn = tsn[kt][r];
                    const float tpr = cs * tr[r] - sn * nti[r], tpi = -cs * nti[r] - sn * tr[r];
                    bf16* dst = TT + ((size_t)(((b * 4 + g) * 64 + k1) * 2) * 64 + n2) * 64 + 16 * jt + lr;
                    dst[0] = (bf16)f2bf(tpr); dst[64 * 64] = (bf16)f2bf(tpi); }
            }
        }
    }
}
__device__ __forceinline__ void p_fft_b(const Ctx& C) {
    const bf16* TT = (const bf16*)(C.ws + WS_TT); float* FO = (float*)(C.ws + WS_FO);
    const LAS unsigned char* CT = C.lds + CT_OFF; const LAS unsigned char* ST = C.lds + ST_OFF;
    LAS unsigned char* scr = C.lds + RING_OFF + C.wave * 16384;
    const int lane = C.lane, lr = lane & 15, lq = lane >> 4;
    const f32x4 z4 = (f32x4){0.f, 0.f, 0.f, 0.f};
    for (int id = C.wave * C.G + (int)blockIdx.x; id < NB * 4 * 64; id += C.NGW)     {
        const int b = id >> 8, g = (id >> 6) & 3, k1 = id & 63;
        const v4u* src = (const v4u*)(TT + (size_t)(((b * 4 + g) * 64 + k1) * 2) * 64 * 64);
#pragma unroll
        for (int i = 0; i < 16; ++i) { const v4u w = src[i * 64 + lane]; *(LAS v4u*)(scr + (i * 64 + lane) * 16) = w; }
        LDS_WAIT(); asm volatile("" ::: "memory");
        f32x4 acc[4][4];
#pragma unroll
        for (int kt = 0; kt < 4; ++kt)
#pragma unroll
            for (int jt = 0; jt < 4; ++jt) acc[kt][jt] = z4;
#pragma unroll
        for (int ri = 0; ri < 2; ++ri)
#pragma unroll
            for (int ks = 0; ks < 2; ++ks) {
                bf16x8 Bop[4];
#pragma unroll
                for (int jt = 0; jt < 4; ++jt) {
                    const int r0 = 32 * ks + 8 * lq; const LAS unsigned char* pa = scr + ri * 8192 + (r0 + (lr >> 2)) * 128 + (16 * jt + 4 * (lr & 3)) * 2;
                    const v4i16_t lo = __builtin_amdgcn_ds_read_tr16_b64_v4i16((LAS v4i16_t*)pa), hi = __builtin_amdgcn_ds_read_tr16_b64_v4i16((LAS v4i16_t*)(pa + 4 * 128));
                    Bop[jt] = (bf16x8){lo[0], lo[1], lo[2], lo[3], hi[0], hi[1], hi[2], hi[3]}; }
#pragma unroll
                for (int kt = 0; kt < 4; ++kt) { const bf16x8 aop = *(const LAS bf16x8*)((ri == 0 ? CT : ST) + (16 * kt + lr) * 128 + (32 * ks + 8 * lq) * 2);
#pragma unroll
                    for (int jt = 0; jt < 4; ++jt) acc[kt][jt] = MFMA16(aop, Bop[jt], acc[kt][jt]); }
            }
#pragma unroll
        for (int kt = 0; kt < 4; ++kt)
#pragma unroll
            for (int r = 0; r < 4; ++r) { const int k2 = 16 * kt + 4 * lq + r; float* dst = FO + (size_t)(b * SEQ + k1 + 64 * k2) * 256 + g * 64 + lr;
#pragma unroll
                for (int jt = 0; jt < 4; ++jt) dst[16 * jt] = acc[kt][jt][r] * (1.0f / 512.0f); }
        LDS_WAIT(); asm volatile("" ::: "memory");
    }
}
__device__ __forceinline__ void p_fft_ctx1(const Ctx& C) {
    const bf16* P = (const bf16*)(C.ws + WS_P); bf16* GT = (bf16*)(C.ws + WS_GC);
    const LAS unsigned char* CT = C.lds + CT_OFF; const LAS unsigned char* ST = C.lds + ST_OFF;
    const int lane = C.lane, lr = lane & 15, lq = lane >> 4;
    const f32x4 z4 = (f32x4){0.f, 0.f, 0.f, 0.f};
    for (int id = ((C.wave + 4) & 7) * C.G + (int)blockIdx.x; id < NB * 4 * 16; id += C.NGW) {
        const int b = id >> 6, g = (id >> 4) & 3, nt = id & 15;
        const bf16* fr = P + (size_t)(MX + b * CTXL + 16 * nt + lr) * NIN + PF + g * 64 + 8 * lq;
        const bf16x8 fa0 = *(const bf16x8*)fr, fa1 = *(const bf16x8*)(fr + 32);
#pragma unroll
        for (int jt = 0; jt < 4; ++jt) {
            const bf16x8 c0 = *(const LAS bf16x8*)(CT + (16 * jt + lr) * 128 + (8 * lq) * 2), c1 = *(const LAS bf16x8*)(CT + (16 * jt + lr) * 128 + (32 + 8 * lq) * 2);
            const bf16x8 s0 = *(const LAS bf16x8*)(ST + (16 * jt + lr) * 128 + (8 * lq) * 2), s1 = *(const LAS bf16x8*)(ST + (16 * jt + lr) * 128 + (32 + 8 * lq) * 2);
            f32x4 gr = MFMA16(fa0, c0, z4); gr = MFMA16(fa1, c1, gr);
            f32x4 gs = MFMA16(fa0, s0, z4); gs = MFMA16(fa1, s1, gs);
            bf16* dst = GT + ((size_t)((b * 4 + g) * 2) * 64 + 16 * jt + lr) * CTXL + 16 * nt + 4 * lq;
            u32x2 wr_, wi_; wr_.x = pk2(gr[0], gr[1]); wr_.y = pk2(gr[2], gr[3]); wi_.x = pk2(-gs[0], -gs[1]); wi_.y = pk2(-gs[2], -gs[3]);
            *(u32x2*)dst = wr_; *(u32x2*)(dst + (size_t)64 * CTXL) = wi_;
        }
    }
}
__device__ __forceinline__ void p_fft_ctx2(const Ctx& C) {
    const bf16* GT = (const bf16*)(C.ws + WS_GC); float* FO = (float*)(C.ws + WS_FO);
    const LAS f32x2* tw256 = (const LAS f32x2*)(C.lds + TW256_OFF);
    const int lane = C.lane, lr = lane & 15, lq = lane >> 4;
    for (int id = ((C.wave + 4) & 7) * C.G + (int)blockIdx.x; id < NB * 4 * 16; id += C.NGW) {
        const int b = id >> 6, g = (id >> 4) & 3, kt = id & 15, k = 16 * kt + lr;
        f32x4 acc[4];
#pragma unroll
        for (int jt = 0; jt < 4; ++jt) acc[jt] = (f32x4){0.f, 0.f, 0.f, 0.f};
#pragma unroll 1
        for (int ri = 0; ri < 2; ++ri) {
            const bf16* gb = GT + ((size_t)((b * 4 + g) * 2 + ri) * 64 + lr) * CTXL + 8 * lq;
#pragma unroll 1
            for (int ks = 0; ks < 8; ks += 2) {
                bf16x8 Bop[2][4];
#pragma unroll
                for (int k2 = 0; k2 < 2; ++k2)
#pragma unroll
                    for (int jt = 0; jt < 4; ++jt) Bop[k2][jt] = *(const bf16x8*)(gb + (size_t)(16 * jt) * CTXL + 32 * (ks + k2));
#pragma unroll
                for (int k2 = 0; k2 < 2; ++k2) { const int n0 = 32 * (ks + k2) + 8 * lq;
                    float w[8];
#pragma unroll
                    for (int e = 0; e < 8; ++e) { const f32x2 t = tw256[(k * (n0 + e)) & 255]; w[e] = ri == 0 ? t.x : t.y; }
                    v4u aw; aw.x = pk2(w[0], w[1]); aw.y = pk2(w[2], w[3]); aw.z = pk2(w[4], w[5]); aw.w = pk2(w[6], w[7]);
                    const bf16x8 aop = __builtin_bit_cast(bf16x8, aw);
#pragma unroll
                    for (int jt = 0; jt < 4; ++jt) acc[jt] = MFMA16(aop, Bop[k2][jt], acc[jt]); }
            }
        }
#pragma unroll
        for (int r = 0; r < 4; ++r) { float* dst = FO + (size_t)(MX + b * CTXL + 16 * kt + 4 * lq + r) * 256 + g * 64 + lr;
#pragma unroll
            for (int jt = 0; jt < 4; ++jt) dst[16 * jt] = acc[jt][r] * (1.0f / 128.0f); }
    }
}

struct MergeIn { v4u na; u32x2 cg[3], uu[3], bg; f32x4 fo; unsigned okm[3]; };
__device__ __forceinline__ void merge_load(MergeIn& m, const bf16* P, const bf16* NA, const float* FO, int row, int lane) {
    const bool isctx = row >= MX; const int slen = isctx ? CTXL : SEQ, pos = isctx ? ((row - MX) & (CTXL - 1)) : (row & (SEQ - 1));
    m.na = *(const v4u*)(NA + (size_t)row * 512 + 8 * lane);
    const bf16* pr = P + (size_t)row * NIN;
#pragma unroll
    for (int dk = 0; dk < 3; ++dk) { const int pp = pos + dk - 1; const bool ok = pp >= 0 && pp < slen; const bf16* pq = pr + (ptrdiff_t)(dk - 1) * NIN;
        const bf16* pz = ok ? pq : pr;
        const u32x2 cgv = *(const u32x2*)(pz + PCG + 4 * lane), uuv = *(const u32x2*)(pz + PU + 4 * lane);
        m.cg[dk] = cgv; m.uu[dk] = uuv; m.okm[dk] = ok ? 0xffffffffu : 0u; }
    m.bg = *(const u32x2*)(pr + PBG + 4 * lane);
    m.fo = *(const f32x4*)(FO + (size_t)row * 256 + 4 * lane);
}
__device__ __forceinline__ void p_merge(const Ctx& C, const float* const (&in)[19], int layer) {
    const bf16* P = (const bf16*)(C.ws + WS_P); const bf16* NA = (const bf16*)(C.ws + WS_NA); const float* FO = (const float*)(C.ws + WS_FO); bf16* Y = (bf16*)(C.ws + WS_Y);
    LAS float* cw = (LAS float*)(C.lds + RING_OFF); LAS float* gm = cw + 768;
    stage_vec4(cw, in[IN_CONVW] + (size_t)layer * 3 * 256, 768 / 4, C.tid); stage_vec4(gm, in[IN_GMIXOUT] + (size_t)layer * D, D / 4, C.tid);
    __syncthreads();
    const int nrows = layer == 0 ? MT : MX, lane = C.lane;
    int row = C.gw; MergeIn m, nm;
    if (row < nrows) merge_load(m, P, NA, FO, row, lane);
    while (row < nrows) {
        const int nrow = row + C.NGW;
        merge_load(nm, P, NA, FO, nrow < nrows ? nrow : nrows - 1, lane);
        float na[8]; { const v4u w = m.na;
            na[0] = bflo(w.x); na[1] = bfhi(w.x); na[2] = bflo(w.y); na[3] = bfhi(w.y); na[4] = bflo(w.z); na[5] = bfhi(w.z); na[6] = bflo(w.w); na[7] = bfhi(w.w); }
        float s_na = 0.f;
#pragma unroll
        for (int i = 0; i < 8; ++i) s_na += na[i] * na[i];
        float z[3][4];
#pragma unroll
        for (int dk = 0; dk < 3; ++dk) { u32x2 cg = m.cg[dk]; const u32x2 uu = m.uu[dk]; cg.x &= m.okm[dk]; cg.y &= m.okm[dk];
            z[dk][0] = bflo(cg.x) * bflo(uu.x); z[dk][1] = bfhi(cg.x) * bfhi(uu.x); z[dk][2] = bflo(cg.y) * bflo(uu.y); z[dk][3] = bfhi(cg.y) * bfhi(uu.y); }
        const u32x2 bgw = m.bg;
        const f32x4 w0 = *(const LAS f32x4*)(cw + 4 * lane), w1 = *(const LAS f32x4*)(cw + 256 + 4 * lane), w2 = *(const LAS f32x4*)(cw + 512 + 4 * lane);
        float cv[4];
        cv[0] = bflo(bgw.x) * (w0.x * z[0][0] + w1.x * z[1][0] + w2.x * z[2][0]); cv[1] = bfhi(bgw.x) * (w0.y * z[0][1] + w1.y * z[1][1] + w2.y * z[2][1]);
        cv[2] = bflo(bgw.y) * (w0.z * z[0][2] + w1.z * z[1][2] + w2.z * z[2][2]); cv[3] = bfhi(bgw.y) * (w0.w * z[0][3] + w1.w * z[1][3] + w2.w * z[2][3]);
        float s_cv = cv[0] * cv[0] + cv[1] * cv[1] + cv[2] * cv[2] + cv[3] * cv[3];
        const f32x4 fo = m.fo;
        float s_fo = fo.x * fo.x + fo.y * fo.y + fo.z * fo.z + fo.w * fo.w;
        s_na = wave_sum(s_na); s_cv = wave_sum(s_cv); s_fo = wave_sum(s_fo);
        const float r_na = 1.0f / sqrtf(s_na * (1.f / 512.f) + RMS_EPS), r_cv = 1.0f / sqrtf(s_cv * (1.f / 256.f) + RMS_EPS), r_fo = 1.0f / sqrtf(s_fo * (1.f / 256.f) + RMS_EPS);
#if WOUT_FP8
        unsigned char* yr = (unsigned char*)Y + (size_t)row * D;
        { const f32x4 g0 = *(const LAS f32x4*)(gm + 8 * lane), g1 = *(const LAS f32x4*)(gm + 8 * lane + 4); const float q = r_na * S_Y;
          u32x2 w; w.x = pg8::pk4_fp8(na[0] * q * g0.x, na[1] * q * g0.y, na[2] * q * g0.z, na[3] * q * g0.w); w.y = pg8::pk4_fp8(na[4] * q * g1.x, na[5] * q * g1.y, na[6] * q * g1.z, na[7] * q * g1.w); *(u32x2*)(yr + 8 * lane) = w; }
        { const f32x4 g0 = *(const LAS f32x4*)(gm + 512 + 4 * lane); const float q = r_cv * S_Y; *(unsigned*)(yr + 512 + 4 * lane) = pg8::pk4_fp8(cv[0] * q * g0.x, cv[1] * q * g0.y, cv[2] * q * g0.z, cv[3] * q * g0.w); }
        { const f32x4 g0 = *(const LAS f32x4*)(gm + 768 + 4 * lane); const float q = r_fo * S_Y; *(unsigned*)(yr + 768 + 4 * lane) = pg8::pk4_fp8(fo.x * q * g0.x, fo.y * q * g0.y, fo.z * q * g0.z, fo.w * q * g0.w); }
#else
        bf16* yr = Y + (size_t)row * D;
        { const f32x4 g0 = *(const LAS f32x4*)(gm + 8 * lane), g1 = *(const LAS f32x4*)(gm + 8 * lane + 4);
          v4u w; w.x = pk2(na[0] * r_na * g0.x, na[1] * r_na * g0.y); w.y = pk2(na[2] * r_na * g0.z, na[3] * r_na * g0.w);
          w.z = pk2(na[4] * r_na * g1.x, na[5] * r_na * g1.y); w.w = pk2(na[6] * r_na * g1.z, na[7] * r_na * g1.w); *(v4u*)(yr + 8 * lane) = w; }
        { const f32x4 g0 = *(const LAS f32x4*)(gm + 512 + 4 * lane); u32x2 w; w.x = pk2(cv[0] * r_cv * g0.x, cv[1] * r_cv * g0.y); w.y = pk2(cv[2] * r_cv * g0.z, cv[3] * r_cv * g0.w); *(u32x2*)(yr + 512 + 4 * lane) = w; }
        { const f32x4 g0 = *(const LAS f32x4*)(gm + 768 + 4 * lane); u32x2 w; w.x = pk2(fo.x * r_fo * g0.x, fo.y * r_fo * g0.y); w.y = pk2(fo.z * r_fo * g0.z, fo.w * r_fo * g0.w); *(u32x2*)(yr + 768 + 4 * lane) = w; }
#endif
        m = nm; row = nrow;
    }
}
__device__ __forceinline__ const float* xin_row0(const float* const (&in)[19], int row) { return row < MX ? in[IN_X] + (size_t)row * D : in[IN_CTX] + (size_t)(row - MX) * D; }
__device__ __forceinline__ f32x4 bf4(u32x2 w) { return (f32x4){bflo(w.x), bfhi(w.x), bflo(w.y), bfhi(w.y)}; }
__device__ __forceinline__ u32x2 pk4bf(f32x4 a) { u32x2 w; w.x = pk2(a.x, a.y); w.y = pk2(a.z, a.w); return w; }
template <bool L0>
__device__ __forceinline__ void postmix_rows(const Ctx& C, const float* const (&in)[19], int layer, int row0, int rstride, int rend, const LAS float* WR, const LAS float* GPOST, const LAS float* GPRE, const LAS float* G1, const LAS float* SH2, const LAS float* SC2) {
    const bf16* MO = (const bf16*)(C.ws + WS_MO); bf16* X1 = (bf16*)(C.ws + WS_X1); const bf16* X2 = (const bf16*)(C.ws + WS_X2); unsigned char* H2 = C.ws + WS_H2; float* AFF = (float*)(C.ws + WS_AFF);
    const int lane = C.lane;
    int row = row0; f32x4 v[4], xx[4]; u32x2 nm[4], nxb[4]; f32x4 nxf[4];
    if (row >= rend) return;
#pragma unroll
    for (int j = 0; j < 4; ++j) { nm[j] = ((const u32x2*)(MO + (size_t)row * D))[lane + 64 * j];
        if (L0) nxf[j] = ((const f32x4*)xin_row0(in, row))[lane + 64 * j]; else nxb[j] = ((const u32x2*)(X2 + (size_t)row * D))[lane + 64 * j]; }
    while (row < rend) {
#pragma unroll
        for (int j = 0; j < 4; ++j) { v[j] = bf4(nm[j]); xx[j] = L0 ? nxf[j] : bf4(nxb[j]); }
        const int nrow = row + rstride, prow = nrow < rend ? nrow : rend - 1;
#pragma unroll
        for (int j = 0; j < 4; ++j) { nm[j] = ((const u32x2*)(MO + (size_t)prow * D))[lane + 64 * j];
            if (L0) nxf[j] = ((const f32x4*)xin_row0(in, prow))[lane + 64 * j]; else nxb[j] = ((const u32x2*)(X2 + (size_t)prow * D))[lane + 64 * j]; }
        const float r1 = 1.0f / sqrtf(wave_sum(sumsq4(v)) * (1.f / D) + RMS_EPS);
#pragma unroll
        for (int j = 0; j < 4; ++j) { const f32x4 gg = ((const LAS f32x4*)GPOST)[lane + 64 * j], g1v = ((const LAS f32x4*)G1)[lane + 64 * j];
            v[j] = xx[j] + g1v * (v[j] * r1 * gg); ((u32x2*)(X1 + (size_t)row * D))[lane + 64 * j] = pk4bf(v[j]); }
        const float r2 = 1.0f / sqrtf(wave_sum(sumsq4(v)) * (1.f / D) + RMS_EPS);
        f32x2 acc2[NE];
#pragma unroll
        for (int e = 0; e < NE; ++e) acc2[e] = (f32x2){0.f, 0.f};
#pragma unroll
        for (int j = 0; j < 4; ++j) {
            const f32x4 gg = ((const LAS f32x4*)GPRE)[lane + 64 * j], hh = ((const LAS f32x4*)SH2)[lane + 64 * j], cc = ((const LAS f32x4*)SC2)[lane + 64 * j];
            const f32x4 h = (v[j] * r2 * gg) * (cc + 1.0f) + hh;
            ((unsigned*)(H2 + (size_t)row * D))[lane + 64 * j] = pg8::pk4_fp8(h.x * S_ACT, h.y * S_ACT, h.z * S_ACT, h.w * S_ACT);
            const f32x2 hlo = (f32x2){h.x, h.y}, hhi = (f32x2){h.z, h.w};
#pragma unroll
            for (int e = 0; e < NE; ++e) { const f32x4 ww = ((const LAS f32x4*)(WR + e * D))[lane + 64 * j];
                acc2[e] += hlo * (f32x2){ww.x, ww.y}; acc2[e] += hhi * (f32x2){ww.z, ww.w};
                if ((e & 7) == 7) asm volatile("" ::: "memory"); }
        }
#ifdef DBG_PM_DUP
        { f32x2 dup[NE];
#pragma unroll
          for (int e = 0; e < NE; ++e) dup[e] = (f32x2){0.f, 0.f};
#pragma unroll
          for (int j = 0; j < 4; ++j) { const f32x2 hlo = (f32x2){v[j].x, v[j].y}, hhi = (f32x2){v[j].z, v[j].w};
#pragma unroll
            for (int e = 0; e < NE; ++e) { const f32x4 ww = ((const LAS f32x4*)(WR + e * D))[lane + 64 * j]; dup[e] += hlo * (f32x2){ww.x, ww.y}; dup[e] += hhi * (f32x2){ww.z, ww.w};
                if ((e & 7) == 7) asm volatile("" ::: "memory"); } }
#pragma unroll
          for (int e = 0; e < NE; ++e) asm volatile("" :: "v"(dup[e])); }
#endif
        float f;
        { const bool b0 = lane & 1, b1 = lane & 2, b2 = lane & 4, b3 = lane & 8;
          float s8[8], s4[4], s2[2];
#pragma unroll
          for (int k = 0; k < 8; ++k) { const float lo = acc2[k].x + acc2[k].y, hi = acc2[k + 8].x + acc2[k + 8].y; s8[k] = (b0 ? hi : lo) + dppf<0xB1>(b0 ? lo : hi); }
#pragma unroll
          for (int k = 0; k < 4; ++k) s4[k] = (b1 ? s8[k + 4] : s8[k]) + dppf<0x4E>(b1 ? s8[k] : s8[k + 4]);
#pragma unroll
          for (int k = 0; k < 2; ++k) s2[k] = (b2 ? s4[k + 2] : s4[k]) + __shfl_xor(b2 ? s4[k] : s4[k + 2], 4);
          f = (b3 ? s2[1] : s2[0]) + __shfl_xor(b3 ? s2[0] : s2[1], 8);
          f += __shfl_xor(f, 16); f += __shfl_xor(f, 32); }
        float mx = f; mx = fmaxf(mx, dppf<0xB1>(mx)); mx = fmaxf(mx, dppf<0x4E>(mx)); mx = fmaxf(mx, dppf<0x141>(mx)); mx = fmaxf(mx, dppf<0x140>(mx));
        const float pe = expf(f - mx);
        float sum = pe; sum += dppf<0xB1>(sum); sum += dppf<0x4E>(sum); sum += dppf<0x141>(sum); sum += dppf<0x140>(sum);
        if (lane < 16) AFF[(size_t)row * NE + (((lane & 1) << 3) | ((lane & 2) << 1) | ((lane & 4) >> 1) | ((lane & 8) >> 3))] = pe / sum;
        row = nrow;
    }
}
__device__ __forceinline__ void p_postmix(const Ctx& C, const float* const (&in)[19], int layer) {
    LAS float* WR = (LAS float*)(C.lds + RING_OFF); LAS float* GPOST = WR + D * NE; LAS float* GPRE = GPOST + D; LAS float* G1 = GPRE + D; LAS float* SH2 = G1 + D; LAS float* SC2 = SH2 + D;
    { const float* wr = in[IN_WROUTER] + (size_t)layer * D * NE;
      for (int u = C.tid; u < D * NE / 4; u += NWAVES * 64) { const f32x4 w = ((const f32x4*)wr)[u]; const int d = u >> 2, e0 = (u & 3) * 4;
          WR[(e0 + 0) * D + d] = w.x; WR[(e0 + 1) * D + d] = w.y; WR[(e0 + 2) * D + d] = w.z; WR[(e0 + 3) * D + d] = w.w; } }
    stage_vec4(GPOST, in[IN_GPOSTMIX] + (size_t)layer * D, D / 4, C.tid); stage_vec4(GPRE, in[IN_GPREFFN] + (size_t)layer * D, D / 4, C.tid);
    const bool by_sample = (C.G & 3) == 0;
    const int npass = by_sample ? 1 : 4;
    for (int ps = 0; ps < npass; ++ps) {
        const int b = by_sample ? ((int)blockIdx.x & 3) : ps;
        if (ps > 0) __syncthreads();
        stage_vec4(G1, modx(C, layer, b, 2), 3 * D / 4, C.tid);
        __syncthreads();
        const int wgs = by_sample ? C.G / 4 : C.G, wgi = by_sample ? ((int)blockIdx.x >> 2) : (int)blockIdx.x;
        if (layer == 0) postmix_rows<true>(C, in, layer, b * SEQ + wgi * NWAVES + C.wave, wgs * NWAVES, (b + 1) * SEQ, WR, GPOST, GPRE, G1, SH2, SC2);
        else postmix_rows<false>(C, in, layer, b * SEQ + wgi * NWAVES + C.wave, wgs * NWAVES, (b + 1) * SEQ, WR, GPOST, GPRE, G1, SH2, SC2);
    }
    if (layer == 0) {
        __syncthreads();
        stage_vec4(G1, modx(C, layer, 4, 2), 3 * D / 4, C.tid);
        __syncthreads();
        postmix_rows<true>(C, in, layer, MX + C.gw, C.NGW, MT, WR, GPOST, GPRE, G1, SH2, SC2);
    }
}

__device__ __forceinline__ int wave_isum(int v) {
#pragma unroll
    for (int o = 1; o < 64; o <<= 1) v += __shfl_xor(v, o);
    return v;
}
__device__ __forceinline__ void p_route(const Ctx& C, int layer) {
    const float* AFF = (const float*)(C.ws + WS_AFF); int* SLOT = (int*)(C.ws + WS_SLOT); const unsigned char* H2 = C.ws + WS_H2; unsigned char* XS = C.ws + WS_XS;
    LAS int* red = (LAS int*)(C.lds + RING_OFF);
    LAS int* list = (LAS int*)(C.lds + RING_OFF + 1024); LAS int* cnt = (LAS int*)(C.lds + RING_OFF + 512);
    if (layer == 0) {
        for (int id = C.wave * C.G + (int)blockIdx.x; id < NB * NE; id += C.NGW) {
            const int b = id >> 4, e = id & 15, rowbase = MX + b * CTXL, xsbase = e * EROWS + NB * CAPX + b * CAPC;
            unsigned v[4];
#pragma unroll
            for (int j = 0; j < 4; ++j) v[j] = __float_as_uint(AFF[(size_t)(rowbase + C.lane * 4 + j) * NE + e]);
            unsigned T = 0u;
            for (int bit = 30; bit >= 0; --bit) { const unsigned cand = T | (1u << bit); int c = 0;
#pragma unroll
                for (int j = 0; j < 4; ++j) c += __builtin_popcountll(__builtin_amdgcn_ballot_w64(v[j] >= cand));
                if (c >= CAPC) T = cand; }
            int cg = 0, ce = 0;
#pragma unroll
            for (int j = 0; j < 4; ++j) { cg += (v[j] > T) ? 1 : 0; ce += (v[j] == T) ? 1 : 0; }
            int sg = cg, se = ce;
#pragma unroll
            for (int o = 1; o < 64; o <<= 1) { const int ag = __shfl_up(sg, o), ae = __shfl_up(se, o); if (C.lane >= o) { sg += ag; se += ae; } }
            const int totg = __builtin_amdgcn_readlane(sg, 63), need_eq = CAPC - totg;
            int pg = sg - cg, pe = se - ce;
#pragma unroll
            for (int j = 0; j < 4; ++j) {
                const int t = C.lane * 4 + j; const bool gt = v[j] > T, eq = v[j] == T; const bool sel = gt || (eq && pe < need_eq); const int slot = pg + min(pe, need_eq);
                SLOT[(size_t)(rowbase + t) * NE + e] = sel ? slot : -1;
                unsigned long long mk = __builtin_amdgcn_ballot_w64(sel);
                while (mk) { const int l = __builtin_ctzll(mk); mk &= mk - 1ull; const int sl = __builtin_amdgcn_readlane(slot, l);
                    ((v4u*)(XS + (size_t)(xsbase + sl) * D))[C.lane] = ((const v4u*)(H2 + (size_t)(rowbase + l * 4 + j) * D))[C.lane]; }
                pg += gt ? 1 : 0; pe += eq ? 1 : 0;
            }
        }
    }
    const int nitems = 256;
    for (int item = blockIdx.x; item < nitems; item += C.G) {
        int b, e, NT, rowbase, cap, tok0, ntok, xsbase;
        if (item < 256) { b = item >> 6; e = (item >> 2) & 15; NT = SEQ; rowbase = b * SEQ; cap = CAPX; tok0 = (item & 3) * 1024; ntok = 1024; xsbase = e * EROWS + b * CAPX; }
        else { const int j = item - 256; b = j >> 4; e = j & 15; NT = CTXL; rowbase = MX + b * CTXL; cap = CAPC; tok0 = 0; ntok = CTXL; xsbase = e * EROWS + NB * CAPX + b * CAPC; }
        unsigned v[8];
#pragma unroll
        for (int j = 0; j < 8; ++j) { const int t = C.tid * 8 + j; v[j] = t < NT ? __float_as_uint(AFF[(size_t)(rowbase + t) * NE + e]) : 0u; }
        if (C.tid == 0) *cnt = 0;
        unsigned T = 0u;
        for (int bit = 30; bit >= 0; --bit) {
            const unsigned cand = T | (1u << bit); int c = 0;
#pragma unroll
            for (int j = 0; j < 8; ++j) c += __builtin_popcountll(__builtin_amdgcn_ballot_w64(v[j] >= cand));
            LAS int* r = red + (bit & 1) * 8;
            if (C.lane == 0) r[C.wave] = c;
            __syncthreads();
            int tot = 0;
#pragma unroll
            for (int w = 0; w < 8; ++w) tot += r[w];
            if (tot >= cap) T = cand;
        }
        int cg = 0, ce = 0;
#pragma unroll
        for (int j = 0; j < 8; ++j) { cg += (v[j] > T) ? 1 : 0; ce += (v[j] == T && (C.tid * 8 + j) < NT) ? 1 : 0; }
        int sg = cg, se = ce;
#pragma unroll
        for (int o = 1; o < 64; o <<= 1) { const int ag = __shfl_up(sg, o), ae = __shfl_up(se, o); if (C.lane >= o) { sg += ag; se += ae; } }
        LAS int* sc = red + 64;
        __syncthreads();
        if (C.lane == 63) { sc[C.wave] = sg; sc[8 + C.wave] = se; }
        __syncthreads();
        int bg = 0, be = 0, totg = 0;
#pragma unroll
        for (int w = 0; w < 8; ++w) { const int xg = sc[w], xe = sc[8 + w]; if (w < C.wave) { bg += xg; be += xe; } totg += xg; }
        int pg = bg + sg - cg, pe = be + se - ce;
        const int need_eq = cap - totg;
#pragma unroll
        for (int j = 0; j < 8; ++j) {
            const int t = C.tid * 8 + j; const bool gt = v[j] > T, eq = (v[j] == T) && t < NT;
            const bool sel = gt || (eq && pe < need_eq);
            const int slot = pg + min(pe, need_eq);
            if (t >= tok0 && t < tok0 + ntok) {
                SLOT[(size_t)(rowbase + t) * NE + e] = sel ? slot : -1;
                if (sel) { const int pos = atomicAdd((int*)cnt, 1); list[2 * pos] = t; list[2 * pos + 1] = slot; }
            }
            pg += gt ? 1 : 0; pe += eq ? 1 : 0;
        }
        __syncthreads();
        const int n = *cnt;
        for (int idx = C.wave * 8; idx < n; idx += NWAVES * 8) {
            v4u w[8]; int sl8[8];
#pragma unroll
            for (int q = 0; q < 8; ++q) { const int ii = min(idx + q, n - 1); sl8[q] = list[2 * ii + 1]; w[q] = ((const v4u*)(H2 + (size_t)(rowbase + list[2 * ii]) * D))[C.lane]; }
#pragma unroll
            for (int q = 0; q < 8; ++q) ((v4u*)(XS + (size_t)(xsbase + sl8[q]) * D))[C.lane] = w[q];
        }
        __syncthreads();
    }
}

__device__ __forceinline__ void combine_rows(const Ctx& C, float* XO, int layer, int row0, int rstride, int rend, int ebase_, const LAS float* GPF, const LAS float* G2, const LAS float* GP1, const LAS float* SH1, const LAS float* SC1) {
    const float* AFF = (const float*)(C.ws + WS_AFF); const int* SLOT = (const int*)(C.ws + WS_SLOT); const bf16* YE = (const bf16*)(C.ws + WS_YE); const bf16* X1 = (const bf16*)(C.ws + WS_X1); bf16* H = (bf16*)(C.ws + WS_H);
    const int lane = C.lane, le = lane & 15;
    int row = row0; u32x2 xx[4], nx[4]; int sl = -1, nsl = -1; float gt = 0.f, ngt = 0.f;
    if (row < rend) { sl = SLOT[(size_t)row * NE + le]; gt = AFF[(size_t)row * NE + le];
#pragma unroll
        for (int j = 0; j < 4; ++j) xx[j] = ((const u32x2*)(X1 + (size_t)row * D))[lane + 64 * j]; }
    while (row < rend) {
        const int nrow = row + rstride;
        { const int prow = nrow < rend ? nrow : rend - 1;
          nsl = SLOT[(size_t)prow * NE + le]; ngt = AFF[(size_t)prow * NE + le];
#pragma unroll
          for (int j = 0; j < 4; ++j) nx[j] = ((const u32x2*)(X1 + (size_t)prow * D))[lane + 64 * j]; }
        f32x4 a[4];
#pragma unroll
        for (int j = 0; j < 4; ++j) a[j] = (f32x4){0.f, 0.f, 0.f, 0.f};
        const int ebase = ebase_ >= 0 ? ebase_ : NB * CAPX + ((row - MX) >> 8) * CAPC;
        unsigned mask = (unsigned)(__builtin_amdgcn_ballot_w64(sl >= 0) & 0xffffull);
        while (mask) {
            const int e0 = __builtin_ctz(mask); mask &= mask - 1u;
            const int s0 = __builtin_amdgcn_readlane(sl, e0); const float g0 = __builtin_bit_cast(float, __builtin_amdgcn_readlane(__builtin_bit_cast(int, gt), e0));
            const u32x2* y0 = (const u32x2*)(YE + (size_t)(e0 * EROWS + ebase + s0) * D);
            if (mask) {
                const int e1 = __builtin_ctz(mask); mask &= mask - 1u;
                const int s1 = __builtin_amdgcn_readlane(sl, e1); const float g1 = __builtin_bit_cast(float, __builtin_amdgcn_readlane(__builtin_bit_cast(int, gt), e1));
                const u32x2* y1 = (const u32x2*)(YE + (size_t)(e1 * EROWS + ebase + s1) * D);
                u32x2 w0[4], w1[4];
#pragma unroll
                for (int j = 0; j < 4; ++j) { w0[j] = y0[lane + 64 * j]; w1[j] = y1[lane + 64 * j]; }
#pragma unroll
                for (int j = 0; j < 4; ++j) { a[j].x += g0 * bflo(w0[j].x); a[j].y += g0 * bfhi(w0[j].x); a[j].z += g0 * bflo(w0[j].y); a[j].w += g0 * bfhi(w0[j].y); }
#pragma unroll
                for (int j = 0; j < 4; ++j) { a[j].x += g1 * bflo(w1[j].x); a[j].y += g1 * bfhi(w1[j].x); a[j].z += g1 * bflo(w1[j].y); a[j].w += g1 * bfhi(w1[j].y); }
            } else {
#pragma unroll
                for (int j = 0; j < 4; ++j) { const u32x2 w = y0[lane + 64 * j]; a[j].x += g0 * bflo(w.x); a[j].y += g0 * bfhi(w.x); a[j].z += g0 * bflo(w.y); a[j].w += g0 * bfhi(w.y); }
            }
        }
        const float r = 1.0f / sqrtf(wave_sum(sumsq4(a)) * (1.f / D) + RMS_EPS);
#pragma unroll
        for (int j = 0; j < 4; ++j) { const f32x4 gg = ((const LAS f32x4*)GPF)[lane + 64 * j], g2v = ((const LAS f32x4*)G2)[lane + 64 * j];
            a[j] = bf4(xx[j]) + g2v * (a[j] * r * gg);
            if (layer == 0) ((u32x2*)((bf16*)XO + (size_t)row * D))[lane + 64 * j] = pk4bf(a[j]); else ((f32x4*)(XO + (size_t)row * D))[lane + 64 * j] = a[j]; }
        if (layer == 0) norm_mod_store_lds(a, wave_sum(sumsq4(a)), GP1, SH1, SC1, H + (size_t)row * D, lane);
#pragma unroll
        for (int j = 0; j < 4; ++j) xx[j] = nx[j];
        sl = nsl; gt = ngt; row = nrow;
    }
}
__device__ __forceinline__ void p_combine(const Ctx& C, const float* const (&in)[19], float* out, int layer) {
    float* XO = layer == 0 ? (float*)(C.ws + WS_X2) : out;
    LAS float* GPF = (LAS float*)(C.lds + RING_OFF); LAS float* GP1 = GPF + D; LAS float* G2 = GP1 + D; LAS float* SH1 = G2 + D; LAS float* SC1 = SH1 + D;
    stage_vec4(GPF, in[IN_GPOSTFFN] + (size_t)layer * D, D / 4, C.tid);
    if (layer == 0) stage_vec4(GP1, in[IN_GPREMIX] + D, D / 4, C.tid);
    const bool by_sample = (C.G & 3) == 0; const int npass = by_sample ? 1 : 4;
    for (int ps = 0; ps < npass; ++ps) {
        const int b = by_sample ? ((int)blockIdx.x & 3) : ps;
        if (ps > 0) __syncthreads();
        stage_vec4(G2, modx(C, layer, b, 5), D / 4, C.tid);
        if (layer == 0) stage_vec4(SH1, modx(C, 1, b, 0), 2 * D / 4, C.tid);
        __syncthreads();
        const int wgs = by_sample ? C.G / 4 : C.G, wgi = by_sample ? ((int)blockIdx.x >> 2) : (int)blockIdx.x;
        combine_rows(C, XO, layer, b * SEQ + wgi * NWAVES + C.wave, wgs * NWAVES, (b + 1) * SEQ, b * CAPX, GPF, G2, GP1, SH1, SC1);
    }
    if (layer == 0) {
        __syncthreads();
        stage_vec4(G2, modx(C, layer, 4, 5), D / 4, C.tid); stage_vec4(SH1, modx(C, 1, 4, 0), 2 * D / 4, C.tid);
        __syncthreads();
        combine_rows(C, XO, layer, MX + C.gw, C.NGW, MT, -1, GPF, G2, GP1, SH1, SC1);
    }
}
constexpr int NPH = 22;
#ifndef MK_PER_PHASE
#define MK_PER_PHASE 0
#endif
struct Args { const float* in[19]; float* out; unsigned char* ws; int ph_lo, ph_hi; };
__global__ void __launch_bounds__(NWAVES * 64, 2) mk_fwd(Args args) {
    extern __shared__ __attribute__((aligned(16))) unsigned char lds_raw[];
    Ctx C;
    C.ws = args.ws; C.lds = (LAS unsigned char*)lds_raw;
    C.tid = threadIdx.x; C.lane = C.tid & 63; C.wave = __builtin_amdgcn_readfirstlane(C.tid >> 6); C.G = gridDim.x;
    C.gw = blockIdx.x * NWAVES + C.wave; C.NGW = C.G * NWAVES;
    volatile LAS unsigned* MISC = (volatile LAS unsigned*)(C.lds + MISC_OFF);
    for (int u = C.tid; u < (512 - 0) / 4; u += NWAVES * 64) ((LAS unsigned*)(C.lds + LDSCTL_OFF))[u] = 0u;
    if (C.tid < 64) { float s, c; sincospif((float)C.tid * (1.0f / 32.0f), &s, &c); ((LAS f32x2*)(C.lds + TW64_OFF))[C.tid] = (f32x2){c, s}; }
    if (C.tid < 256) { float s, c; sincospif((float)C.tid * (1.0f / 128.0f), &s, &c); ((LAS f32x2*)(C.lds + TW256_OFF))[C.tid] = (f32x2){c, s}; }
    if (C.tid >= 256 && C.tid < 320) { float s, c; sincospif((float)(C.tid - 256) * (1.0f / 2048.0f), &s, &c); ((LAS f32x2*)(C.lds + TW4K_OFF))[C.tid - 256] = (f32x2){c, s}; }
    for (int u = C.tid; u < 4096; u += NWAVES * 64) { float s, c; sincospif((float)(((u >> 6) * (u & 63)) & 63) * (1.0f / 32.0f), &s, &c); ((LAS bf16*)(C.lds + CT_OFF))[u] = (bf16)f2bf(c); ((LAS bf16*)(C.lds + ST_OFF))[u] = (bf16)f2bf(s); }
    __syncthreads();
    gu32* ctl = (gu32*)(C.ws + WS_CTL);
    XcdBarrier bar = xcd_barrier_post((unsigned*)(ctl + CW_BAR), MISC + 8);
    const int lo = args.ph_lo, hi = args.ph_hi;
#ifndef DBG_MASK
#define DBG_MASK 0xffffffffu
#endif
#define PH_ON(k) (((DBG_MASK) >> (k)) & 1u)
#ifndef DBG_REP
#define DBG_REP 0u
#endif
#define REP(k) _Pragma("unroll") for (int rep_ = 0; rep_ < 1 + (int)(((DBG_REP) >> (k)) & 1u); ++rep_)
#define IN(k) (lo <= (k) && (k) < hi)
#ifdef DBG_TPHASE
    unsigned long long tp0_ = 0, tp1_ = 0;
#define TPROBE(k) do { if ((k) == DBG_TPHASE) tp0_ = __builtin_amdgcn_s_memrealtime(); if ((k) == DBG_TPHASE + 1) tp1_ = __builtin_amdgcn_s_memrealtime(); } while (0)
#else
#define TPROBE(k) do { } while (0)
#endif
#define SEAM(k) do { if (IN(k) && IN((k) + 1)) xcd_barrier(bar); TPROBE((k) + 1); } while (0)

    TPROBE(0);
    if (PH_ON(0) && IN(0)) REP(0) p0_prologue(C, args.in);
    SEAM(0);
    if (PH_ON(1) && IN(1)) REP(1) p1_h0(C, args.in);
    SEAM(1);
    for (int layer = 0; layer < DEPTH; ++layer) {
        const int pb = 2 + 10 * layer;
        Ctx L = C; asm volatile("" : "+v"(L.tid), "+v"(L.lane)); asm volatile("" : "+s"(L.wave), "+s"(L.gw));
        if (PH_ON(2) && IN(pb + 0)) REP(2) {
            pg8::Gemm g{(const pg8::bf16_t*)(L.ws + WS_H), (const pg8::bf16_t*)(L.ws + WS_WINT) + (size_t)layer * NIN * D, MT, NIN, D};
            pg8::TileOrder S; S.init(MT / 256, NIN / 256, L.G, (int)blockIdx.x);
            pg8::EpiBf16Map E{(pg8::bf16_t*)(L.ws + WS_P), NIN, 1 << 30, 1.0f};
            pg8::gemm_phase<pg8::EpiBf16Map, pg8::TileOrder, true, true>(L.lds + RING_OFF, g, S, E);
            { const Defer d = defer_counts(L.G);
              tail_convert(L, args.in, (MT / 256) * (NIN / 256), layer == 0 ? N_EXP_L - (d.inproj + d.wout0) : 2 * N_EXP_L - d.inproj, NI_INPROJ); }
        }
        SEAM(pb + 0);
        if (IN(pb + 1)) { if (PH_ON(3)) REP(3) p_attn(L, args.in, layer);
            if (layer == 0 && (int)blockIdx.x >= 32) { const Defer d = defer_counts(L.G); const int abase = N_EXP_L - (d.inproj + d.wout0 + d.att);
              p0_expert_stream(L, args.in, abase + ((int)blockIdx.x - 32) * NWAVES + L.wave, abase + d.att, (L.G - 32) * NWAVES); } if (PH_ON(4)) REP(4) p_fft_a(L); if (PH_ON(5) && layer == 0) REP(5) p_fft_ctx1(L); }
        SEAM(pb + 1);
        if (IN(pb + 2)) { if (PH_ON(6)) REP(6) p_fft_b(L); if (PH_ON(5) && layer == 0) REP(5) p_fft_ctx2(L); }
        SEAM(pb + 2);
        if (PH_ON(7) && IN(pb + 3)) REP(7) p_merge(L, args.in, layer);
        SEAM(pb + 3);
        if (PH_ON(8) && IN(pb + 4)) REP(8) {
#if WOUT_FP8
            pg8::Gemm g{(const pg8::bf16_t*)(L.ws + WS_Y), (const pg8::bf16_t*)(L.ws + WS_WOUTT + (size_t)layer * D * D), MT, D, D / 2};
#else
            pg8::Gemm g{(const pg8::bf16_t*)(L.ws + WS_Y), (const pg8::bf16_t*)(L.ws + WS_WOUTT) + (size_t)layer * D * D, MT, D, D};
#endif
            pg8::TileOrder S; S.init((layer == 0 ? MT : MX) / 256, D / 256, L.G, (int)blockIdx.x);
            pg8::EpiBf16Map E{(pg8::bf16_t*)(L.ws + WS_MO), D, 1 << 30, WOUT_FP8 ? 1.0f / (S_Y * S_WOUT) : 1.0f};
            pg8::gemm_phase<pg8::EpiBf16Map, pg8::TileOrder, true, true, WOUT_FP8 != 0>(L.lds + RING_OFF, g, S, E);
            if (layer == 0) { const Defer d = defer_counts(L.G); tail_convert(L, args.in, (MT / 256) * (D / 256), N_EXP_L - d.wout0, NI_WOUT0); }
        }
        SEAM(pb + 4);
        if (PH_ON(9) && IN(pb + 5)) REP(9) p_postmix(L, args.in, layer);
        SEAM(pb + 5);
        if (PH_ON(10) && IN(pb + 6)) REP(10) p_route(L, layer);
        SEAM(pb + 6);
        if (PH_ON(11) && IN(pb + 7)) REP(11) {
            pg8::Gemm g{(const pg8::bf16_t*)(L.ws + WS_XS), (const pg8::bf16_t*)(L.ws + WS_WGUT + (size_t)layer * NE * 2 * FH * D), NE * EROWS, NE * 2 * FH, D / 2};
            pg8::GroupOrder S; S.init(NE, layer == 0 ? ETILES : ETILES - 1, ETILES, FNT, L.G, (int)blockIdx.x, ETILES - 1);
            pg8::EpiSwiGLU8 E{L.ws + WS_HID, FH, FNT, 1.0f / (S_ACT * S_WGU), S_HID};
            pg8::gemm_phase<pg8::EpiSwiGLU8, pg8::GroupOrder, true, true, true>(L.lds + RING_OFF, g, S, E);
            if (layer == 0) { const Defer d = defer_counts(L.G); tail_convert(L, args.in, NE * ETILES * FNT, 2 * N_EXP_L - (d.gu0 + d.dn0 + d.inproj), NI_GU0); }
        }
        SEAM(pb + 7);
        if (PH_ON(12) && IN(pb + 8)) REP(12) {
            pg8::Gemm g{(const pg8::bf16_t*)(L.ws + WS_HID), (const pg8::bf16_t*)(L.ws + WS_WDT + (size_t)layer * NE * D * FH), NE * EROWS, NE * D, FH / 2};
            pg8::GroupOrder S; S.init(NE, layer == 0 ? ETILES : ETILES - 1, ETILES, D / 256, L.G, (int)blockIdx.x, ETILES - 1);
            pg8::EpiBf16Map E{(pg8::bf16_t*)(L.ws + WS_YE), D, D / 256, 1.0f / (S_HID * S_WDN)};
            pg8::gemm_phase<pg8::EpiBf16Map, pg8::GroupOrder, true, true, true>(L.lds + RING_OFF, g, S, E);
            if (layer == 0) { const Defer d = defer_counts(L.G); tail_convert(L, args.in, NE * ETILES * (D / 256), 2 * N_EXP_L - (d.dn0 + d.inproj), NI_DN0); }
        }
        SEAM(pb + 8);
        if (PH_ON(13) && IN(pb + 9)) REP(13) p_combine(L, args.in, args.out, layer);
        SEAM(pb + 9);
#ifdef DBG_XBAR
        for (int xb = 0; xb < DBG_XBAR; ++xb) xcd_barrier(bar);
#endif
    }
#ifdef DBG_TPHASE
    if (DBG_TPHASE == NPH - 1) tp1_ = __builtin_amdgcn_s_memrealtime();
    { const unsigned long long t0 = __builtin_amdgcn_s_memrealtime(), dt = (tp1_ - tp0_) * DBG_SPINMUL; if (blockIdx.x == 0) while (__builtin_amdgcn_s_memrealtime() - t0 < dt) __builtin_amdgcn_s_sleep(8); }
#endif
#undef IN
#undef SEAM
}

extern "C" void kernel_launch(void* const* d_in, const int* in_sizes, int n_in, void* d_out, int out_size, void* d_ws, size_t ws_size, hipStream_t stream) {
    static int grid = 0;
    if (grid == 0) {
        if (n_in != 19 || in_sizes[0] != MX * D || out_size != MX * D || ws_size < WS_END) { fprintf(stderr, "kernel_launch: unexpected shapes (n_in %d, in0 %d, out %d, ws %zu < %zu); nothing launched\n", n_in, n_in > 0 ? in_sizes[0] : -1, out_size, ws_size, (size_t)WS_END); grid = -1; return; }
        int dev = 0, cus = 0, per_cu = 0;
        if (hipGetDevice(&dev) != hipSuccess || hipDeviceGetAttribute(&cus, hipDeviceAttributeMultiprocessorCount, dev) != hipSuccess) { fprintf(stderr, "kernel_launch: device query failed\n"); grid = -1; return; }
        if (hipFuncSetAttribute((const void*)mk_fwd, hipFuncAttributeMaxDynamicSharedMemorySize, LDS_BYTES) != hipSuccess) { fprintf(stderr, "kernel_launch: hipFuncSetAttribute failed\n"); grid = -1; return; }
        if (hipOccupancyMaxActiveBlocksPerMultiprocessor(&per_cu, (const void*)mk_fwd, NWAVES * 64, LDS_BYTES) != hipSuccess || per_cu < 1)
            fprintf(stderr, "kernel_launch: note: occupancy query reports %d workgroups per CU\n", per_cu);
        (void)hipGetLastError();
        grid = cus;
    }
    if (grid < 0) return;
    if (hipMemsetAsync((char*)d_ws + WS_CTL, 0, CTL_ZERO_BYTES, stream) != hipSuccess) { fprintf(stderr, "kernel_launch: memset failed\n"); return; }
    Args a{};
    for (int i = 0; i < 19; ++i) a.in[i] = (const float*)d_in[i];
    a.out = (float*)d_out; a.ws = (unsigned char*)d_ws;
#if MK_PER_PHASE
    for (int ph = 0; ph < NPH; ++ph) { a.ph_lo = ph; a.ph_hi = ph + 1; hipLaunchKernelGGL(mk_fwd, dim3(grid), dim3(NWAVES * 64), LDS_BYTES, stream, a); }
#else
    a.ph_lo = 0; a.ph_hi = NPH;
    hipLaunchKernelGGL(mk_fwd, dim3(grid), dim3(NWAVES * 64), LDS_BYTES, stream, a);
#endif
    const hipError_t le = hipPeekAtLastError();
    if (le != hipSuccess) fprintf(stderr, "kernel_launch: launch failed: %s\n", hipGetErrorName(le));
}
```
